# Optimizing an MI355X kernel written in HIP

```python
import math
import jax
import jax.numpy as jnp
from jax import lax
import numpy as np

D_MODEL = 1024
BATCH = 8
SEQ = 2048
DEPTH = 1
DEC_BATCH = 128
DEC_SEQ = 4
PAST_LEN = 2048
PAGE_SIZE = 128

HEAD_DIM = 64
N_ATTN_HEADS = D_MODEL // (2 * HEAD_DIM)
N_GDN_HEADS = D_MODEL // (2 * HEAD_DIM)
ATTN_WIDTH = N_ATTN_HEADS * HEAD_DIM
GDN_WIDTH = N_GDN_HEADS * HEAD_DIM
DILATED_PATTERNS = ((128, 1), (512, 4), (2048, 16))
MAX_WINDOW = 2048
T5_BUCKETS = 32
T5_MAX_EXACT = T5_BUCKETS // 2
T5_MAX_DIST = MAX_WINDOW
CONV_WIDTH = 4
GDN_CHUNK = 64
D_FF = 2816
IN_COLS = 3 * ATTN_WIDTH + 3 * GDN_WIDTH + GDN_WIDTH + 2 * N_GDN_HEADS
LN_EPS = 1e-5
RMS_EPS = 1e-6

kernel_name = 'hymba_dilated_gdn_macaron_deepnorm_step'


def _layernorm(x, g, b):
    xf = x.astype(jnp.float32)
    mu = jnp.mean(xf, axis=-1, keepdims=True)
    xc = xf - mu
    var = jnp.mean(xc * xc, axis=-1, keepdims=True)
    return (xc * lax.rsqrt(var + LN_EPS) * g.astype(jnp.float32) + b.astype(jnp.float32)).astype(x.dtype)


def _swiglu(x, w_gate, w_up, w_down):
    return (jax.nn.silu(x @ w_gate) * (x @ w_up)) @ w_down


def _l2norm(x):
    return x * lax.rsqrt(jnp.sum(x * x, axis=-1, keepdims=True) + RMS_EPS)


def _t5_bias(dist, rel_bias):
    n = jnp.maximum(dist, 0)
    nf = jnp.maximum(n, 1).astype(jnp.float32)
    large = T5_MAX_EXACT + (jnp.log(nf / T5_MAX_EXACT) / math.log(T5_MAX_DIST / T5_MAX_EXACT)
                            * (T5_BUCKETS - T5_MAX_EXACT)).astype(jnp.int32)
    large = jnp.minimum(large, T5_BUCKETS - 1)
    bucket = jnp.where(n < T5_MAX_EXACT, n, large)
    return rel_bias[bucket].astype(jnp.float32)


def _split_projection(h):
    B, L, _ = h.shape
    sizes = [ATTN_WIDTH, ATTN_WIDTH, ATTN_WIDTH, 3 * GDN_WIDTH, GDN_WIDTH, N_GDN_HEADS, N_GDN_HEADS]
    offs = [int(o) for o in np.cumsum(sizes)[:-1]]
    aq, ak, av, g_qkv, z, b, a = jnp.split(h, offs, axis=-1)
    heads = lambda t: t.reshape(B, L, N_ATTN_HEADS, HEAD_DIM)
    return heads(aq), heads(ak), heads(av), g_qkv, z, b, a


def _dilated_prompt(q, k, v, rel_bias, window, dilation):
    B, S, H, E = q.shape
    nb = window // dilation
    L = S // dilation
    nblk = -(-L // nb)
    lp = nblk * nb

    def classes(t):
        t = t.astype(jnp.float32).reshape(B, L, dilation, H, E).transpose(0, 2, 1, 3, 4)
        t = jnp.pad(t, ((0, 0), (0, 0), (0, lp - L), (0, 0), (0, 0)))
        return t.reshape(B, dilation, nblk, nb, H, E)

    qc = classes(q) * HEAD_DIM ** -0.5
    kc = classes(k)
    vc = classes(v)
    prev = lambda t: jnp.pad(t, ((0, 0), (0, 0), (1, 0), (0, 0), (0, 0), (0, 0)))[:, :, :-1]
    kk = jnp.concatenate([prev(kc), kc], axis=3)
    vv = jnp.concatenate([prev(vc), vc], axis=3)
    logits = jnp.einsum('brnqhe,brnkhe->brnhqk', qc, kk)
    qi = jnp.arange(nb)[:, None]
    ki = jnp.arange(2 * nb)[None, :]
    dist = qi + nb - ki
    key_cls = jnp.arange(nblk)[:, None, None] * nb - nb + ki[None]
    valid = (dist >= 0) & (dist <= nb) & (key_cls >= 0)
    bias = _t5_bias(dist * dilation, rel_bias).transpose(2, 0, 1)
    logits = jnp.where(valid[:, None], logits + bias, -jnp.inf)
    m = jnp.max(logits, axis=-1, keepdims=True)
    p = jnp.exp(logits - m)
    s = jnp.sum(p, axis=-1)
    o = jnp.einsum('brnhqk,brnkhe->brnqhe', p, vv) / s.transpose(0, 1, 2, 4, 3)[..., None]
    lse = (m[..., 0] + jnp.log(s)).transpose(0, 1, 2, 4, 3)

    def unclass(t):
        t = t.reshape((B, dilation, lp) + t.shape[4:])[:, :, :L]
        t = jnp.moveaxis(t, 1, 2)
        return t.reshape((B, S) + t.shape[3:])

    return unclass(o), unclass(lse)


def _dilated_sample(q, k_all, v_all, rel_bias, window, dilation):
    T = q.shape[1]
    w_past = k_all.shape[1] - T
    offs = jnp.arange(window // dilation + 1) * dilation
    idx = w_past + jnp.arange(T)[:, None] - offs[None, :]
    valid = idx >= 0
    idx = jnp.maximum(idx, 0)
    kg = k_all[:, idx].astype(jnp.float32)
    vg = v_all[:, idx].astype(jnp.float32)
    logits = jnp.einsum('bthe,btkhe->bthk', q.astype(jnp.float32) * HEAD_DIM ** -0.5, kg)
    logits = logits + _t5_bias(offs, rel_bias).T
    logits = jnp.where(valid[None, :, None, :], logits, -jnp.inf)
    m = jnp.max(logits, axis=-1, keepdims=True)
    p = jnp.exp(logits - m)
    s = jnp.sum(p, axis=-1)
    o = jnp.einsum('bthk,btkhe->bthe', p, vg) / s[..., None]
    return o, m[..., 0] + jnp.log(s)


def _merge_dilations(outs, lses):
    w = jax.nn.softmax(jnp.stack(lses), axis=0)
    return jnp.sum(w[..., None] * jnp.stack(outs), axis=0)


def _gdn_chunked(q, k, v, g, beta, s0, chunk):
    B, L, H, DK = q.shape
    DV = v.shape[-1]
    n = -(-L // chunk)
    pad = n * chunk - L
    padt = lambda t: jnp.pad(t, ((0, 0), (0, pad)) + ((0, 0),) * (t.ndim - 2))
    q, k, v, g, beta = [padt(t) for t in (q, k, v, g, beta)]
    ch4 = lambda t: t.reshape(B, n, chunk, H, t.shape[-1]).transpose(1, 0, 3, 2, 4)
    ch3 = lambda t: t.reshape(B, n, chunk, H).transpose(1, 0, 3, 2)
    q, k, v = ch4(q), ch4(k), ch4(v)
    g, beta = ch3(g), ch3(beta)
    gc = jnp.cumsum(g, axis=-1)
    eye = jnp.eye(chunk, dtype=jnp.float32)
    tril = jnp.tril(jnp.ones((chunk, chunk), dtype=bool))
    strict = tril & ~jnp.eye(chunk, dtype=bool)
    diff = gc[..., :, None] - gc[..., None, :]
    decay = jnp.where(tril, jnp.exp(jnp.where(tril, diff, 0.0)), 0.0)
    kb = k * beta[..., None]
    a = jnp.where(strict, jnp.einsum('nbhcd,nbhsd->nbhcs', kb, k) * decay, 0.0)
    t_inv = lax.linalg.triangular_solve(eye + a, jnp.broadcast_to(eye, a.shape),
                                        left_side=True, lower=True, unit_diagonal=True)
    u = jnp.einsum('nbhcs,nbhse->nbhce', t_inv, v * beta[..., None])
    w = jnp.einsum('nbhcs,nbhsd->nbhcd', t_inv, kb * jnp.exp(gc)[..., None])
    intra = jnp.where(tril, jnp.einsum('nbhcd,nbhsd->nbhcs', q, k) * decay, 0.0)
    qd = q * jnp.exp(gc)[..., None]
    kd = k * jnp.exp(gc[..., -1:] - gc)[..., None]
    glast = jnp.exp(gc[..., -1])

    def step(s, xs):
        u_i, w_i, intra_i, qd_i, kd_i, gl_i = xs
        v_new = u_i - jnp.einsum('bhcd,bhde->bhce', w_i, s)
        o_i = jnp.einsum('bhcd,bhde->bhce', qd_i, s) + jnp.einsum('bhcs,bhse->bhce', intra_i, v_new)
        s = s * gl_i[..., None, None] + jnp.einsum('bhcd,bhce->bhde', kd_i, v_new)
        return s, o_i

    s_final, o = lax.scan(step, s0, (u, w, intra, qd, kd, glast))
    o = o.transpose(1, 0, 3, 2, 4).reshape(B, n * chunk, H, DV)[:, :L]
    return o, s_final


def _gdn_branch(qkv_raw, z, b, a, conv_buf, s0, conv_w, a_log, dt_bias, norm_w):
    B, L, _ = qkv_raw.shape
    xp = jnp.concatenate([conv_buf.astype(qkv_raw.dtype), qkv_raw], axis=1)
    conv = sum(xp[:, j:j + L] * conv_w[j] for j in range(CONV_WIDTH))
    new_buf = xp[:, L:]
    qkv = jax.nn.silu(conv.astype(jnp.float32))
    q, k, v = [t.reshape(B, L, N_GDN_HEADS, HEAD_DIM) for t in jnp.split(qkv, 3, axis=-1)]
    q = _l2norm(q) * HEAD_DIM ** -0.5
    k = _l2norm(k)
    beta = jax.nn.sigmoid(b.astype(jnp.float32))
    g = -jnp.exp(a_log.astype(jnp.float32)) * jax.nn.softplus(a.astype(jnp.float32) + dt_bias.astype(jnp.float32))
    o, s_new = _gdn_chunked(q, k, v, g, beta, s0.astype(jnp.float32), min(GDN_CHUNK, L))
    o = o * lax.rsqrt(jnp.mean(o * o, axis=-1, keepdims=True) + RMS_EPS) * norm_w.astype(jnp.float32)
    o = o * jax.nn.silu(z.astype(jnp.float32).reshape(B, L, N_GDN_HEADS, HEAD_DIM))
    return o.reshape(B, L, GDN_WIDTH), s_new, new_buf


def _mixer_prompt(xn, w_in, rel_bias, conv_w, a_log, dt_bias, norm_w):
    B, L, _ = xn.shape
    aq, ak, av, g_qkv, z, b, a = _split_projection(xn @ w_in)
    res = [_dilated_prompt(aq, ak, av, rel_bias, wd, dl) for (wd, dl) in DILATED_PATTERNS]
    attn = _merge_dilations([r[0] for r in res], [r[1] for r in res])
    conv0 = jnp.zeros((B, CONV_WIDTH - 1, 3 * GDN_WIDTH), xn.dtype)
    s0 = jnp.zeros((B, N_GDN_HEADS, HEAD_DIM, HEAD_DIM), jnp.float32)
    gdn, s_new, conv_new = _gdn_branch(g_qkv, z, b, a, conv0, s0, conv_w, a_log, dt_bias, norm_w)
    heads = jnp.concatenate([attn.reshape(B, L, ATTN_WIDTH).astype(xn.dtype), gdn.astype(xn.dtype)], axis=-1)
    wp = min(MAX_WINDOW, L)
    return heads, (ak[:, L - wp:], av[:, L - wp:], s_new, conv_new)


def _mixer_sample(xn, k_past, v_past, s_past, conv_past, w_in, rel_bias, conv_w, a_log, dt_bias, norm_w):
    B, L, _ = xn.shape
    aq, ak, av, g_qkv, z, b, a = _split_projection(xn @ w_in)
    k_all = jnp.concatenate([k_past.astype(ak.dtype), ak], axis=1)
    v_all = jnp.concatenate([v_past.astype(av.dtype), av], axis=1)
    res = [_dilated_sample(aq, k_all, v_all, rel_bias, wd, dl) for (wd, dl) in DILATED_PATTERNS]
    attn = _merge_dilations([r[0] for r in res], [r[1] for r in res])
    gdn, s_new, conv_new = _gdn_branch(g_qkv, z, b, a, conv_past, s_past, conv_w, a_log, dt_bias, norm_w)
    heads = jnp.concatenate([attn.reshape(B, L, ATTN_WIDTH).astype(xn.dtype), gdn.astype(xn.dtype)], axis=-1)
    return heads, (ak, av, s_new, conv_new)


def _macaron_layer(x, mixer, alpha, ln1_g, ln1_b, ln2_g, ln2_b, ln3_g, ln3_b,
                   f1_gate, f1_up, f1_down, f2_gate, f2_up, f2_down, w_out):
    x = _layernorm(alpha * x + 0.5 * _swiglu(x, f1_gate, f1_up, f1_down), ln1_g, ln1_b)
    heads, states = mixer(x)
    x = _layernorm(alpha * x + heads @ w_out, ln2_g, ln2_b)
    x = _layernorm(alpha * x + 0.5 * _swiglu(x, f2_gate, f2_up, f2_down), ln3_g, ln3_b)
    return x, states


def setup_inputs(seed: int = 0) -> dict:
    key = jax.random.key(seed)
    ks = jax.random.split(key, 32)
    f32 = jnp.float32
    w_buf = min(MAX_WINDOW, PAST_LEN)
    out_scale = (8.0 * DEPTH) ** -0.25

    def dense(k, shape, fan_in, scale=1.0):
        return jax.random.normal(k, shape, f32) * (scale * fan_in ** -0.5)

    def gain(k, shape):
        return 1.0 + 0.05 * jax.random.normal(k, shape, f32)

    def small(k, shape):
        return 0.02 * jax.random.normal(k, shape, f32)

    dt = jnp.exp(jax.random.uniform(ks[24], (DEPTH, N_GDN_HEADS), f32, math.log(1e-3), math.log(1e-1)))
    return {
        'x_prompt': jax.random.normal(ks[0], (BATCH, SEQ, D_MODEL), f32),
        'x_sample': jax.random.normal(ks[1], (DEC_BATCH, DEC_SEQ, D_MODEL), f32),
        'cache_attn_k': jax.random.normal(ks[2], (DEPTH, DEC_BATCH, w_buf, N_ATTN_HEADS, HEAD_DIM), f32),
        'cache_attn_v': jax.random.normal(ks[3], (DEPTH, DEC_BATCH, w_buf, N_ATTN_HEADS, HEAD_DIM), f32),
        'state_gdn': 0.1 * jax.random.normal(ks[4], (DEPTH, DEC_BATCH, N_GDN_HEADS, HEAD_DIM, HEAD_DIM), f32),
        'state_conv': jax.random.normal(ks[5], (DEPTH, DEC_BATCH, CONV_WIDTH - 1, 3 * GDN_WIDTH), f32),
        'rel_bias': 0.5 * jax.random.normal(ks[6], (T5_BUCKETS, N_ATTN_HEADS), f32),
        'ln1_g': gain(ks[7], (DEPTH, D_MODEL)),
        'ln1_b': small(ks[8], (DEPTH, D_MODEL)),
        'ffn1_w_gate': dense(ks[9], (DEPTH, D_MODEL, D_FF), D_MODEL),
        'ffn1_w_up': dense(ks[10], (DEPTH, D_MODEL, D_FF), D_MODEL),
        'ffn1_w_down': dense(ks[11], (DEPTH, D_FF, D_MODEL), D_FF, out_scale),
        'w_in': dense(ks[12], (DEPTH, D_MODEL, IN_COLS), D_MODEL),
        'w_out': dense(ks[13], (DEPTH, D_MODEL, D_MODEL), D_MODEL, out_scale),
        'gdn_conv_w': dense(ks[14], (DEPTH, CONV_WIDTH, 3 * GDN_WIDTH), CONV_WIDTH),
        'gdn_a_log': jnp.log(jax.random.uniform(ks[15], (DEPTH, N_GDN_HEADS), f32, 1.0, 16.0)),
        'gdn_dt_bias': dt + jnp.log(-jnp.expm1(-dt)),
        'gdn_norm_w': gain(ks[16], (DEPTH, HEAD_DIM)),
        'ln2_g': gain(ks[17], (DEPTH, D_MODEL)),
        'ln2_b': small(ks[18], (DEPTH, D_MODEL)),
        'ffn2_w_gate': dense(ks[19], (DEPTH, D_MODEL, D_FF), D_MODEL),
        'ffn2_w_up': dense(ks[20], (DEPTH, D_MODEL, D_FF), D_MODEL),
        'ffn2_w_down': dense(ks[21], (DEPTH, D_FF, D_MODEL), D_FF, out_scale),
        'ln3_g': gain(ks[22], (DEPTH, D_MODEL)),
        'ln3_b': small(ks[23], (DEPTH, D_MODEL)),
    }


def reference(x_prompt, x_sample, cache_attn_k, cache_attn_v, state_gdn, state_conv, rel_bias,
              ln1_g, ln1_b, ffn1_w_gate, ffn1_w_up, ffn1_w_down, w_in, w_out,
              gdn_conv_w, gdn_a_log, gdn_dt_bias, gdn_norm_w, ln2_g, ln2_b,
              ffn2_w_gate, ffn2_w_up, ffn2_w_down, ln3_g, ln3_b):
    alpha = (2.0 * DEPTH) ** 0.25
    yp, ys = x_prompt, x_sample
    collected = [[] for _ in range(8)]
    for layer in range(DEPTH):
        common = (ln1_g[layer], ln1_b[layer], ln2_g[layer], ln2_b[layer], ln3_g[layer], ln3_b[layer],
                  ffn1_w_gate[layer], ffn1_w_up[layer], ffn1_w_down[layer],
                  ffn2_w_gate[layer], ffn2_w_up[layer], ffn2_w_down[layer], w_out[layer])
        mix_w = (w_in[layer], rel_bias, gdn_conv_w[layer], gdn_a_log[layer], gdn_dt_bias[layer], gdn_norm_w[layer])
        yp, st_p = _macaron_layer(yp, lambda xn: _mixer_prompt(xn, *mix_w), alpha, *common)
        ys, st_s = _macaron_layer(
            ys, lambda xn: _mixer_sample(xn, cache_attn_k[layer], cache_attn_v[layer],
                                         state_gdn[layer], state_conv[layer], *mix_w), alpha, *common)
        for lst, st in zip(collected, st_p + st_s):
            lst.append(st)
    k_p, v_p, sg_p, sc_p, k_s, v_s, sg_s, sc_s = [jnp.stack(t, axis=0) for t in collected]
    return (yp, ys, k_p, v_p, sg_p, sc_p, k_s, v_s, sg_s, sc_s)
```

```cpp
#include <hip/hip_runtime.h>
#include <cstdio>
#include <cstdint>
#include <cstring>
#include <cmath>
namespace pg8 {
#define PG8_LAS __attribute__((address_space(3)))
typedef unsigned short bf16_t;
typedef short bf16x8 __attribute__((ext_vector_type(8)));
typedef float f32x4 __attribute__((ext_vector_type(4)));
typedef unsigned u32x4 __attribute__((ext_vector_type(4)));
constexpr int BM = 256, BK = 64, HALF = 128, HTB = HALF * BK * 2  , STAGE_BYTES = 8 * HTB, NXCD = 8, WGM = 8;

__host__ __device__ __forceinline__ int lds_byte(int r, int c) { const int st = (r >> 4) * 2 + (c >> 5), rr = r & 15, cc = c & 31, ob = rr * 64 + cc * 2; return st * 1024 + (ob ^ (((ob >> 9) & 1) << 5)); }
__host__ __device__ __forceinline__ void stage_rc(int b, int& R, int& C) { const int st = b / 1024, sb = b % 1024, swz = sb ^ (((sb >> 9) & 1) << 5); R = (st >> 1) * 16 + swz / 64; C = (st & 1) * 32 + (swz % 64) / 2; }
__host__ __device__ __forceinline__ int perm32(int rho) { const int n = rho >> 4, i = rho & 15; return 8 * (i >> 2) + 4 * n + (i & 3); }

struct Unit { int pm, pn; };
struct Gemm { const bf16_t* A; const bf16_t* Bt; int M, N, K, pad; };

struct StaticOrder {
    int nM, nN, nwg, G, c;
    __host__ __device__ void init(int M, int N, int G_, int c_) { nM = M / BM; nN = N / BM; nwg = nM * nN; G = G_; c = c_; }
    __host__ __device__ bool next(int i, Unit& u) const {
        const long L = (long)i * G + c; if (L >= nwg) return false;
        int wgid = (int)L; { const int q = nwg / NXCD, r = nwg % NXCD, xcd = wgid % NXCD, off = wgid / NXCD; wgid = (xcd < r ? xcd * (q + 1) : r * (q + 1) + (xcd - r) * q) + off; }
        const int nig = WGM * nN, gid = wgid / nig, fm = gid * WGM, gsz = (nM - fm) < WGM ? (nM - fm) : WGM;
        u.pm = fm + ((wgid % nig) % gsz); u.pn = (wgid % nig) / gsz; return true;
    }
    __device__ __forceinline__ void a_ready(const Unit&) const {}
    __device__ __forceinline__ void done(const Unit&) const {}
};

__device__ __forceinline__ unsigned cvt_pk_bf16(float lo, float hi) { unsigned r; asm volatile("v_cvt_pk_bf16_f32 %0, %1, %2" : "=v"(r) : "v"(lo), "v"(hi)); return r; }
typedef float f32x2 __attribute__((ext_vector_type(2)));
struct EpiF32 {
    static constexpr bool PERM = false, AFTER_DRAIN = false;
    float* C; int ldc, pad;
    __device__ __forceinline__ void operator()(const f32x4 (&acc)[2][2][4][2], const Unit& u, int wr, int wc, int fr, int fq) const {
        const int row0 = u.pm * BM + wr * 64 + fr, col0 = u.pn * BM + wc * 32 + 4 * fq;
#pragma unroll
        for (int ai = 0; ai < 2; ++ai)
#pragma unroll
            for (int m = 0; m < 4; ++m) { float* rowp = C + (size_t)(row0 + ai * HALF + m * 16) * ldc + col0;
#pragma unroll
                for (int bj = 0; bj < 2; ++bj)
#pragma unroll
                    for (int n = 0; n < 2; ++n) *(f32x4*)(rowp + bj * HALF + n * 16) = acc[ai][bj][m][n]; }
    }
};
__device__ __forceinline__ float silu_f(float x) { return x * __builtin_amdgcn_rcpf(1.0f + __builtin_amdgcn_exp2f(-1.4426950408889634f * x)); }
struct EpiSwiGLU {
    static constexpr bool PERM = true, AFTER_DRAIN = false;
    bf16_t* H; int ldc, pad;
    __device__ __forceinline__ void operator()(const f32x4 (&acc)[2][2][4][2], const Unit& u, int wr, int wc, int fr, int fq) const {
        const int row0 = u.pm * BM + wr * 64 + fr, col0 = u.pn * HALF + wc * 32 + 8 * fq;
#pragma unroll
        for (int ai = 0; ai < 2; ++ai)
#pragma unroll
            for (int m = 0; m < 4; ++m) { bf16_t* rowp = H + (size_t)(row0 + ai * HALF + m * 16) * ldc + col0;
                const f32x4 g0 = acc[ai][0][m][0], g1 = acc[ai][0][m][1], u0 = acc[ai][1][m][0], u1 = acc[ai][1][m][1];
                u32x4 w;
                w.x = cvt_pk_bf16(silu_f(g0[0]) * u0[0], silu_f(g0[1]) * u0[1]); w.y = cvt_pk_bf16(silu_f(g0[2]) * u0[2], silu_f(g0[3]) * u0[3]);
                w.z = cvt_pk_bf16(silu_f(g1[0]) * u1[0], silu_f(g1[1]) * u1[1]); w.w = cvt_pk_bf16(silu_f(g1[2]) * u1[2], silu_f(g1[3]) * u1[3]);
                *(u32x4*)rowp = w; }
    }
};
template <class Epi, class Sched, bool ALIGN_EPI = false, bool SP2 = false>
__device__ __forceinline__ void gemm_phase(PG8_LAS unsigned char* lds, const Gemm g, const Sched& S, const Epi& E) {
    const int tid = threadIdx.x, wid = __builtin_amdgcn_readfirstlane(tid >> 6), lane = tid & 63, wr = wid >> 2, wc = wid & 3, fr = lane & 15, fq = lane >> 4;
    const int K = g.K, nt = K / BK;
    unsigned voffA[2], voffB[2];
#pragma unroll
    for (int i = 0; i < 2; ++i) { int R, C; stage_rc(tid * 16 + i * 8192, R, C); const int Rb = Epi::PERM ? ((R & ~31) + perm32(R & 31)) : R;
        voffA[i] = (unsigned)(R * K + C) * 2u; voffB[i] = (unsigned)(Rb * K + C) * 2u; }
    const size_t kstep = (size_t)(BK * 2);
    const size_t hstep = (size_t)HALF * K * 2;
    const size_t tstep = 2 * hstep;
    const unsigned ldsw = (unsigned)wid * 1024u;
    const int aoff = lds_byte(wr * 64 + fr, fq * 8), boff = lds_byte(wc * 32 + fr, fq * 8);
#define PG8_SA(b, h) (((b) * 2 + (h)) * HTB)
#define PG8_SB(b, h) ((4 + (b) * 2 + (h)) * HTB)
#define PG8_STAGE(bufoff, gbase, voff) do { _Pragma("unroll") for (int _i = 0; _i < 2; ++_i) \
        __builtin_amdgcn_global_load_lds((const unsigned*)((const char*)(gbase) + (voff)[_i]), (PG8_LAS unsigned*)(lds + (bufoff) + ldsw + _i * 8192), 16, 0, 0); } while (0)
#define PG8_LDA(dst, b, h) do { _Pragma("unroll") for (int m = 0; m < 4; ++m) _Pragma("unroll") for (int k = 0; k < 2; ++k) dst[m][k] = *(const PG8_LAS bf16x8*)(lds + PG8_SA(b, h) + aoff + m * 2048 + k * 1024); } while (0)
#define PG8_LDB(dst, b, h) do { _Pragma("unroll") for (int n = 0; n < 2; ++n) _Pragma("unroll") for (int k = 0; k < 2; ++k) dst[n][k] = *(const PG8_LAS bf16x8*)(lds + PG8_SB(b, h) + boff + n * 2048 + k * 1024); } while (0)
#define PG8_MMA(ai, bj, At, Bt) do { __builtin_amdgcn_s_setprio(1); _Pragma("unroll") for (int m = 0; m < 4; ++m) _Pragma("unroll") for (int n = 0; n < 2; ++n) _Pragma("unroll") for (int k = 0; k < 2; ++k) \
        acc[ai][bj][m][n] = __builtin_amdgcn_mfma_f32_16x16x32_bf16(Bt[n][k], At[m][k], acc[ai][bj][m][n], 0, 0, 0); __builtin_amdgcn_s_setprio(0); } while (0)
#define PG8_WAIT_V(n) asm volatile("s_waitcnt vmcnt(" #n ")" ::: "memory")
#define PG8_WAIT_L(n) asm volatile("s_waitcnt lgkmcnt(" #n ")" ::: "memory")
#define PG8_BAR __builtin_amdgcn_s_barrier()
#define PG8_SCHED __builtin_amdgcn_sched_barrier(0)
    Unit cur, nxt; int ui = 0;
    if (!S.next(0, cur)) return;
    f32x4 acc[2][2][4][2];
#pragma unroll
    for (int a = 0; a < 2; ++a)
#pragma unroll
        for (int b = 0; b < 2; ++b)
#pragma unroll
            for (int m = 0; m < 4; ++m)
#pragma unroll
                for (int n = 0; n < 2; ++n) acc[a][b][m][n] = (f32x4){0.f, 0.f, 0.f, 0.f};
    bf16x8 At[4][2], B0[2][2], B1[2][2];
    const char* cA = (const char*)g.A + (size_t)cur.pm * tstep; const char* cB = (const char*)g.Bt + (size_t)cur.pn * tstep;
    S.a_ready(cur);
    if constexpr (SP2) {
        PG8_STAGE(PG8_SB(0, 0), cB, voffB); PG8_STAGE(PG8_SB(0, 1), cB + hstep, voffB); PG8_STAGE(PG8_SA(0, 0), cA, voffA); PG8_STAGE(PG8_SA(0, 1), cA + hstep, voffA);
        if (wr == 1) PG8_BAR;
        PG8_WAIT_V(2); PG8_BAR;
        PG8_STAGE(PG8_SB(1, 0), cB + kstep, voffB); PG8_STAGE(PG8_SA(1, 0), cA + kstep, voffA); PG8_STAGE(PG8_SB(1, 1), cB + hstep + kstep, voffB);
        PG8_WAIT_V(6); PG8_BAR;
    } else {
        PG8_STAGE(PG8_SB(0, 0), cB, voffB); PG8_STAGE(PG8_SA(0, 0), cA, voffA); PG8_STAGE(PG8_SB(0, 1), cB + hstep, voffB); PG8_STAGE(PG8_SA(0, 1), cA + hstep, voffA);
        if (wr == 1) PG8_BAR;
        PG8_WAIT_V(4); PG8_BAR;
        PG8_STAGE(PG8_SB(1, 0), cB + kstep, voffB); PG8_STAGE(PG8_SA(1, 0), cA + kstep, voffA); PG8_STAGE(PG8_SB(1, 1), cB + hstep + kstep, voffB);
        PG8_WAIT_V(6); PG8_BAR;
    }
    for (;;) {
        const bool has_next = S.next(ui + 1, nxt);
        const char* nA = has_next ? (const char*)g.A + (size_t)nxt.pm * tstep : cA; const char* nB = has_next ? (const char*)g.Bt + (size_t)nxt.pn * tstep : cB;
        for (int t = 0; t < nt; t += 2) {
            const bool last = (t == nt - 2);
            const char* a1 = cA + (size_t)(t + 1) * kstep;
            const char* a2 = last ? nA : cA + (size_t)(t + 2) * kstep; const char* b2 = last ? nB : cB + (size_t)(t + 2) * kstep;
            const char* a3 = a2 + kstep; const char* b3 = b2 + kstep;
            if (last && has_next) S.a_ready(nxt);
            if constexpr (SP2) {
            PG8_LDB(B0, 0, 0); PG8_LDB(B1, 0, 1); PG8_SCHED; PG8_LDA(At, 0, 0); PG8_STAGE(PG8_SA(1, 1), a1 + hstep, voffA);
            PG8_WAIT_V(8); PG8_WAIT_L(0); PG8_BAR; PG8_MMA(0, 0, At, B0); PG8_MMA(0, 1, At, B1); PG8_BAR; PG8_SCHED;
            PG8_LDA(At, 0, 1); PG8_STAGE(PG8_SB(0, 0), b2, voffB); PG8_STAGE(PG8_SB(0, 1), b2 + hstep, voffB); PG8_STAGE(PG8_SA(0, 0), a2, voffA);
            PG8_WAIT_V(8); PG8_WAIT_L(0); PG8_BAR; PG8_MMA(1, 0, At, B0); PG8_MMA(1, 1, At, B1); PG8_BAR; PG8_SCHED;
            PG8_LDB(B0, 1, 0); PG8_LDB(B1, 1, 1); PG8_SCHED; PG8_LDA(At, 1, 0); PG8_STAGE(PG8_SA(0, 1), a2 + hstep, voffA);
            PG8_WAIT_V(8); PG8_WAIT_L(0); PG8_BAR; PG8_MMA(0, 0, At, B0); PG8_MMA(0, 1, At, B1); PG8_BAR; PG8_SCHED;
            PG8_LDA(At, 1, 1); PG8_STAGE(PG8_SB(1, 0), b3, voffB); PG8_STAGE(PG8_SB(1, 1), b3 + hstep, voffB); PG8_STAGE(PG8_SA(1, 0), a3, voffA);
            PG8_WAIT_V(8); PG8_WAIT_L(0); PG8_BAR; PG8_MMA(1, 0, At, B0); PG8_MMA(1, 1, At, B1); PG8_BAR; PG8_SCHED;
            } else {
            PG8_LDB(B0, 0, 0); PG8_SCHED; PG8_LDA(At, 0, 0); PG8_STAGE(PG8_SA(1, 1), a1 + hstep, voffA);
            PG8_WAIT_L(8); PG8_BAR; PG8_WAIT_L(0); PG8_MMA(0, 0, At, B0); PG8_BAR; PG8_SCHED;
            PG8_LDB(B1, 0, 1); PG8_STAGE(PG8_SB(0, 0), b2, voffB);
            PG8_BAR; PG8_WAIT_L(0); PG8_MMA(0, 1, At, B1); PG8_BAR;
            PG8_LDA(At, 0, 1); PG8_STAGE(PG8_SA(0, 0), a2, voffA);
            PG8_BAR; PG8_WAIT_L(0); PG8_MMA(1, 0, At, B0); PG8_BAR; PG8_SCHED;
            PG8_STAGE(PG8_SB(0, 1), b2 + hstep, voffB);
            PG8_WAIT_V(6); PG8_BAR; PG8_MMA(1, 1, At, B1); PG8_BAR;
            PG8_LDB(B0, 1, 0); PG8_SCHED; PG8_LDA(At, 1, 0); PG8_STAGE(PG8_SA(0, 1), a2 + hstep, voffA);
            PG8_WAIT_L(8); PG8_BAR; PG8_WAIT_L(0); PG8_MMA(0, 0, At, B0); PG8_BAR; PG8_SCHED;
            PG8_LDB(B1, 1, 1); PG8_STAGE(PG8_SB(1, 0), b3, voffB);
            PG8_BAR; PG8_WAIT_L(0); PG8_MMA(0, 1, At, B1); PG8_BAR;
            PG8_LDA(At, 1, 1); PG8_STAGE(PG8_SA(1, 0), a3, voffA);
            PG8_BAR; PG8_WAIT_L(0); PG8_MMA(1, 0, At, B0); PG8_BAR; PG8_SCHED;
            PG8_STAGE(PG8_SB(1, 1), b3 + hstep, voffB);
            PG8_WAIT_V(6); PG8_BAR; PG8_MMA(1, 1, At, B1); PG8_BAR;
            }
        }
        if constexpr (ALIGN_EPI) { if (wr == 0) PG8_BAR; }
        if constexpr (!Epi::AFTER_DRAIN) { E(acc, cur, wr, wc, fr, fq); S.done(cur); }
        if (!has_next) break;
#pragma unroll
        for (int a = 0; a < 2; ++a)
#pragma unroll
            for (int b = 0; b < 2; ++b)
#pragma unroll
                for (int m = 0; m < 4; ++m)
#pragma unroll
                    for (int n = 0; n < 2; ++n) acc[a][b][m][n] = (f32x4){0.f, 0.f, 0.f, 0.f};
        cur = nxt; cA = nA; cB = nB; ++ui;
        if constexpr (ALIGN_EPI) { if (wr == 1) PG8_BAR; }
    }
    PG8_WAIT_V(0);
    if constexpr (!ALIGN_EPI) { if (wr == 0) PG8_BAR; }
    PG8_BAR;
    if constexpr (Epi::AFTER_DRAIN) { E.fused(acc, cur, wr, wc, fr, fq, lds, wid, lane); S.done(cur); }
#undef PG8_SA
#undef PG8_SB
#undef PG8_STAGE
#undef PG8_LDA
#undef PG8_LDB
#undef PG8_MMA
#undef PG8_WAIT_V
#undef PG8_WAIT_L
#undef PG8_BAR
#undef PG8_SCHED
}
}

typedef unsigned short bf16;
typedef float f32x4 __attribute__((ext_vector_type(4)));
constexpr int DM = 1024, NB = 8, SEQ = 2048, DB = 128, DS = 4;
constexpr int MP = NB * SEQ, MS = DB * DS, M = MP + MS;
constexpr int FF = 2816, NGU = 2 * FF, NIN = 3600, NINP = 3840;
constexpr int NH = 8, HD = 64, AW = 512, GW = 512;
constexpr int C_AQ = 0, C_AK = 512, C_AV = 1024, C_GQKV = 1536, C_Z = 3072, C_B = 3584, C_A = 3592;
constexpr float LN_EPS = 1e-5f, RMS_EPS = 1e-6f, ALPHA = 1.189207115002721f;
constexpr size_t O_YP = 0, O_YS = 16777216, O_KP = 17301504, O_VP = 25690112, O_SGP = 34078720, O_SCP = 34340864, O_KS = 34377728, O_VS = 34639872, O_SGS = 34902016, O_SCS = 39096320, O_END = 39686144;
constexpr size_t MiB = 1u << 20;
constexpr size_t WS_CTL = 0, WS_WGU1 = 1 * MiB, WS_WD1 = 13 * MiB, WS_WIN = 19 * MiB, WS_WOUT = 27 * MiB, WS_WGU2 = 29 * MiB, WS_WD2 = 41 * MiB;
constexpr size_t WS_XB = 48 * MiB, WS_H = 82 * MiB, WS_T = 174 * MiB, WS_X1 = 240 * MiB, WS_X1B = 306 * MiB, WS_P = 340 * MiB, WS_HEADS = 588 * MiB;
constexpr size_t WS_GQ = 622 * MiB, WS_GK = 655 * MiB, WS_GV = 688 * MiB, WS_GG = 721 * MiB, WS_GB = 722 * MiB, WS_GO = 723 * MiB, WS_X2 = 756 * MiB, WS_X2B = 822 * MiB, WS_END = 856 * MiB;

struct Args { const float* in[25]; float* out; unsigned char* ws; };

__device__ __forceinline__ unsigned f2bf(float f) { unsigned u = __builtin_bit_cast(unsigned, f); return (u + 0x7fffu + ((u >> 16) & 1u)) >> 16; }
__device__ __forceinline__ float wave_sum(float v) {
#pragma unroll
    for (int o = 1; o < 64; o <<= 1) v += __shfl_xor(v, o);
    return v;
}
__device__ __forceinline__ float wave_max(float v) {
#pragma unroll
    for (int o = 1; o < 64; o <<= 1) v = fmaxf(v, __shfl_xor(v, o));
    return v;
}
__device__ __forceinline__ int t5_bucket(int n) {
    if (n < 16) return n;
    int b = 16;
    b += (n >= 22); b += (n >= 30); b += (n >= 40); b += (n >= 54); b += (n >= 73); b += (n >= 99); b += (n >= 134); b += (n >= 182);
    b += (n >= 246); b += (n >= 332); b += (n >= 450); b += (n >= 609); b += (n >= 825); b += (n >= 1117); b += (n >= 1513);
    return b;
}

__global__ void __launch_bounds__(256) k_transpose(const float* W0, const float* W1, int K, int Nsrc, bf16* dst, int mode) {
    __shared__ float tile[64][65];
    const int n0 = blockIdx.x * 64, k0 = blockIdx.y * 64, tid = threadIdx.x;
    const float* src = W0; int c0 = n0;
    if (mode == 1) { const int t = n0 / 256, w = n0 % 256; src = (w < 128) ? W0 : W1; c0 = t * 128 + (w & 127); }
    for (int i = 0; i < 16; ++i) { const int kk = i * 4 + (tid >> 6), j = tid & 63; tile[kk][j] = (c0 + j < Nsrc) ? src[(size_t)(k0 + kk) * Nsrc + c0 + j] : 0.f; }
    __syncthreads();
    for (int i = 0; i < 16; ++i) { const int r = i * 4 + (tid >> 6), c = tid & 63; dst[(size_t)(n0 + r) * K + k0 + c] = (bf16)f2bf(tile[c][r]); }
}
__global__ void __launch_bounds__(256) k_cvt_x(const float* xp, const float* xs, bf16* xb) {
    const size_t i = ((size_t)blockIdx.x * 256 + threadIdx.x) * 4;
    if (i >= (size_t)M * DM) return;
    const float* s = (i < (size_t)MP * DM) ? xp + i : xs + (i - (size_t)MP * DM);
    const f32x4 v = *(const f32x4*)s;
    unsigned long long w = (unsigned long long)(f2bf(v.x) | (f2bf(v.y) << 16)) | ((unsigned long long)(f2bf(v.z) | (f2bf(v.w) << 16)) << 32);
    *(unsigned long long*)(xb + i) = w;
}
__global__ void __launch_bounds__(512) k_ln(const float* r0, const float* r1, const float* t, float s, const float* g, const float* b, float* o0, float* o1, bf16* ob) {
    const int wave = threadIdx.x >> 6, lane = threadIdx.x & 63, m = blockIdx.x * 8 + wave;
    if (m >= M) return;
    const float* rr = (m < MP) ? r0 + (size_t)m * DM : r1 + (size_t)(m - MP) * DM;
    const float* tt = t + (size_t)m * DM;
    f32x4 v[4]; float sum = 0.f;
#pragma unroll
    for (int j = 0; j < 4; ++j) { const f32x4 a = *(const f32x4*)(rr + j * 256 + lane * 4), c = *(const f32x4*)(tt + j * 256 + lane * 4); v[j] = a * ALPHA + c * s; sum += (v[j].x + v[j].y) + (v[j].z + v[j].w); }
    const float mean = wave_sum(sum) * (1.f / DM); float s2 = 0.f;
#pragma unroll
    for (int j = 0; j < 4; ++j) { v[j] = v[j] - mean; s2 += (v[j].x * v[j].x + v[j].y * v[j].y) + (v[j].z * v[j].z + v[j].w * v[j].w); }
    const float rstd = 1.0f / sqrtf(wave_sum(s2) * (1.f / DM) + LN_EPS);
    float* oo = (m < MP) ? o0 + (size_t)m * DM : o1 + (size_t)(m - MP) * DM;
#pragma unroll
    for (int j = 0; j < 4; ++j) { const f32x4 gg = *(const f32x4*)(g + j * 256 + lane * 4), bb = *(const f32x4*)(b + j * 256 + lane * 4); const f32x4 y = v[j] * rstd * gg + bb;
        *(f32x4*)(oo + j * 256 + lane * 4) = y;
        if (ob) { unsigned long long w = (unsigned long long)(f2bf(y.x) | (f2bf(y.y) << 16)) | ((unsigned long long)(f2bf(y.z) | (f2bf(y.w) << 16)) << 32); *(unsigned long long*)(ob + (size_t)m * DM + j * 256 + lane * 4) = w; } }
}
template <class Epi> __global__ void __launch_bounds__(512, 2) k_gemm(pg8::Gemm g, Epi E) {
    extern __shared__ __attribute__((aligned(16))) unsigned char lds[];
    pg8::StaticOrder S; S.init(g.M, g.N, (int)gridDim.x, (int)blockIdx.x);
    pg8::gemm_phase<Epi, pg8::StaticOrder, true, true>((PG8_LAS unsigned char*)lds, g, S, E);
}
__global__ void __launch_bounds__(256) k_copy_out(const float* P, float* out) {
    const int m = blockIdx.x, tid = threadIdx.x;
    const float* pr = P + (size_t)m * NINP;
    float* kd; float* vd;
    if (m < MP) { kd = out + O_KP + (size_t)m * AW; vd = out + O_VP + (size_t)m * AW; } else { kd = out + O_KS + (size_t)(m - MP) * AW; vd = out + O_VS + (size_t)(m - MP) * AW; }
    for (int c = tid; c < AW; c += 256) { kd[c] = pr[C_AK + c]; vd[c] = pr[C_AV + c]; }
    int slot = -1; float* sd = nullptr;
    if (m < MP) { const int b = m / SEQ, t = m % SEQ; if (t >= SEQ - 3) { slot = t - (SEQ - 3); sd = out + O_SCP + ((size_t)b * 3 + slot) * 1536; } }
    else { const int b = (m - MP) / DS, t = (m - MP) % DS; if (t >= 1) { slot = t - 1; sd = out + O_SCS + ((size_t)b * 3 + slot) * 1536; } }
    if (slot >= 0) for (int c = tid; c < 1536; c += 256) sd[c] = pr[C_GQKV + c];
}
__global__ void __launch_bounds__(512) k_attn_simple(const float* P, const float* ck, const float* cv, const float* relb, bf16* heads) {
    __shared__ float sq[8][64]; __shared__ float sp[8][392];
    const int m = blockIdx.x, h = threadIdx.x >> 6, lane = threadIdx.x & 63;
    const bool samp = m >= MP; int b, p;
    if (!samp) { b = m / SEQ; p = m % SEQ; } else { b = (m - MP) / DS; p = SEQ + (m - MP) % DS; }
    sq[h][lane] = P[(size_t)m * NINP + C_AQ + h * 64 + lane] * 0.125f;
    __syncthreads();
    float lg[7]; float mx = -INFINITY;
#pragma unroll
    for (int i = 0; i < 7; ++i) {
        const int e = i * 64 + lane; float v = -INFINITY;
        if (e < 387) { const int g = e / 129, j = e % 129, dil = (g == 0) ? 1 : (g == 1 ? 4 : 16), delta = j * dil, pos = p - delta;
            if (pos >= 0) {
                const float* kp;
                if (!samp) kp = P + (size_t)(b * SEQ + pos) * NINP + C_AK + h * 64;
                else if (pos >= SEQ) kp = P + (size_t)(MP + b * DS + (pos - SEQ)) * NINP + C_AK + h * 64;
                else kp = ck + (((size_t)b * SEQ + pos) * NH + h) * HD;
                float acc = 0.f;
#pragma unroll
                for (int d = 0; d < 64; d += 4) { const f32x4 kv = *(const f32x4*)(kp + d); acc += kv.x * sq[h][d] + kv.y * sq[h][d + 1] + kv.z * sq[h][d + 2] + kv.w * sq[h][d + 3]; }
                v = acc + relb[t5_bucket(delta) * NH + h]; } }
        lg[i] = v; mx = fmaxf(mx, v); }
    mx = wave_max(mx);
    float sum = 0.f;
#pragma unroll
    for (int i = 0; i < 7; ++i) { const int e = i * 64 + lane; const float pe = (lg[i] == -INFINITY) ? 0.f : __expf(lg[i] - mx); if (e < 387) sp[h][e] = pe; sum += pe; }
    sum = wave_sum(sum);
    __syncthreads();
    float o = 0.f;
    for (int e = 0; e < 387; ++e) { const float pe = sp[h][e]; if (pe == 0.f) continue;
        const int g = e / 129, j = e % 129, dil = (g == 0) ? 1 : (g == 1 ? 4 : 16), pos = p - j * dil;
        const float* vp;
        if (!samp) vp = P + (size_t)(b * SEQ + pos) * NINP + C_AV + h * 64;
        else if (pos >= SEQ) vp = P + (size_t)(MP + b * DS + (pos - SEQ)) * NINP + C_AV + h * 64;
        else vp = cv + (((size_t)b * SEQ + pos) * NH + h) * HD;
        o += pe * vp[lane]; }
    heads[(size_t)m * DM + h * 64 + lane] = (bf16)f2bf(o / sum);
}
__global__ void __launch_bounds__(512) k_gdn_prep(const float* P, const float* sconv, const float* convw, const float* alog, const float* dtb, float* GQ, float* GK, float* GV, float* GG, float* GB) {
    const int m = blockIdx.x, h = threadIdx.x >> 6, lane = threadIdx.x & 63;
    const bool samp = m >= MP; int b, t;
    if (!samp) { b = m / SEQ; t = m % SEQ; } else { b = (m - MP) / DS; t = (m - MP) % DS; }
    float r[3];
#pragma unroll
    for (int part = 0; part < 3; ++part) {
        const int c = part * 512 + h * 64 + lane; float acc = 0.f;
#pragma unroll
        for (int j = 0; j < 4; ++j) { const int tt = t - 3 + j; float x;
            if (tt >= 0) x = P[(size_t)(m - t + tt) * NINP + C_GQKV + c]; else x = samp ? sconv[((size_t)b * 3 + (tt + 3)) * 1536 + c] : 0.f;
            acc += x * convw[j * 1536 + c]; }
        r[part] = acc / (1.0f + __expf(-acc)); }
    const float qn = wave_sum(r[0] * r[0]), kn = wave_sum(r[1] * r[1]);
    GQ[(size_t)m * GW + h * 64 + lane] = r[0] * (1.0f / sqrtf(qn + RMS_EPS)) * 0.125f;
    GK[(size_t)m * GW + h * 64 + lane] = r[1] * (1.0f / sqrtf(kn + RMS_EPS));
    GV[(size_t)m * GW + h * 64 + lane] = r[2];
    if (lane == 0) { const float bb = P[(size_t)m * NINP + C_B + h], aa = P[(size_t)m * NINP + C_A + h] + dtb[h];
        GB[(size_t)m * NH + h] = 1.0f / (1.0f + __expf(-bb));
        const float sp = (aa > 20.f) ? aa : log1pf(__expf(aa));
        GG[(size_t)m * NH + h] = -__expf(alog[h]) * sp; }
}
__global__ void __launch_bounds__(64) k_gdn_scan(const float* GQ, const float* GK, const float* GV, const float* GG, const float* GB, const float* s0, float* GO, float* out) {
    const int seq = blockIdx.x / NH, h = blockIdx.x % NH, lane = threadIdx.x;
    float S[64]; int row0, L; float* sdst;
    if (seq < NB) { row0 = seq * SEQ; L = SEQ; sdst = out + O_SGP + ((size_t)seq * NH + h) * 4096;
#pragma unroll
        for (int d = 0; d < 64; ++d) S[d] = 0.f; }
    else { const int b = seq - NB; row0 = MP + b * DS; L = DS; sdst = out + O_SGS + ((size_t)b * NH + h) * 4096; const float* sp = s0 + ((size_t)b * NH + h) * 4096;
#pragma unroll
        for (int d = 0; d < 64; ++d) S[d] = sp[d * 64 + lane]; }
    size_t o = (size_t)row0 * GW + h * 64 + lane;
    float qn = GQ[o], kn = GK[o], vn = GV[o], gn = GG[(size_t)row0 * NH + h], bn = GB[(size_t)row0 * NH + h];
    for (int t = 0; t < L; ++t) {
        const float qv = qn, kv = kn, vv = vn, eg = __expf(gn), beta = bn; const size_t oc = o;
        if (t + 1 < L) { o += GW; qn = GQ[o]; kn = GK[o]; vn = GV[o]; gn = GG[(size_t)(row0 + t + 1) * NH + h]; bn = GB[(size_t)(row0 + t + 1) * NH + h]; }
        float k0 = 0.f, k1 = 0.f, k2 = 0.f, k3 = 0.f;
#pragma unroll
        for (int d = 0; d < 64; d += 4) {
            k0 += __builtin_bit_cast(float, __builtin_amdgcn_readlane(__builtin_bit_cast(int, kv), d)) * S[d];
            k1 += __builtin_bit_cast(float, __builtin_amdgcn_readlane(__builtin_bit_cast(int, kv), d + 1)) * S[d + 1];
            k2 += __builtin_bit_cast(float, __builtin_amdgcn_readlane(__builtin_bit_cast(int, kv), d + 2)) * S[d + 2];
            k3 += __builtin_bit_cast(float, __builtin_amdgcn_readlane(__builtin_bit_cast(int, kv), d + 3)) * S[d + 3]; }
        const float ks = (k0 + k1) + (k2 + k3);
        const float c = beta * (vv - eg * ks);
        float o0 = 0.f, o1 = 0.f, o2 = 0.f, o3 = 0.f;
#pragma unroll
        for (int d = 0; d < 64; d += 4) {
#pragma unroll
            for (int e = 0; e < 4; ++e) { const float kd = __builtin_bit_cast(float, __builtin_amdgcn_readlane(__builtin_bit_cast(int, kv), d + e)); S[d + e] = fmaf(kd, c, eg * S[d + e]); }
            o0 += __builtin_bit_cast(float, __builtin_amdgcn_readlane(__builtin_bit_cast(int, qv), d)) * S[d];
            o1 += __builtin_bit_cast(float, __builtin_amdgcn_readlane(__builtin_bit_cast(int, qv), d + 1)) * S[d + 1];
            o2 += __builtin_bit_cast(float, __builtin_amdgcn_readlane(__builtin_bit_cast(int, qv), d + 2)) * S[d + 2];
            o3 += __builtin_bit_cast(float, __builtin_amdgcn_readlane(__builtin_bit_cast(int, qv), d + 3)) * S[d + 3]; }
        GO[oc] = (o0 + o1) + (o2 + o3);
    }
#pragma unroll
    for (int d = 0; d < 64; ++d) sdst[d * 64 + lane] = S[d];
}
__global__ void __launch_bounds__(512) k_gdn_out(const float* GO, const float* P, const float* nw, bf16* heads) {
    const int m = blockIdx.x, h = threadIdx.x >> 6, lane = threadIdx.x & 63;
    const float o = GO[(size_t)m * GW + h * 64 + lane];
    const float ms = wave_sum(o * o) * (1.f / 64.f);
    const float z = P[(size_t)m * NINP + C_Z + h * 64 + lane];
    const float y = o * (1.0f / sqrtf(ms + RMS_EPS)) * nw[lane] * (z / (1.0f + __expf(-z)));
    heads[(size_t)m * DM + AW + h * 64 + lane] = (bf16)f2bf(y);
}

template <class Epi> static void launch_gemm(const bf16* A, const bf16* Bt, int N, int K, Epi E, hipStream_t stream) {
    pg8::Gemm g; memset(&g, 0, sizeof(g)); g.A = A; g.Bt = Bt; g.M = M; g.N = N; g.K = K;
    hipLaunchKernelGGL(k_gemm<Epi>, dim3(256), dim3(512), pg8::STAGE_BYTES, stream, g, E);
}
extern "C" void kernel_launch(void* const* d_in, const int* in_sizes, int n_in, void* d_out, int out_size, void* d_ws, size_t ws_size, hipStream_t stream) {
    static int ok = 0;
    if (ok == 0) {
        if (n_in != 25 || out_size != (int)O_END || ws_size < WS_END) { fprintf(stderr, "kernel_launch: unexpected shapes (n_in %d out %d ws %zu)\n", n_in, out_size, ws_size); ok = -1; return; }
        hipFuncSetAttribute((const void*)k_gemm<pg8::EpiF32>, hipFuncAttributeMaxDynamicSharedMemorySize, pg8::STAGE_BYTES);
        hipFuncSetAttribute((const void*)k_gemm<pg8::EpiSwiGLU>, hipFuncAttributeMaxDynamicSharedMemorySize, pg8::STAGE_BYTES);
        ok = 1;
    }
    if (ok < 0) return;
    const float* const* in = (const float* const*)d_in;
    unsigned char* ws = (unsigned char*)d_ws; float* out = (float*)d_out;
    bf16 *Wgu1 = (bf16*)(ws + WS_WGU1), *Wd1 = (bf16*)(ws + WS_WD1), *Win = (bf16*)(ws + WS_WIN), *Wout = (bf16*)(ws + WS_WOUT), *Wgu2 = (bf16*)(ws + WS_WGU2), *Wd2 = (bf16*)(ws + WS_WD2);
    bf16 *XB = (bf16*)(ws + WS_XB), *H = (bf16*)(ws + WS_H), *X1B = (bf16*)(ws + WS_X1B), *HEADS = (bf16*)(ws + WS_HEADS), *X2B = (bf16*)(ws + WS_X2B);
    float *T = (float*)(ws + WS_T), *X1 = (float*)(ws + WS_X1), *P = (float*)(ws + WS_P), *GQ = (float*)(ws + WS_GQ), *GK = (float*)(ws + WS_GK), *GV = (float*)(ws + WS_GV), *GG = (float*)(ws + WS_GG), *GB = (float*)(ws + WS_GB), *GO = (float*)(ws + WS_GO), *X2 = (float*)(ws + WS_X2);
    hipLaunchKernelGGL(k_transpose, dim3(NGU / 64, DM / 64), dim3(256), 0, stream, in[9], in[10], DM, FF, Wgu1, 1);
    hipLaunchKernelGGL(k_transpose, dim3(DM / 64, FF / 64), dim3(256), 0, stream, in[11], (const float*)nullptr, FF, DM, Wd1, 0);
    hipLaunchKernelGGL(k_transpose, dim3(NINP / 64, DM / 64), dim3(256), 0, stream, in[12], (const float*)nullptr, DM, NIN, Win, 0);
    hipLaunchKernelGGL(k_transpose, dim3(DM / 64, DM / 64), dim3(256), 0, stream, in[13], (const float*)nullptr, DM, DM, Wout, 0);
    hipLaunchKernelGGL(k_transpose, dim3(NGU / 64, DM / 64), dim3(256), 0, stream, in[20], in[21], DM, FF, Wgu2, 1);
    hipLaunchKernelGGL(k_transpose, dim3(DM / 64, FF / 64), dim3(256), 0, stream, in[22], (const float*)nullptr, FF, DM, Wd2, 0);
    hipLaunchKernelGGL(k_cvt_x, dim3((M * DM / 4 + 255) / 256), dim3(256), 0, stream, in[0], in[1], XB);
    { pg8::EpiSwiGLU E; memset(&E, 0, sizeof(E)); E.H = H; E.ldc = FF; launch_gemm(XB, Wgu1, NGU, DM, E, stream); }
    { pg8::EpiF32 E; memset(&E, 0, sizeof(E)); E.C = T; E.ldc = DM; launch_gemm(H, Wd1, DM, FF, E, stream); }
    hipLaunchKernelGGL(k_ln, dim3(M / 8), dim3(512), 0, stream, in[0], in[1], (const float*)T, 0.5f, in[7], in[8], X1, X1 + (size_t)MP * DM, X1B);
    { pg8::EpiF32 E; memset(&E, 0, sizeof(E)); E.C = P; E.ldc = NINP; launch_gemm(X1B, Win, NINP, DM, E, stream); }
    hipLaunchKernelGGL(k_copy_out, dim3(M), dim3(256), 0, stream, (const float*)P, out);
    hipLaunchKernelGGL(k_attn_simple, dim3(M), dim3(512), 0, stream, (const float*)P, in[2], in[3], in[6], HEADS);
    hipLaunchKernelGGL(k_gdn_prep, dim3(M), dim3(512), 0, stream, (const float*)P, in[5], in[14], in[15], in[16], GQ, GK, GV, GG, GB);
    hipLaunchKernelGGL(k_gdn_scan, dim3((NB + DB) * NH), dim3(64), 0, stream, (const float*)GQ, (const float*)GK, (const float*)GV, (const float*)GG, (const float*)GB, in[4], GO, out);
    hipLaunchKernelGGL(k_gdn_out, dim3(M), dim3(512), 0, stream, (const float*)GO, (const float*)P, in[17], HEADS);
    { pg8::EpiF32 E; memset(&E, 0, sizeof(E)); E.C = T; E.ldc = DM; launch_gemm(HEADS, Wout, DM, DM, E, stream); }
    hipLaunchKernelGGL(k_ln, dim3(M / 8), dim3(512), 0, stream, (const float*)X1, (const float*)(X1 + (size_t)MP * DM), (const float*)T, 1.0f, in[18], in[19], X2, X2 + (size_t)MP * DM, X2B);
    { pg8::EpiSwiGLU E; memset(&E, 0, sizeof(E)); E.H = H; E.ldc = FF; launch_gemm(X2B, Wgu2, NGU, DM, E, stream); }
    { pg8::EpiF32 E; memset(&E, 0, sizeof(E)); E.C = T; E.ldc = DM; launch_gemm(H, Wd2, DM, FF, E, stream); }
    hipLaunchKernelGGL(k_ln, dim3(M / 8), dim3(512), 0, stream, (const float*)X2, (const float*)(X2 + (size_t)MP * DM), (const float*)T, 0.5f, in[23], in[24], out + O_YP, out + O_YS, (bf16*)nullptr);
}
```

```cpp
#include <hip/hip_runtime.h>
#include <cstdio>
#include <cstdint>
#include <cstring>
#include <cmath>
namespace pg8 {
#define PG8_LAS __attribute__((address_space(3)))
typedef unsigned short bf16_t;
typedef short bf16x8 __attribute__((ext_vector_type(8)));
typedef float f32x4 __attribute__((ext_vector_type(4)));
typedef unsigned u32x4 __attribute__((ext_vector_type(4)));
constexpr int BM = 256, BK = 64, HALF = 128, HTB = HALF * BK * 2  , STAGE_BYTES = 8 * HTB, NXCD = 8, WGM = 8;

__host__ __device__ __forceinline__ int lds_byte(int r, int c) { const int st = (r >> 4) * 2 + (c >> 5), rr = r & 15, cc = c & 31, ob = rr * 64 + cc * 2; return st * 1024 + (ob ^ (((ob >> 9) & 1) << 5)); }
__host__ __device__ __forceinline__ void stage_rc(int b, int& R, int& C) { const int st = b / 1024, sb = b % 1024, swz = sb ^ (((sb >> 9) & 1) << 5); R = (st >> 1) * 16 + swz / 64; C = (st & 1) * 32 + (swz % 64) / 2; }
__host__ __device__ __forceinline__ int perm32(int rho) { const int n = rho >> 4, i = rho & 15; return 8 * (i >> 2) + 4 * n + (i & 3); }

struct Unit { int pm, pn; };
struct Gemm { const bf16_t* A; const bf16_t* Bt; int M, N, K, pad; };

struct StaticOrder {
    int nM, nN, nwg, G, c;
    __host__ __device__ void init(int M, int N, int G_, int c_) { nM = M / BM; nN = N / BM; nwg = nM * nN; G = G_; c = c_; }
    __host__ __device__ bool next(int i, Unit& u) const {
        const long L = (long)i * G + c; if (L >= nwg) return false;
        int wgid = (int)L; { const int q = nwg / NXCD, r = nwg % NXCD, xcd = wgid % NXCD, off = wgid / NXCD; wgid = (xcd < r ? xcd * (q + 1) : r * (q + 1) + (xcd - r) * q) + off; }
        const int nig = WGM * nN, gid = wgid / nig, fm = gid * WGM, gsz = (nM - fm) < WGM ? (nM - fm) : WGM;
        u.pm = fm + ((wgid % nig) % gsz); u.pn = (wgid % nig) / gsz; return true;
    }
    __device__ __forceinline__ void a_ready(const Unit&) const {}
    __device__ __forceinline__ void done(const Unit&) const {}
};

__device__ __forceinline__ unsigned cvt_pk_bf16(float lo, float hi) { unsigned r; asm volatile("v_cvt_pk_bf16_f32 %0, %1, %2" : "=v"(r) : "v"(lo), "v"(hi)); return r; }
typedef float f32x2 __attribute__((ext_vector_type(2)));
struct EpiF32 {
    static constexpr bool PERM = false, AFTER_DRAIN = false;
    float* C; int ldc, pad;
    __device__ __forceinline__ void operator()(const f32x4 (&acc)[2][2][4][2], const Unit& u, int wr, int wc, int fr, int fq) const {
        const int row0 = u.pm * BM + wr * 64 + fr, col0 = u.pn * BM + wc * 32 + 4 * fq;
#pragma unroll
        for (int ai = 0; ai < 2; ++ai)
#pragma unroll
            for (int m = 0; m < 4; ++m) { float* rowp = C + (size_t)(row0 + ai * HALF + m * 16) * ldc + col0;
#pragma unroll
                for (int bj = 0; bj < 2; ++bj)
#pragma unroll
                    for (int n = 0; n < 2; ++n) *(f32x4*)(rowp + bj * HALF + n * 16) = acc[ai][bj][m][n]; }
    }
};
__device__ __forceinline__ float silu_f(float x) { return x * __builtin_amdgcn_rcpf(1.0f + __builtin_amdgcn_exp2f(-1.4426950408889634f * x)); }
struct EpiSwiGLU {
    static constexpr bool PERM = true, AFTER_DRAIN = false;
    bf16_t* H; int ldc, pad;
    __device__ __forceinline__ void operator()(const f32x4 (&acc)[2][2][4][2], const Unit& u, int wr, int wc, int fr, int fq) const {
        const int row0 = u.pm * BM + wr * 64 + fr, col0 = u.pn * HALF + wc * 32 + 8 * fq;
#pragma unroll
        for (int ai = 0; ai < 2; ++ai)
#pragma unroll
            for (int m = 0; m < 4; ++m) { bf16_t* rowp = H + (size_t)(row0 + ai * HALF + m * 16) * ldc + col0;
                const f32x4 g0 = acc[ai][0][m][0], g1 = acc[ai][0][m][1], u0 = acc[ai][1][m][0], u1 = acc[ai][1][m][1];
                u32x4 w;
                w.x = cvt_pk_bf16(silu_f(g0[0]) * u0[0], silu_f(g0[1]) * u0[1]); w.y = cvt_pk_bf16(silu_f(g0[2]) * u0[2], silu_f(g0[3]) * u0[3]);
                w.z = cvt_pk_bf16(silu_f(g1[0]) * u1[0], silu_f(g1[1]) * u1[1]); w.w = cvt_pk_bf16(silu_f(g1[2]) * u1[2], silu_f(g1[3]) * u1[3]);
                *(u32x4*)rowp = w; }
    }
};
template <class Epi, class Sched, bool ALIGN_EPI = false, bool SP2 = false>
__device__ __forceinline__ void gemm_phase(PG8_LAS unsigned char* lds, const Gemm g, const Sched& S, const Epi& E) {
    const int tid = threadIdx.x, wid = __builtin_amdgcn_readfirstlane(tid >> 6), lane = tid & 63, wr = wid >> 2, wc = wid & 3, fr = lane & 15, fq = lane >> 4;
    const int K = g.K, nt = K / BK;
    unsigned voffA[2], voffB[2];
#pragma unroll
    for (int i = 0; i < 2; ++i) { int R, C; stage_rc(tid * 16 + i * 8192, R, C); const int Rb = Epi::PERM ? ((R & ~31) + perm32(R & 31)) : R;
        voffA[i] = (unsigned)(R * K + C) * 2u; voffB[i] = (unsigned)(Rb * K + C) * 2u; }
    const size_t kstep = (size_t)(BK * 2);
    const size_t hstep = (size_t)HALF * K * 2;
    const size_t tstep = 2 * hstep;
    const unsigned ldsw = (unsigned)wid * 1024u;
    const int aoff = lds_byte(wr * 64 + fr, fq * 8), boff = lds_byte(wc * 32 + fr, fq * 8);
#define PG8_SA(b, h) (((b) * 2 + (h)) * HTB)
#define PG8_SB(b, h) ((4 + (b) * 2 + (h)) * HTB)
#define PG8_STAGE(bufoff, gbase, voff) do { _Pragma("unroll") for (int _i = 0; _i < 2; ++_i) \
        __builtin_amdgcn_global_load_lds((const unsigned*)((const char*)(gbase) + (voff)[_i]), (PG8_LAS unsigned*)(lds + (bufoff) + ldsw + _i * 8192), 16, 0, 0); } while (0)
#define PG8_LDA(dst, b, h) do { _Pragma("unroll") for (int m = 0; m < 4; ++m) _Pragma("unroll") for (int k = 0; k < 2; ++k) dst[m][k] = *(const PG8_LAS bf16x8*)(lds + PG8_SA(b, h) + aoff + m * 2048 + k * 1024); } while (0)
#define PG8_LDB(dst, b, h) do { _Pragma("unroll") for (int n = 0; n < 2; ++n) _Pragma("unroll") for (int k = 0; k < 2; ++k) dst[n][k] = *(const PG8_LAS bf16x8*)(lds + PG8_SB(b, h) + boff + n * 2048 + k * 1024); } while (0)
#define PG8_MMA(ai, bj, At, Bt) do { __builtin_amdgcn_s_setprio(1); _Pragma("unroll") for (int m = 0; m < 4; ++m) _Pragma("unroll") for (int n = 0; n < 2; ++n) _Pragma("unroll") for (int k = 0; k < 2; ++k) \
        acc[ai][bj][m][n] = __builtin_amdgcn_mfma_f32_16x16x32_bf16(Bt[n][k], At[m][k], acc[ai][bj][m][n], 0, 0, 0); __builtin_amdgcn_s_setprio(0); } while (0)
#define PG8_WAIT_V(n) asm volatile("s_waitcnt vmcnt(" #n ")" ::: "memory")
#define PG8_WAIT_L(n) asm volatile("s_waitcnt lgkmcnt(" #n ")" ::: "memory")
#define PG8_BAR __builtin_amdgcn_s_barrier()
#define PG8_SCHED __builtin_amdgcn_sched_barrier(0)
    Unit cur, nxt; int ui = 0;
    if (!S.next(0, cur)) return;
    f32x4 acc[2][2][4][2];
#pragma unroll
    for (int a = 0; a < 2; ++a)
#pragma unroll
        for (int b = 0; b < 2; ++b)
#pragma unroll
            for (int m = 0; m < 4; ++m)
#pragma unroll
                for (int n = 0; n < 2; ++n) acc[a][b][m][n] = (f32x4){0.f, 0.f, 0.f, 0.f};
    bf16x8 At[4][2], B0[2][2], B1[2][2];
    const char* cA = (const char*)g.A + (size_t)cur.pm * tstep; const char* cB = (const char*)g.Bt + (size_t)cur.pn * tstep;
    S.a_ready(cur);
    if constexpr (SP2) {
        PG8_STAGE(PG8_SB(0, 0), cB, voffB); PG8_STAGE(PG8_SB(0, 1), cB + hstep, voffB); PG8_STAGE(PG8_SA(0, 0), cA, voffA); PG8_STAGE(PG8_SA(0, 1), cA + hstep, voffA);
        if (wr == 1) PG8_BAR;
        PG8_WAIT_V(2); PG8_BAR;
        PG8_STAGE(PG8_SB(1, 0), cB + kstep, voffB); PG8_STAGE(PG8_SA(1, 0), cA + kstep, voffA); PG8_STAGE(PG8_SB(1, 1), cB + hstep + kstep, voffB);
        PG8_WAIT_V(6); PG8_BAR;
    } else {
        PG8_STAGE(PG8_SB(0, 0), cB, voffB); PG8_STAGE(PG8_SA(0, 0), cA, voffA); PG8_STAGE(PG8_SB(0, 1), cB + hstep, voffB); PG8_STAGE(PG8_SA(0, 1), cA + hstep, voffA);
        if (wr == 1) PG8_BAR;
        PG8_WAIT_V(4); PG8_BAR;
        PG8_STAGE(PG8_SB(1, 0), cB + kstep, voffB); PG8_STAGE(PG8_SA(1, 0), cA + kstep, voffA); PG8_STAGE(PG8_SB(1, 1), cB + hstep + kstep, voffB);
        PG8_WAIT_V(6); PG8_BAR;
    }
    for (;;) {
        const bool has_next = S.next(ui + 1, nxt);
        const char* nA = has_next ? (const char*)g.A + (size_t)nxt.pm * tstep : cA; const char* nB = has_next ? (const char*)g.Bt + (size_t)nxt.pn * tstep : cB;
        for (int t = 0; t < nt; t += 2) {
            const bool last = (t == nt - 2);
            const char* a1 = cA + (size_t)(t + 1) * kstep;
            const char* a2 = last ? nA : cA + (size_t)(t + 2) * kstep; const char* b2 = last ? nB : cB + (size_t)(t + 2) * kstep;
            const char* a3 = a2 + kstep; const char* b3 = b2 + kstep;
            if (last && has_next) S.a_ready(nxt);
            if constexpr (SP2) {
            PG8_LDB(B0, 0, 0); PG8_LDB(B1, 0, 1); PG8_SCHED; PG8_LDA(At, 0, 0); PG8_STAGE(PG8_SA(1, 1), a1 + hstep, voffA);
            PG8_WAIT_V(8); PG8_WAIT_L(0); PG8_BAR; PG8_MMA(0, 0, At, B0); PG8_MMA(0, 1, At, B1); PG8_BAR; PG8_SCHED;
            PG8_LDA(At, 0, 1); PG8_STAGE(PG8_SB(0, 0), b2, voffB); PG8_STAGE(PG8_SB(0, 1), b2 + hstep, voffB); PG8_STAGE(PG8_SA(0, 0), a2, voffA);
            PG8_WAIT_V(8); PG8_WAIT_L(0); PG8_BAR; PG8_MMA(1, 0, At, B0); PG8_MMA(1, 1, At, B1); PG8_BAR; PG8_SCHED;
            PG8_LDB(B0, 1, 0); PG8_LDB(B1, 1, 1); PG8_SCHED; PG8_LDA(At, 1, 0); PG8_STAGE(PG8_SA(0, 1), a2 + hstep, voffA);
            PG8_WAIT_V(8); PG8_WAIT_L(0); PG8_BAR; PG8_MMA(0, 0, At, B0); PG8_MMA(0, 1, At, B1); PG8_BAR; PG8_SCHED;
            PG8_LDA(At, 1, 1); PG8_STAGE(PG8_SB(1, 0), b3, voffB); PG8_STAGE(PG8_SB(1, 1), b3 + hstep, voffB); PG8_STAGE(PG8_SA(1, 0), a3, voffA);
            PG8_WAIT_V(8); PG8_WAIT_L(0); PG8_BAR; PG8_MMA(1, 0, At, B0); PG8_MMA(1, 1, At, B1); PG8_BAR; PG8_SCHED;
            } else {
            PG8_LDB(B0, 0, 0); PG8_SCHED; PG8_LDA(At, 0, 0); PG8_STAGE(PG8_SA(1, 1), a1 + hstep, voffA);
            PG8_WAIT_L(8); PG8_BAR; PG8_WAIT_L(0); PG8_MMA(0, 0, At, B0); PG8_BAR; PG8_SCHED;
            PG8_LDB(B1, 0, 1); PG8_STAGE(PG8_SB(0, 0), b2, voffB);
            PG8_BAR; PG8_WAIT_L(0); PG8_MMA(0, 1, At, B1); PG8_BAR;
            PG8_LDA(At, 0, 1); PG8_STAGE(PG8_SA(0, 0), a2, voffA);
            PG8_BAR; PG8_WAIT_L(0); PG8_MMA(1, 0, At, B0); PG8_BAR; PG8_SCHED;
            PG8_STAGE(PG8_SB(0, 1), b2 + hstep, voffB);
            PG8_WAIT_V(6); PG8_BAR; PG8_MMA(1, 1, At, B1); PG8_BAR;
            PG8_LDB(B0, 1, 0); PG8_SCHED; PG8_LDA(At, 1, 0); PG8_STAGE(PG8_SA(0, 1), a2 + hstep, voffA);
            PG8_WAIT_L(8); PG8_BAR; PG8_WAIT_L(0); PG8_MMA(0, 0, At, B0); PG8_BAR; PG8_SCHED;
            PG8_LDB(B1, 1, 1); PG8_STAGE(PG8_SB(1, 0), b3, voffB);
            PG8_BAR; PG8_WAIT_L(0); PG8_MMA(0, 1, At, B1); PG8_BAR;
            PG8_LDA(At, 1, 1); PG8_STAGE(PG8_SA(1, 0), a3, voffA);
            PG8_BAR; PG8_WAIT_L(0); PG8_MMA(1, 0, At, B0); PG8_BAR; PG8_SCHED;
            PG8_STAGE(PG8_SB(1, 1), b3 + hstep, voffB);
            PG8_WAIT_V(6); PG8_BAR; PG8_MMA(1, 1, At, B1); PG8_BAR;
            }
        }
        if constexpr (ALIGN_EPI) { if (wr == 0) PG8_BAR; }
        if constexpr (!Epi::AFTER_DRAIN) { E(acc, cur, wr, wc, fr, fq); S.done(cur); }
        if (!has_next) break;
#pragma unroll
        for (int a = 0; a < 2; ++a)
#pragma unroll
            for (int b = 0; b < 2; ++b)
#pragma unroll
                for (int m = 0; m < 4; ++m)
#pragma unroll
                    for (int n = 0; n < 2; ++n) acc[a][b][m][n] = (f32x4){0.f, 0.f, 0.f, 0.f};
        cur = nxt; cA = nA; cB = nB; ++ui;
        if constexpr (ALIGN_EPI) { if (wr == 1) PG8_BAR; }
    }
    PG8_WAIT_V(0);
    if constexpr (!ALIGN_EPI) { if (wr == 0) PG8_BAR; }
    PG8_BAR;
    if constexpr (Epi::AFTER_DRAIN) { E.fused(acc, cur, wr, wc, fr, fq, lds, wid, lane); S.done(cur); }
#undef PG8_SA
#undef PG8_SB
#undef PG8_STAGE
#undef PG8_LDA
#undef PG8_LDB
#undef PG8_MMA
#undef PG8_WAIT_V
#undef PG8_WAIT_L
#undef PG8_BAR
#undef PG8_SCHED
}
}
#define GAS __attribute__((address_space(1)))
#define LAS __attribute__((address_space(3)))
typedef unsigned short bf16;
typedef unsigned v4u __attribute__((ext_vector_type(4)));
typedef float f32x4 __attribute__((ext_vector_type(4)));
typedef short bf16x8 __attribute__((ext_vector_type(8)));
typedef GAS unsigned gu32;
typedef GAS unsigned long long gu64;
#define RLX_AGENT __ATOMIC_RELAXED, __HIP_MEMORY_SCOPE_AGENT
#define LDS_WAIT() asm volatile("s_waitcnt lgkmcnt(0)" ::: "memory")
#define VM_WAIT() asm volatile("s_waitcnt vmcnt(0)" ::: "memory")
__device__ __forceinline__ unsigned long long rt() { return __builtin_amdgcn_s_memrealtime(); }
__device__ __forceinline__ unsigned f2bf(float f) { unsigned u = __builtin_bit_cast(unsigned, f); return (u + 0x7fffu + ((u >> 16) & 1u)) >> 16; }
__device__ __forceinline__ unsigned pk2(float lo, float hi) { return f2bf(lo) | (f2bf(hi) << 16); }
#define XB_TMO      128
#define XB_XCNT(j)  (256  + 64 * (j))
#define XB_XSUB(j)  (1280 + 64 * (j))
#define XB_XGEN(j)  (2304 + 64 * (j))
#define XB_TOP      3328
#define XB_TOPGEN   3392
#define XCD_BAR_WORDS 3456
#define XB_SPIN_CAP (1u << 18)

__device__ __forceinline__ unsigned xb_ld(unsigned* p)              { return __hip_atomic_load(p, __ATOMIC_RELAXED, __HIP_MEMORY_SCOPE_AGENT); }
__device__ __forceinline__ unsigned xb_add(unsigned* p, unsigned v) { return __hip_atomic_fetch_add(p, v, __ATOMIC_RELAXED, __HIP_MEMORY_SCOPE_AGENT); }
__device__ __forceinline__ unsigned xb_xcc_id() { return (unsigned)__builtin_amdgcn_s_getreg((3 << 11) | 20) & 0xFu; }
#define XB_SPIN(cond, bar) do { unsigned _sp = 0; while (cond) { __builtin_amdgcn_s_sleep(1); \
    if ((++_sp & 255u) == 0u) { if (xb_ld(&(bar)[XB_TMO])) break; if (_sp > XB_SPIN_CAP) { atomicAdd(&(bar)[XB_TMO], 1u); break; } } } } while (0)

struct XcdBarrier {
    unsigned* bar; unsigned x;
    volatile LAS unsigned* st;
};

__device__ __forceinline__ XcdBarrier xcd_barrier_post(unsigned* bar, volatile LAS unsigned* st) {
    XcdBarrier b; b.bar = bar; b.x = xb_xcc_id(); b.st = st;
    if (threadIdx.x == 0) (void)xb_add(&bar[XB_XCNT(b.x)], 1u);
    return b;
}
__device__ __forceinline__ void xcd_barrier_complete(unsigned* bar, unsigned x, unsigned& nloc, unsigned& nx) {
    const unsigned G = gridDim.x * gridDim.y * gridDim.z;
    unsigned sum, cnt, mine, sp = 0u;
    for (;;) {
        sum = 0u; cnt = 0u; mine = 0u;
#pragma unroll
        for (unsigned j = 0; j < 16; ++j) { const unsigned c = xb_ld(&bar[XB_XCNT(j)]); sum += c; cnt += (c > 0u) ? 1u : 0u; mine = (j == x) ? c : mine; }
        if (sum == G) break;
        __builtin_amdgcn_s_sleep(1);
        if ((++sp & 255u) == 0u) { if (xb_ld(&bar[XB_TMO])) break; if (sp > XB_SPIN_CAP) { atomicAdd(&bar[XB_TMO], 1u); break; } }
    }
    nloc = mine > 0u ? mine : 1u; nx = cnt > 0u ? cnt : 1u;
}

__device__ __forceinline__ void xcd_barrier(const XcdBarrier& b) {
    asm volatile("s_waitcnt vmcnt(0)" ::: "memory");
    __syncthreads();
    if (threadIdx.x == 0) {
        unsigned* bar = b.bar;
        __builtin_amdgcn_s_waitcnt(0);
        unsigned nloc = b.st[0], nx = b.st[1];
        if (nloc == 0u) { xcd_barrier_complete(bar, b.x, nloc, nx); b.st[0] = nloc; b.st[1] = nx; }
        const unsigned old = xb_add(&bar[XB_XSUB(b.x)], 1u);
        const unsigned gen = old / nloc;
        if (old + 1u == (gen + 1u) * nloc) {
            __builtin_amdgcn_fence(__ATOMIC_RELEASE, "agent");
            asm volatile("s_waitcnt vmcnt(0)" ::: "memory");
            const unsigned og = xb_add(&bar[XB_TOP], 1u);
            const unsigned tg = og / nx;
            if (og + 1u == (tg + 1u) * nx) xb_add(&bar[XB_TOPGEN], 1u);
            else XB_SPIN(xb_ld(&bar[XB_TOPGEN]) == tg, bar);
            __builtin_amdgcn_fence(__ATOMIC_ACQUIRE, "agent");
            xb_add(&bar[XB_XGEN(b.x)], 1u);
            asm volatile("s_waitcnt vmcnt(0)" ::: "memory");
        } else {
            XB_SPIN(xb_ld(&bar[XB_XGEN(b.x)]) == gen, bar);
            __builtin_amdgcn_fence(__ATOMIC_ACQUIRE, "agent");
            asm volatile("s_waitcnt vmcnt(0)" ::: "memory");
        }
    }
    __syncthreads();
}

constexpr int NWAVES = 8;
constexpr int DM = 1024, NB = 8, SEQ = 2048, DB = 128, DS = 4;
constexpr int MP = NB * SEQ, MS = DB * DS, M = MP + MS;
constexpr int FF = 2816, NGU = 2 * FF, NIN = 3600, NINP = 3840;
constexpr int NH = 8, HD = 64, AW = 512, GW = 512;
constexpr int C_AQ = 0, C_AK = 512, C_AV = 1024, C_GQKV = 1536, C_Z = 3072, C_B = 3584, C_A = 3592;
constexpr float LN_EPS = 1e-5f, RMS_EPS = 1e-6f, ALPHA = 1.189207115002721f;
constexpr size_t O_YP = 0, O_YS = 16777216, O_KP = 17301504, O_VP = 25690112, O_SGP = 34078720, O_SCP = 34340864, O_KS = 34377728, O_VS = 34639872, O_SGS = 34902016, O_SCS = 39096320, O_END = 39686144;
constexpr size_t MiB = 1u << 20;
constexpr size_t WS_CTL = 0, CTL_ZERO_BYTES = 1 * MiB, WS_WGU1 = 1 * MiB, WS_WD1 = 13 * MiB, WS_WIN = 19 * MiB, WS_WOUT = 27 * MiB, WS_WGU2 = 29 * MiB, WS_WD2 = 41 * MiB;
constexpr size_t WS_XB = 48 * MiB, WS_H = 82 * MiB, WS_T = 174 * MiB, WS_X1 = 240 * MiB, WS_X1B = 306 * MiB, WS_P = 340 * MiB, WS_HEADS = 588 * MiB;
constexpr size_t WS_GQ = 622 * MiB, WS_GK = 655 * MiB, WS_GV = 688 * MiB, WS_GG = 721 * MiB, WS_GB = 722 * MiB, WS_GO = 723 * MiB, WS_X2 = 756 * MiB, WS_X2B = 822 * MiB, WS_END = 856 * MiB;
constexpr int CW_BAR = 4096;
constexpr int RING_OFF = 0, RING_BYTES = 131072, LDSCTL_OFF = RING_BYTES, MISC_OFF = LDSCTL_OFF + 320, LDS_BYTES = 147456;

struct Args { const float* in[25]; float* out; unsigned char* ws; };

__device__ __forceinline__ float wave_sum(float v) {
#pragma unroll
    for (int o = 1; o < 64; o <<= 1) v += __shfl_xor(v, o);
    return v;
}
__device__ __forceinline__ float wave_max(float v) {
#pragma unroll
    for (int o = 1; o < 64; o <<= 1) v = fmaxf(v, __shfl_xor(v, o));
    return v;
}
__device__ __forceinline__ int t5_bucket(int n) {
    if (n < 16) return n;
    int b = 16;
    b += (n >= 22); b += (n >= 30); b += (n >= 40); b += (n >= 54); b += (n >= 73); b += (n >= 99); b += (n >= 134); b += (n >= 182);
    b += (n >= 246); b += (n >= 332); b += (n >= 450); b += (n >= 609); b += (n >= 825); b += (n >= 1117); b += (n >= 1513);
    return b;
}
__device__ __forceinline__ unsigned long long pk4(f32x4 v) { return (unsigned long long)pk2(v.x, v.y) | ((unsigned long long)pk2(v.z, v.w) << 32); }

__device__ __forceinline__ void p0_transpose_item(const float* W0, const float* W1, int K, int Nsrc, int Nd, int mode, bf16* WT, LAS float* scr, int item, int lane) {
    const int nblk = Nd / 32, kb = item / nblk, nb = item % nblk, k0 = 64 * kb, n0 = 32 * nb;
    const float* src = W0; int c0 = n0;
    if (mode == 1) { const int t = n0 / 256, w = n0 % 256; src = (w < 128) ? W0 : W1; c0 = t * 128 + (w & 127); }
    const bool okc = (c0 + (lane & 31)) < Nsrc;
#pragma unroll 8
    for (int i = 0; i < 32; ++i) { const int kk = 2 * i + (lane >> 5); scr[kk * 33 + (lane & 31)] = okc ? src[(size_t)(k0 + kk) * Nsrc + c0 + (lane & 31)] : 0.f; }
    LDS_WAIT(); asm volatile("" ::: "memory");
    const int c = lane & 7;
#pragma unroll
    for (int j = 0; j < 4; ++j) { const int n = (lane >> 3) + 8 * j; const LAS float* s = scr + (8 * c) * 33 + n;
        v4u o; o.x = pk2(s[0 * 33], s[1 * 33]); o.y = pk2(s[2 * 33], s[3 * 33]); o.z = pk2(s[4 * 33], s[5 * 33]); o.w = pk2(s[6 * 33], s[7 * 33]);
        *(GAS v4u*)(WT + (size_t)(n0 + n) * K + k0 + 8 * c) = o; }
    LDS_WAIT(); asm volatile("" ::: "memory");
}
__device__ __forceinline__ void p_transpose(const float* W0, const float* W1, int K, int Nsrc, int Nd, int mode, bf16* WT, LAS float* scr, int gw, int NGW, int lane) {
    const int nitems = (K / 64) * (Nd / 32);
    for (int it = gw; it < nitems; it += NGW) p0_transpose_item(W0, W1, K, Nsrc, Nd, mode, WT, scr, it, lane);
}
__device__ __forceinline__ void p_cvt_x(const float* xp, const float* xs, bf16* xb, int gw, int NGW, int lane) {
    for (int m = gw; m < M; m += NGW) { const float* s = (m < MP) ? xp + (size_t)m * DM : xs + (size_t)(m - MP) * DM;
#pragma unroll
        for (int j = 0; j < 4; ++j) { const f32x4 v = *(const f32x4*)(s + j * 256 + lane * 4); *(unsigned long long*)(xb + (size_t)m * DM + j * 256 + lane * 4) = pk4(v); } }
}
__device__ __forceinline__ void p_ln(const float* r0, const float* r1, const float* t, float s, const float* g, const float* b, float* o0, float* o1, bf16* ob, int gw, int NGW, int lane) {
    for (int m = gw; m < M; m += NGW) {
        const float* rr = (m < MP) ? r0 + (size_t)m * DM : r1 + (size_t)(m - MP) * DM;
        const float* tt = t + (size_t)m * DM;
        f32x4 v[4]; float sum = 0.f;
#pragma unroll
        for (int j = 0; j < 4; ++j) { const f32x4 a = *(const f32x4*)(rr + j * 256 + lane * 4), c = *(const f32x4*)(tt + j * 256 + lane * 4); v[j] = a * ALPHA + c * s; sum += (v[j].x + v[j].y) + (v[j].z + v[j].w); }
        const float mean = wave_sum(sum) * (1.f / DM); float s2 = 0.f;
#pragma unroll
        for (int j = 0; j < 4; ++j) { v[j] = v[j] - mean; s2 += (v[j].x * v[j].x + v[j].y * v[j].y) + (v[j].z * v[j].z + v[j].w * v[j].w); }
        const float rstd = 1.0f / sqrtf(wave_sum(s2) * (1.f / DM) + LN_EPS);
        float* oo = (m < MP) ? o0 + (size_t)m * DM : o1 + (size_t)(m - MP) * DM;
#pragma unroll
        for (int j = 0; j < 4; ++j) { const f32x4 gg = *(const f32x4*)(g + j * 256 + lane * 4), bb = *(const f32x4*)(b + j * 256 + lane * 4); const f32x4 y = v[j] * rstd * gg + bb;
            *(f32x4*)(oo + j * 256 + lane * 4) = y;
            if (ob) *(unsigned long long*)(ob + (size_t)m * DM + j * 256 + lane * 4) = pk4(y); }
    }
}
__device__ __forceinline__ void p_copy_out(const float* P, float* out, int gw, int NGW, int lane) {
    for (int m = gw; m < M; m += NGW) {
        const float* pr = P + (size_t)m * NINP;
        float* kd; float* vd;
        if (m < MP) { kd = out + O_KP + (size_t)m * AW; vd = out + O_VP + (size_t)m * AW; } else { kd = out + O_KS + (size_t)(m - MP) * AW; vd = out + O_VS + (size_t)(m - MP) * AW; }
#pragma unroll
        for (int j = 0; j < 2; ++j) { *(f32x4*)(kd + j * 256 + lane * 4) = *(const f32x4*)(pr + C_AK + j * 256 + lane * 4); *(f32x4*)(vd + j * 256 + lane * 4) = *(const f32x4*)(pr + C_AV + j * 256 + lane * 4); }
        float* sd = nullptr;
        if (m < MP) { const int b = m / SEQ, t = m % SEQ; if (t >= SEQ - 3) sd = out + O_SCP + ((size_t)b * 3 + (t - (SEQ - 3))) * 1536; }
        else { const int b = (m - MP) / DS, t = (m - MP) % DS; if (t >= 1) sd = out + O_SCS + ((size_t)b * 3 + (t - 1)) * 1536; }
        if (sd) {
#pragma unroll
            for (int j = 0; j < 6; ++j) *(f32x4*)(sd + j * 256 + lane * 4) = *(const f32x4*)(pr + C_GQKV + j * 256 + lane * 4); }
    }
}
__device__ __forceinline__ void p_attn_simple(const float* P, const float* ck, const float* cv, const float* relb, bf16* heads, LAS float* lds, int vcu, int G, int h, int lane) {
    LAS float* sq = lds + h * 64; LAS float* sp = lds + 8 * 64 + h * 392;
    for (int m = vcu; m < M; m += G) {
        const bool samp = m >= MP; int b, p;
        if (!samp) { b = m / SEQ; p = m % SEQ; } else { b = (m - MP) / DS; p = SEQ + (m - MP) % DS; }
        sq[lane] = P[(size_t)m * NINP + C_AQ + h * 64 + lane] * 0.125f;
        LDS_WAIT(); asm volatile("" ::: "memory");
        float lg[7]; float mx = -INFINITY;
#pragma unroll
        for (int i = 0; i < 7; ++i) {
            const int e = i * 64 + lane; float v = -INFINITY;
            if (e < 387) { const int g = e / 129, j = e % 129, dil = (g == 0) ? 1 : (g == 1 ? 4 : 16), delta = j * dil, pos = p - delta;
                if (pos >= 0) {
                    const float* kp;
                    if (!samp) kp = P + (size_t)(b * SEQ + pos) * NINP + C_AK + h * 64;
                    else if (pos >= SEQ) kp = P + (size_t)(MP + b * DS + (pos - SEQ)) * NINP + C_AK + h * 64;
                    else kp = ck + (((size_t)b * SEQ + pos) * NH + h) * HD;
                    float acc = 0.f;
#pragma unroll
                    for (int d = 0; d < 64; d += 4) { const f32x4 kv = *(const f32x4*)(kp + d); acc += kv.x * sq[d] + kv.y * sq[d + 1] + kv.z * sq[d + 2] + kv.w * sq[d + 3]; }
                    v = acc + relb[t5_bucket(delta) * NH + h]; } }
            lg[i] = v; mx = fmaxf(mx, v); }
        mx = wave_max(mx);
        float sum = 0.f;
#pragma unroll
        for (int i = 0; i < 7; ++i) { const int e = i * 64 + lane; const float pe = (lg[i] == -INFINITY) ? 0.f : __expf(lg[i] - mx); if (e < 387) sp[e] = pe; sum += pe; }
        sum = wave_sum(sum);
        LDS_WAIT(); asm volatile("" ::: "memory");
        float o = 0.f;
        for (int e = 0; e < 387; ++e) { const float pe = sp[e]; if (pe == 0.f) continue;
            const int g = e / 129, j = e % 129, dil = (g == 0) ? 1 : (g == 1 ? 4 : 16), pos = p - j * dil;
            const float* vp;
            if (!samp) vp = P + (size_t)(b * SEQ + pos) * NINP + C_AV + h * 64;
            else if (pos >= SEQ) vp = P + (size_t)(MP + b * DS + (pos - SEQ)) * NINP + C_AV + h * 64;
            else vp = cv + (((size_t)b * SEQ + pos) * NH + h) * HD;
            o += pe * vp[lane]; }
        heads[(size_t)m * DM + h * 64 + lane] = (bf16)f2bf(o / sum);
        LDS_WAIT(); asm volatile("" ::: "memory");
    }
}
__device__ __forceinline__ void p_gdn_prep(const float* P, const float* sconv, const float* convw, const float* alog, const float* dtb, float* GQ, float* GK, float* GV, float* GG, float* GB, int vcu, int G, int h, int lane) {
    for (int m = vcu; m < M; m += G) {
        const bool samp = m >= MP; int b, t;
        if (!samp) { b = m / SEQ; t = m % SEQ; } else { b = (m - MP) / DS; t = (m - MP) % DS; }
        float r[3];
#pragma unroll
        for (int part = 0; part < 3; ++part) {
            const int c = part * 512 + h * 64 + lane; float acc = 0.f;
#pragma unroll
            for (int j = 0; j < 4; ++j) { const int tt = t - 3 + j; float x;
                if (tt >= 0) x = P[(size_t)(m - t + tt) * NINP + C_GQKV + c]; else x = samp ? sconv[((size_t)b * 3 + (tt + 3)) * 1536 + c] : 0.f;
                acc += x * convw[j * 1536 + c]; }
            r[part] = acc / (1.0f + __expf(-acc)); }
        const float qn = wave_sum(r[0] * r[0]), kn = wave_sum(r[1] * r[1]);
        GQ[(size_t)m * GW + h * 64 + lane] = r[0] * (1.0f / sqrtf(qn + RMS_EPS)) * 0.125f;
        GK[(size_t)m * GW + h * 64 + lane] = r[1] * (1.0f / sqrtf(kn + RMS_EPS));
        GV[(size_t)m * GW + h * 64 + lane] = r[2];
        if (lane == 0) { const float bb = P[(size_t)m * NINP + C_B + h], aa = P[(size_t)m * NINP + C_A + h] + dtb[h];
            GB[(size_t)m * NH + h] = 1.0f / (1.0f + __expf(-bb));
            const float sp = (aa > 20.f) ? aa : log1pf(__expf(aa));
            GG[(size_t)m * NH + h] = -__expf(alog[h]) * sp; }
    }
}
__device__ __forceinline__ void gdn_scan_task(int task, const float* GQ, const float* GK, const float* GV, const float* GG, const float* GB, const float* s0, const float* P, const float* nw, bf16* heads, float* out, int lane) {
    const int seq = task / NH, h = task % NH;
    float S[64]; int row0, L; float* sdst;
    if (seq < NB) { row0 = seq * SEQ; L = SEQ; sdst = out + O_SGP + ((size_t)seq * NH + h) * 4096;
#pragma unroll
        for (int d = 0; d < 64; ++d) S[d] = 0.f; }
    else { const int b = seq - NB; row0 = MP + b * DS; L = DS; sdst = out + O_SGS + ((size_t)b * NH + h) * 4096; const float* sp = s0 + ((size_t)b * NH + h) * 4096;
#pragma unroll
        for (int d = 0; d < 64; ++d) S[d] = sp[d * 64 + lane]; }
    const float nwl = nw[lane];
    size_t o = (size_t)row0 * GW + h * 64 + lane;
    float qn = GQ[o], kn = GK[o], vn = GV[o], gn = GG[(size_t)row0 * NH + h], bn = GB[(size_t)row0 * NH + h], zn = P[(size_t)row0 * NINP + C_Z + h * 64 + lane];
    for (int t = 0; t < L; ++t) {
        const float qv = qn, kv = kn, vv = vn, eg = __expf(gn), beta = bn, z = zn; const int m = row0 + t;
        if (t + 1 < L) { o += GW; qn = GQ[o]; kn = GK[o]; vn = GV[o]; gn = GG[(size_t)(m + 1) * NH + h]; bn = GB[(size_t)(m + 1) * NH + h]; zn = P[(size_t)(m + 1) * NINP + C_Z + h * 64 + lane]; }
        float k0 = 0.f, k1 = 0.f, k2 = 0.f, k3 = 0.f;
#pragma unroll
        for (int d = 0; d < 64; d += 4) {
            k0 += __builtin_bit_cast(float, __builtin_amdgcn_readlane(__builtin_bit_cast(int, kv), d)) * S[d];
            k1 += __builtin_bit_cast(float, __builtin_amdgcn_readlane(__builtin_bit_cast(int, kv), d + 1)) * S[d + 1];
            k2 += __builtin_bit_cast(float, __builtin_amdgcn_readlane(__builtin_bit_cast(int, kv), d + 2)) * S[d + 2];
            k3 += __builtin_bit_cast(float, __builtin_amdgcn_readlane(__builtin_bit_cast(int, kv), d + 3)) * S[d + 3]; }
        const float ks = (k0 + k1) + (k2 + k3);
        const float c = beta * (vv - eg * ks);
        float o0 = 0.f, o1 = 0.f, o2 = 0.f, o3 = 0.f;
#pragma unroll
        for (int d = 0; d < 64; d += 4) {
#pragma unroll
            for (int e = 0; e < 4; ++e) { const float kd = __builtin_bit_cast(float, __builtin_amdgcn_readlane(__builtin_bit_cast(int, kv), d + e)); S[d + e] = fmaf(kd, c, eg * S[d + e]); }
            o0 += __builtin_bit_cast(float, __builtin_amdgcn_readlane(__builtin_bit_cast(int, qv), d)) * S[d];
            o1 += __builtin_bit_cast(float, __builtin_amdgcn_readlane(__builtin_bit_cast(int, qv), d + 1)) * S[d + 1];
            o2 += __builtin_bit_cast(float, __builtin_amdgcn_readlane(__builtin_bit_cast(int, qv), d + 2)) * S[d + 2];
            o3 += __builtin_bit_cast(float, __builtin_amdgcn_readlane(__builtin_bit_cast(int, qv), d + 3)) * S[d + 3]; }
        const float ov = (o0 + o1) + (o2 + o3);
        const float ms = wave_sum(ov * ov) * (1.f / 64.f);
        const float y = ov * (1.0f / sqrtf(ms + RMS_EPS)) * nwl * (z / (1.0f + __expf(-z)));
        heads[(size_t)m * DM + AW + h * 64 + lane] = (bf16)f2bf(y);
    }
#pragma unroll
    for (int d = 0; d < 64; ++d) sdst[d * 64 + lane] = S[d];
}

__global__ void __launch_bounds__(NWAVES * 64, 2) mega_fwd(Args args) {
    extern __shared__ __attribute__((aligned(16))) unsigned char lds[];
    LAS unsigned char* L = (LAS unsigned char*)lds;
    volatile LAS unsigned* MISC = (volatile LAS unsigned*)(L + MISC_OFF);
    const int tid = threadIdx.x, lane = tid & 63, wave = __builtin_amdgcn_readfirstlane(tid >> 6);
    const int G = gridDim.x; const int bx = blockIdx.x; const int vcu = (G % 8 == 0) ? (bx % 8) * (G / 8) + bx / 8 : bx;
    unsigned char* ws = args.ws; float* out = args.out;
    gu32* ctl = (gu32*)(ws + WS_CTL);
    for (int u = tid; u < (LDS_BYTES - LDSCTL_OFF) / 4; u += NWAVES * 64) ((LAS unsigned*)(L + LDSCTL_OFF))[u] = 0u;
    __syncthreads();
    XcdBarrier bar = xcd_barrier_post((unsigned*)(ctl + CW_BAR), MISC + 8);
#define GRID_BAR() xcd_barrier(bar)
    const float* const* in = args.in;
    bf16 *Wgu1 = (bf16*)(ws + WS_WGU1), *Wd1 = (bf16*)(ws + WS_WD1), *Win = (bf16*)(ws + WS_WIN), *Wout = (bf16*)(ws + WS_WOUT), *Wgu2 = (bf16*)(ws + WS_WGU2), *Wd2 = (bf16*)(ws + WS_WD2);
    bf16 *XB = (bf16*)(ws + WS_XB), *H = (bf16*)(ws + WS_H), *X1B = (bf16*)(ws + WS_X1B), *HEADS = (bf16*)(ws + WS_HEADS), *X2B = (bf16*)(ws + WS_X2B);
    float *T = (float*)(ws + WS_T), *X1 = (float*)(ws + WS_X1), *P = (float*)(ws + WS_P), *GQ = (float*)(ws + WS_GQ), *GK = (float*)(ws + WS_GK), *GV = (float*)(ws + WS_GV), *GG = (float*)(ws + WS_GG), *GB = (float*)(ws + WS_GB), *X2 = (float*)(ws + WS_X2);
    const int gw = vcu * NWAVES + wave, NGW = G * NWAVES;

    {   LAS float* scr = (LAS float*)(L + RING_OFF + wave * 16384);
        p_transpose(in[9], in[10], DM, FF, NGU, 1, Wgu1, scr, gw, NGW, lane);
        p_transpose(in[11], nullptr, FF, DM, DM, 0, Wd1, scr, gw, NGW, lane);
        p_transpose(in[12], nullptr, DM, NIN, NINP, 0, Win, scr, gw, NGW, lane);
        p_transpose(in[13], nullptr, DM, DM, DM, 0, Wout, scr, gw, NGW, lane);
        p_transpose(in[20], in[21], DM, FF, NGU, 1, Wgu2, scr, gw, NGW, lane);
        p_transpose(in[22], nullptr, FF, DM, DM, 0, Wd2, scr, gw, NGW, lane);
        p_cvt_x(in[0], in[1], XB, gw, NGW, lane);
        GRID_BAR(); }
    {   pg8::Gemm g{XB, Wgu1, M, NGU, DM, 0}; pg8::StaticOrder S; S.init(M, NGU, G, bx); pg8::EpiSwiGLU E{H, FF, 0};
        pg8::gemm_phase<pg8::EpiSwiGLU, pg8::StaticOrder, true, true>(L + RING_OFF, g, S, E); GRID_BAR(); }
    {   pg8::Gemm g{H, Wd1, M, DM, FF, 0}; pg8::StaticOrder S; S.init(M, DM, G, bx); pg8::EpiF32 E{T, DM, 0};
        pg8::gemm_phase<pg8::EpiF32, pg8::StaticOrder, true, true>(L + RING_OFF, g, S, E); GRID_BAR(); }
    p_ln(in[0], in[1], T, 0.5f, in[7], in[8], X1, X1 + (size_t)MP * DM, X1B, gw, NGW, lane); GRID_BAR();
    {   pg8::Gemm g{X1B, Win, M, NINP, DM, 0}; pg8::StaticOrder S; S.init(M, NINP, G, bx); pg8::EpiF32 E{P, NINP, 0};
        pg8::gemm_phase<pg8::EpiF32, pg8::StaticOrder, true, true>(L + RING_OFF, g, S, E); GRID_BAR(); }
    p_copy_out(P, out, gw, NGW, lane);
    p_attn_simple(P, in[2], in[3], in[6], HEADS, (LAS float*)(L + RING_OFF), vcu, G, wave, lane);
    p_gdn_prep(P, in[5], in[14], in[15], in[16], GQ, GK, GV, GG, GB, vcu, G, wave, lane);
    GRID_BAR();
    for (int task = wave * G + bx; task < (NB + DB) * NH; task += NGW) gdn_scan_task(task, GQ, GK, GV, GG, GB, in[4], P, in[17], HEADS, out, lane);
    GRID_BAR();
    {   pg8::Gemm g{HEADS, Wout, M, DM, DM, 0}; pg8::StaticOrder S; S.init(M, DM, G, bx); pg8::EpiF32 E{T, DM, 0};
        pg8::gemm_phase<pg8::EpiF32, pg8::StaticOrder, true, true>(L + RING_OFF, g, S, E); GRID_BAR(); }
    p_ln(X1, X1 + (size_t)MP * DM, T, 1.0f, in[18], in[19], X2, X2 + (size_t)MP * DM, X2B, gw, NGW, lane); GRID_BAR();
    {   pg8::Gemm g{X2B, Wgu2, M, NGU, DM, 0}; pg8::StaticOrder S; S.init(M, NGU, G, bx); pg8::EpiSwiGLU E{H, FF, 0};
        pg8::gemm_phase<pg8::EpiSwiGLU, pg8::StaticOrder, true, true>(L + RING_OFF, g, S, E); GRID_BAR(); }
    {   pg8::Gemm g{H, Wd2, M, DM, FF, 0}; pg8::StaticOrder S; S.init(M, DM, G, bx); pg8::EpiF32 E{T, DM, 0};
        pg8::gemm_phase<pg8::EpiF32, pg8::StaticOrder, true, true>(L + RING_OFF, g, S, E); GRID_BAR(); }
    p_ln(X2, X2 + (size_t)MP * DM, T, 0.5f, in[23], in[24], out + O_YP, out + O_YS, nullptr, gw, NGW, lane);
}

extern "C" void kernel_launch(void* const* d_in, const int* in_sizes, int n_in, void* d_out, int out_size, void* d_ws, size_t ws_size, hipStream_t stream) {
    static int grid = 0;
    if (grid == 0) {
        if (n_in != 25 || out_size != (int)O_END || ws_size < WS_END) { fprintf(stderr, "kernel_launch: unexpected shapes (n_in %d out %d ws %zu)\n", n_in, out_size, ws_size); grid = -1; return; }
        int dev = 0, cus = 0, per_cu = 0;
        if (hipGetDevice(&dev) != hipSuccess || hipDeviceGetAttribute(&cus, hipDeviceAttributeMultiprocessorCount, dev) != hipSuccess) { grid = -1; return; }
        if (hipFuncSetAttribute((const void*)mega_fwd, hipFuncAttributeMaxDynamicSharedMemorySize, LDS_BYTES) != hipSuccess) { fprintf(stderr, "kernel_launch: hipFuncSetAttribute failed\n"); grid = -1; return; }
        if (hipOccupancyMaxActiveBlocksPerMultiprocessor(&per_cu, (const void*)mega_fwd, NWAVES * 64, LDS_BYTES) != hipSuccess || per_cu < 1) { fprintf(stderr, "kernel_launch: occupancy query reports %d\n", per_cu); }
        (void)hipGetLastError();
        grid = cus;
    }
    if (grid < 0) return;
    if (hipMemsetAsync((char*)d_ws + WS_CTL, 0, CTL_ZERO_BYTES, stream) != hipSuccess) return;
    Args a; memset(&a, 0, sizeof(a));
    for (int i = 0; i < 25; ++i) a.in[i] = (const float*)d_in[i];
    a.out = (float*)d_out; a.ws = (unsigned char*)d_ws;
    hipLaunchKernelGGL(mega_fwd, dim3(grid), dim3(NWAVES * 64), LDS_BYTES, stream, a);
}
```

```cpp
#include <hip/hip_runtime.h>
#include <cstdio>
#include <cstdint>
#include <cstring>
#include <cmath>
namespace pg8 {
#define PG8_LAS __attribute__((address_space(3)))
typedef unsigned short bf16_t;
typedef short bf16x8 __attribute__((ext_vector_type(8)));
typedef float f32x4 __attribute__((ext_vector_type(4)));
typedef unsigned u32x4 __attribute__((ext_vector_type(4)));
constexpr int BM = 256, BK = 64, HALF = 128, HTB = HALF * BK * 2  , STAGE_BYTES = 8 * HTB, NXCD = 8, WGM = 8;

__host__ __device__ __forceinline__ int lds_byte(int r, int c) { const int st = (r >> 4) * 2 + (c >> 5), rr = r & 15, cc = c & 31, ob = rr * 64 + cc * 2; return st * 1024 + (ob ^ (((ob >> 9) & 1) << 5)); }
__host__ __device__ __forceinline__ void stage_rc(int b, int& R, int& C) { const int st = b / 1024, sb = b % 1024, swz = sb ^ (((sb >> 9) & 1) << 5); R = (st >> 1) * 16 + swz / 64; C = (st & 1) * 32 + (swz % 64) / 2; }
__host__ __device__ __forceinline__ int perm32(int rho) { const int n = rho >> 4, i = rho & 15; return 8 * (i >> 2) + 4 * n + (i & 3); }

struct Unit { int pm, pn; };
struct Gemm { const bf16_t* A; const bf16_t* Bt; int M, N, K, pad; };

struct StaticOrder {
    int nM, nN, nwg, G, c;
    __host__ __device__ void init(int M, int N, int G_, int c_) { nM = M / BM; nN = N / BM; nwg = nM * nN; G = G_; c = c_; }
    __host__ __device__ bool next(int i, Unit& u) const {
        const long L = (long)i * G + c; if (L >= nwg) return false;
        int wgid = (int)L; { const int q = nwg / NXCD, r = nwg % NXCD, xcd = wgid % NXCD, off = wgid / NXCD; wgid = (xcd < r ? xcd * (q + 1) : r * (q + 1) + (xcd - r) * q) + off; }
        const int nig = WGM * nN, gid = wgid / nig, fm = gid * WGM, gsz = (nM - fm) < WGM ? (nM - fm) : WGM;
        u.pm = fm + ((wgid % nig) % gsz); u.pn = (wgid % nig) / gsz; return true;
    }
    __device__ __forceinline__ void a_ready(const Unit&) const {}
    __device__ __forceinline__ void done(const Unit&) const {}
};

__device__ __forceinline__ unsigned cvt_pk_bf16(float lo, float hi) { unsigned r; asm volatile("v_cvt_pk_bf16_f32 %0, %1, %2" : "=v"(r) : "v"(lo), "v"(hi)); return r; }
typedef float f32x2 __attribute__((ext_vector_type(2)));
struct EpiF32 {
    static constexpr bool PERM = false, AFTER_DRAIN = false;
    float* C; int ldc, pad;
    __device__ __forceinline__ void operator()(const f32x4 (&acc)[2][2][4][2], const Unit& u, int wr, int wc, int fr, int fq) const {
        const int row0 = u.pm * BM + wr * 64 + fr, col0 = u.pn * BM + wc * 32 + 4 * fq;
#pragma unroll
        for (int ai = 0; ai < 2; ++ai)
#pragma unroll
            for (int m = 0; m < 4; ++m) { float* rowp = C + (size_t)(row0 + ai * HALF + m * 16) * ldc + col0;
#pragma unroll
                for (int bj = 0; bj < 2; ++bj)
#pragma unroll
                    for (int n = 0; n < 2; ++n) *(f32x4*)(rowp + bj * HALF + n * 16) = acc[ai][bj][m][n]; }
    }
};
__device__ __forceinline__ float silu_f(float x) { return x * __builtin_amdgcn_rcpf(1.0f + __builtin_amdgcn_exp2f(-1.4426950408889634f * x)); }
struct EpiSwiGLU {
    static constexpr bool PERM = true, AFTER_DRAIN = false;
    bf16_t* H; int ldc, pad;
    __device__ __forceinline__ void operator()(const f32x4 (&acc)[2][2][4][2], const Unit& u, int wr, int wc, int fr, int fq) const {
        const int row0 = u.pm * BM + wr * 64 + fr, col0 = u.pn * HALF + wc * 32 + 8 * fq;
#pragma unroll
        for (int ai = 0; ai < 2; ++ai)
#pragma unroll
            for (int m = 0; m < 4; ++m) { bf16_t* rowp = H + (size_t)(row0 + ai * HALF + m * 16) * ldc + col0;
                const f32x4 g0 = acc[ai][0][m][0], g1 = acc[ai][0][m][1], u0 = acc[ai][1][m][0], u1 = acc[ai][1][m][1];
                u32x4 w;
                w.x = cvt_pk_bf16(silu_f(g0[0]) * u0[0], silu_f(g0[1]) * u0[1]); w.y = cvt_pk_bf16(silu_f(g0[2]) * u0[2], silu_f(g0[3]) * u0[3]);
                w.z = cvt_pk_bf16(silu_f(g1[0]) * u1[0], silu_f(g1[1]) * u1[1]); w.w = cvt_pk_bf16(silu_f(g1[2]) * u1[2], silu_f(g1[3]) * u1[3]);
                *(u32x4*)rowp = w; }
    }
};
template <class Epi, class Sched, bool ALIGN_EPI = false, bool SP2 = false>
__device__ __forceinline__ void gemm_phase(PG8_LAS unsigned char* lds, const Gemm g, const Sched& S, const Epi& E) {
    int tid_l = threadIdx.x; asm volatile("" : "+v"(tid_l));
    const int tid = tid_l, wid = __builtin_amdgcn_readfirstlane(tid >> 6), lane = tid & 63, wr = wid >> 2, wc = wid & 3, fr = lane & 15, fq = lane >> 4;
    const int K = g.K, nt = K / BK;
    unsigned voffA[2], voffB[2];
#pragma unroll
    for (int i = 0; i < 2; ++i) { int R, C; stage_rc(tid * 16 + i * 8192, R, C); const int Rb = Epi::PERM ? ((R & ~31) + perm32(R & 31)) : R;
        voffA[i] = (unsigned)(R * K + C) * 2u; voffB[i] = (unsigned)(Rb * K + C) * 2u; }
    const size_t kstep = (size_t)(BK * 2);
    const size_t hstep = (size_t)HALF * K * 2;
    const size_t tstep = 2 * hstep;
    const unsigned ldsw = (unsigned)wid * 1024u;
    const int aoff = lds_byte(wr * 64 + fr, fq * 8), boff = lds_byte(wc * 32 + fr, fq * 8);
#define PG8_SA(b, h) (((b) * 2 + (h)) * HTB)
#define PG8_SB(b, h) ((4 + (b) * 2 + (h)) * HTB)
#define PG8_STAGE(bufoff, gbase, voff) do { _Pragma("unroll") for (int _i = 0; _i < 2; ++_i) \
        __builtin_amdgcn_global_load_lds((const unsigned*)((const char*)(gbase) + (voff)[_i]), (PG8_LAS unsigned*)(lds + (bufoff) + ldsw + _i * 8192), 16, 0, 0); } while (0)
#define PG8_LDA(dst, b, h) do { _Pragma("unroll") for (int m = 0; m < 4; ++m) _Pragma("unroll") for (int k = 0; k < 2; ++k) dst[m][k] = *(const PG8_LAS bf16x8*)(lds + PG8_SA(b, h) + aoff + m * 2048 + k * 1024); } while (0)
#define PG8_LDB(dst, b, h) do { _Pragma("unroll") for (int n = 0; n < 2; ++n) _Pragma("unroll") for (int k = 0; k < 2; ++k) dst[n][k] = *(const PG8_LAS bf16x8*)(lds + PG8_SB(b, h) + boff + n * 2048 + k * 1024); } while (0)
#define PG8_MMA(ai, bj, At, Bt) do { __builtin_amdgcn_s_setprio(1); _Pragma("unroll") for (int m = 0; m < 4; ++m) _Pragma("unroll") for (int n = 0; n < 2; ++n) _Pragma("unroll") for (int k = 0; k < 2; ++k) \
        acc[ai][bj][m][n] = __builtin_amdgcn_mfma_f32_16x16x32_bf16(Bt[n][k], At[m][k], acc[ai][bj][m][n], 0, 0, 0); __builtin_amdgcn_s_setprio(0); } while (0)
#define PG8_WAIT_V(n) asm volatile("s_waitcnt vmcnt(" #n ")" ::: "memory")
#define PG8_WAIT_L(n) asm volatile("s_waitcnt lgkmcnt(" #n ")" ::: "memory")
#define PG8_BAR __builtin_amdgcn_s_barrier()
#define PG8_SCHED __builtin_amdgcn_sched_barrier(0)
    Unit cur, nxt; int ui = 0;
    if (!S.next(0, cur)) return;
    f32x4 acc[2][2][4][2];
#pragma unroll
    for (int a = 0; a < 2; ++a)
#pragma unroll
        for (int b = 0; b < 2; ++b)
#pragma unroll
            for (int m = 0; m < 4; ++m)
#pragma unroll
                for (int n = 0; n < 2; ++n) acc[a][b][m][n] = (f32x4){0.f, 0.f, 0.f, 0.f};
    bf16x8 At[4][2], B0[2][2], B1[2][2];
    const char* cA = (const char*)g.A + (size_t)cur.pm * tstep; const char* cB = (const char*)g.Bt + (size_t)cur.pn * tstep;
    S.a_ready(cur);
    if constexpr (SP2) {
        PG8_STAGE(PG8_SB(0, 0), cB, voffB); PG8_STAGE(PG8_SB(0, 1), cB + hstep, voffB); PG8_STAGE(PG8_SA(0, 0), cA, voffA); PG8_STAGE(PG8_SA(0, 1), cA + hstep, voffA);
        if (wr == 1) PG8_BAR;
        PG8_WAIT_V(2); PG8_BAR;
        PG8_STAGE(PG8_SB(1, 0), cB + kstep, voffB); PG8_STAGE(PG8_SA(1, 0), cA + kstep, voffA); PG8_STAGE(PG8_SB(1, 1), cB + hstep + kstep, voffB);
        PG8_WAIT_V(6); PG8_BAR;
    } else {
        PG8_STAGE(PG8_SB(0, 0), cB, voffB); PG8_STAGE(PG8_SA(0, 0), cA, voffA); PG8_STAGE(PG8_SB(0, 1), cB + hstep, voffB); PG8_STAGE(PG8_SA(0, 1), cA + hstep, voffA);
        if (wr == 1) PG8_BAR;
        PG8_WAIT_V(4); PG8_BAR;
        PG8_STAGE(PG8_SB(1, 0), cB + kstep, voffB); PG8_STAGE(PG8_SA(1, 0), cA + kstep, voffA); PG8_STAGE(PG8_SB(1, 1), cB + hstep + kstep, voffB);
        PG8_WAIT_V(6); PG8_BAR;
    }
    for (;;) {
        const bool has_next = S.next(ui + 1, nxt);
        const char* nA = has_next ? (const char*)g.A + (size_t)nxt.pm * tstep : cA; const char* nB = has_next ? (const char*)g.Bt + (size_t)nxt.pn * tstep : cB;
        for (int t = 0; t < nt; t += 2) {
            const bool last = (t == nt - 2);
            const char* a1 = cA + (size_t)(t + 1) * kstep;
            const char* a2 = last ? nA : cA + (size_t)(t + 2) * kstep; const char* b2 = last ? nB : cB + (size_t)(t + 2) * kstep;
            const char* a3 = a2 + kstep; const char* b3 = b2 + kstep;
            if (last && has_next) S.a_ready(nxt);
            if constexpr (SP2) {
            PG8_LDB(B0, 0, 0); PG8_LDB(B1, 0, 1); PG8_SCHED; PG8_LDA(At, 0, 0); PG8_STAGE(PG8_SA(1, 1), a1 + hstep, voffA);
            PG8_WAIT_V(8); PG8_WAIT_L(0); PG8_BAR; PG8_MMA(0, 0, At, B0); PG8_MMA(0, 1, At, B1); PG8_BAR; PG8_SCHED;
            PG8_LDA(At, 0, 1); PG8_STAGE(PG8_SB(0, 0), b2, voffB); PG8_STAGE(PG8_SB(0, 1), b2 + hstep, voffB); PG8_STAGE(PG8_SA(0, 0), a2, voffA);
            PG8_WAIT_V(8); PG8_WAIT_L(0); PG8_BAR; PG8_MMA(1, 0, At, B0); PG8_MMA(1, 1, At, B1); PG8_BAR; PG8_SCHED;
            PG8_LDB(B0, 1, 0); PG8_LDB(B1, 1, 1); PG8_SCHED; PG8_LDA(At, 1, 0); PG8_STAGE(PG8_SA(0, 1), a2 + hstep, voffA);
            PG8_WAIT_V(8); PG8_WAIT_L(0); PG8_BAR; PG8_MMA(0, 0, At, B0); PG8_MMA(0, 1, At, B1); PG8_BAR; PG8_SCHED;
            PG8_LDA(At, 1, 1); PG8_STAGE(PG8_SB(1, 0), b3, voffB); PG8_STAGE(PG8_SB(1, 1), b3 + hstep, voffB); PG8_STAGE(PG8_SA(1, 0), a3, voffA);
            PG8_WAIT_V(8); PG8_WAIT_L(0); PG8_BAR; PG8_MMA(1, 0, At, B0); PG8_MMA(1, 1, At, B1); PG8_BAR; PG8_SCHED;
            } else {
            PG8_LDB(B0, 0, 0); PG8_SCHED; PG8_LDA(At, 0, 0); PG8_STAGE(PG8_SA(1, 1), a1 + hstep, voffA);
            PG8_WAIT_L(8); PG8_BAR; PG8_WAIT_L(0); PG8_MMA(0, 0, At, B0); PG8_BAR; PG8_SCHED;
            PG8_LDB(B1, 0, 1); PG8_STAGE(PG8_SB(0, 0), b2, voffB);
            PG8_BAR; PG8_WAIT_L(0); PG8_MMA(0, 1, At, B1); PG8_BAR;
            PG8_LDA(At, 0, 1); PG8_STAGE(PG8_SA(0, 0), a2, voffA);
            PG8_BAR; PG8_WAIT_L(0); PG8_MMA(1, 0, At, B0); PG8_BAR; PG8_SCHED;
            PG8_STAGE(PG8_SB(0, 1), b2 + hstep, voffB);
            PG8_WAIT_V(6); PG8_BAR; PG8_MMA(1, 1, At, B1); PG8_BAR;
            PG8_LDB(B0, 1, 0); PG8_SCHED; PG8_LDA(At, 1, 0); PG8_STAGE(PG8_SA(0, 1), a2 + hstep, voffA);
            PG8_WAIT_L(8); PG8_BAR; PG8_WAIT_L(0); PG8_MMA(0, 0, At, B0); PG8_BAR; PG8_SCHED;
            PG8_LDB(B1, 1, 1); PG8_STAGE(PG8_SB(1, 0), b3, voffB);
            PG8_BAR; PG8_WAIT_L(0); PG8_MMA(0, 1, At, B1); PG8_BAR;
            PG8_LDA(At, 1, 1); PG8_STAGE(PG8_SA(1, 0), a3, voffA);
            PG8_BAR; PG8_WAIT_L(0); PG8_MMA(1, 0, At, B0); PG8_BAR; PG8_SCHED;
            PG8_STAGE(PG8_SB(1, 1), b3 + hstep, voffB);
            PG8_WAIT_V(6); PG8_BAR; PG8_MMA(1, 1, At, B1); PG8_BAR;
            }
        }
        if constexpr (ALIGN_EPI) { if (wr == 0) PG8_BAR; }
        if constexpr (!Epi::AFTER_DRAIN) { E(acc, cur, wr, wc, fr, fq); S.done(cur); }
        if (!has_next) break;
#pragma unroll
        for (int a = 0; a < 2; ++a)
#pragma unroll
            for (int b = 0; b < 2; ++b)
#pragma unroll
                for (int m = 0; m < 4; ++m)
#pragma unroll
                    for (int n = 0; n < 2; ++n) acc[a][b][m][n] = (f32x4){0.f, 0.f, 0.f, 0.f};
        cur = nxt; cA = nA; cB = nB; ++ui;
        if constexpr (ALIGN_EPI) { if (wr == 1) PG8_BAR; }
    }
    PG8_WAIT_V(0);
    if constexpr (!ALIGN_EPI) { if (wr == 0) PG8_BAR; }
    PG8_BAR;
    if constexpr (Epi::AFTER_DRAIN) { E.fused(acc, cur, wr, wc, fr, fq, lds, wid, lane); S.done(cur); }
#undef PG8_SA
#undef PG8_SB
#undef PG8_STAGE
#undef PG8_LDA
#undef PG8_LDB
#undef PG8_MMA
#undef PG8_WAIT_V
#undef PG8_WAIT_L
#undef PG8_BAR
#undef PG8_SCHED
}
}
#include <hip/hip_bf16.h>
#include <cmath>
namespace attn_body {
using bf16=__hip_bfloat16;
using bf16x8=__attribute__((ext_vector_type(8)))short;
using s16x4=__attribute__((ext_vector_type(4)))short;
using f32x16=__attribute__((ext_vector_type(16)))float;
using u32x4=__attribute__((ext_vector_type(4)))unsigned;
constexpr int BATCH=8,NHEAD=8,SEQ=2048,D=64,DM=NHEAD*D,OPITCH=1024,BT_OFF=256,BT_N=2304;
constexpr int NW=8,QBLK=32,QB=QBLK*NW,KVBLK=64,NQB=SEQ/QB;
constexpr int ATTN_PITCH=DM, ATTN_UNIT_ROWS=QB;
__device__ __forceinline__ int crow(int r,int hi){return (r&3)+8*(r>>2)+4*hi;}
#define SBAR() __builtin_amdgcn_sched_barrier(0)
__device__ __forceinline__ void cmask(f32x16&p0,f32x16&p1,int jb,int qrel,int hi){
  const float NEG=-INFINITY; int kb=64*jb+4*hi;
  #pragma unroll
  for(int r=0;r<16;++r){int kv=kb+(r&3)+8*(r>>2); if(kv>qrel)p0[r]=NEG; if(kv+32>qrel)p1[r]=NEG;}
}

constexpr int NSLOT=3, SLOTB=8192;
constexpr int LDS_K=0, LDS_V=NSLOT*SLOTB, LDS_WS=2*NSLOT*SLOTB, LDS_OST=LDS_WS+NW*64*4, LDS_BYTES=LDS_OST+NW*4096;
constexpr float C2=0.125f*1.4426950408889634f;
__device__ __forceinline__ void glds16(const void*gsrc,unsigned lds_dst){unsigned keep;
  asm volatile("s_mov_b32 %0, m0\n\ts_mov_b32 m0, %2\n\ts_nop 0\n\tglobal_load_lds_dwordx4 %1, off\n\ts_mov_b32 m0, %0":"=&s"(keep):"v"(gsrc),"s"(lds_dst):"memory");}
__device__ __forceinline__ float max3f(float a,float b,float c){float r;asm("v_max3_f32 %0, %1, %2, %3":"=v"(r):"v"(a),"v"(b),"v"(c));return r;}
__device__ __forceinline__ float max2f(float a,float b){float r;asm("v_max_f32_e32 %0, %1, %2":"=v"(r):"v"(a),"v"(b));return r;}
__device__ __forceinline__ float fadd_s(float a,float b){float r;asm("v_add_f32_e32 %0, %1, %2":"=v"(r):"v"(a),"v"(b));return r;}
__device__ __forceinline__ float fsub_s(float a,float b){float r;asm("v_sub_f32_e32 %0, %1, %2":"=v"(r):"v"(a),"v"(b));return r;}
typedef float f32x2_t __attribute__((ext_vector_type(2))); typedef __bf16 bf16x2_t __attribute__((ext_vector_type(2)));
__device__ __forceinline__ unsigned cvtpk_s(float lo,float hi){f32x2_t v={lo,hi};bf16x2_t b=__builtin_convertvector(v,bf16x2_t);return __builtin_bit_cast(unsigned,b);}
#define WAIT_BAR(N) asm volatile("s_waitcnt vmcnt(" #N ") lgkmcnt(0)\n\ts_barrier":::"memory")

__device__ __forceinline__ void qkt(f32x16&p0,f32x16&p1,const char*Kslot,const bf16x8*qr,const f32x16&negm,int r32,int hi){
  const char*kb=Kslot+hi*1024+r32*16;
  #pragma unroll
  for(int d0=0;d0<4;++d0){
    const bf16x8 b0=*reinterpret_cast<const bf16x8*>(kb+d0*2048);
    const bf16x8 b1=*reinterpret_cast<const bf16x8*>(kb+d0*2048+512);
    if(d0==0){p0=__builtin_amdgcn_mfma_f32_32x32x16_bf16(b0,qr[0],negm,0,0,0);p1=__builtin_amdgcn_mfma_f32_32x32x16_bf16(b1,qr[0],negm,0,0,0);}
    else{p0=__builtin_amdgcn_mfma_f32_32x32x16_bf16(b0,qr[d0],p0,0,0,0);p1=__builtin_amdgcn_mfma_f32_32x32x16_bf16(b1,qr[d0],p1,0,0,0);}}
}
typedef __attribute__((address_space(3))) const char* lds_cptr;
typedef short v4i16_t __attribute__((ext_vector_type(4)));
__device__ __forceinline__ void kload8(bf16x8*kf,lds_cptr kp){
  kf[0]=*(const __attribute__((address_space(3))) bf16x8*)(kp);      kf[1]=*(const __attribute__((address_space(3))) bf16x8*)(kp+512);
  kf[2]=*(const __attribute__((address_space(3))) bf16x8*)(kp+2048); kf[3]=*(const __attribute__((address_space(3))) bf16x8*)(kp+2560);
  kf[4]=*(const __attribute__((address_space(3))) bf16x8*)(kp+4096); kf[5]=*(const __attribute__((address_space(3))) bf16x8*)(kp+4608);
  kf[6]=*(const __attribute__((address_space(3))) bf16x8*)(kp+6144); kf[7]=*(const __attribute__((address_space(3))) bf16x8*)(kp+6656);
}
__device__ __forceinline__ void kload2(bf16x8*kf,lds_cptr kp,int j){ kf[2*j]=*(const __attribute__((address_space(3))) bf16x8*)(kp+j*2048); kf[2*j+1]=*(const __attribute__((address_space(3))) bf16x8*)(kp+j*2048+512); }
__device__ __forceinline__ s16x4 vtr(lds_cptr p){ return __builtin_bit_cast(s16x4,__builtin_amdgcn_ds_read_tr16_b64_v4i16((__attribute__((address_space(3))) v4i16_t*)p)); }
__device__ __forceinline__ float rowmax(const f32x16&p0,const f32x16&p1){
  float a=max3f(p0[0],p0[1],p1[0]),b=max3f(p0[2],p0[3],p1[1]);a=max3f(a,p1[2],p1[3]);
  #pragma unroll
  for(int r=4;r<16;r+=4){a=max3f(a,p0[r],p0[r+1]);b=max3f(b,p0[r+2],p0[r+3]);a=max3f(a,p1[r],p1[r+1]);b=max3f(b,p1[r+2],p1[r+3]);}
  const float m=max2f(a,b);
  auto rr=__builtin_amdgcn_permlane32_swap(__float_as_uint(m),__float_as_uint(m),false,false);
  return max2f(__uint_as_float(rr[0]),__uint_as_float(rr[1]));
}
__device__ __forceinline__ void pv(f32x16*o,int vb,bf16x8 pa0,bf16x8 pa1,bf16x8 pa2,bf16x8 pa3){
  #pragma unroll
  for(int d0=0;d0<2;++d0){s16x4 lo[4],hi[4];
    #pragma unroll
    for(int ks=0;ks<4;++ks){
      asm volatile("ds_read_b64_tr_b16 %0,%1 offset:%c2":"=&v"(lo[ks]):"v"(vb),"i"(d0*4096+ks*1024):"memory");
      asm volatile("ds_read_b64_tr_b16 %0,%1 offset:%c2":"=&v"(hi[ks]):"v"(vb),"i"(d0*4096+ks*1024+512):"memory");}
    asm volatile("s_waitcnt lgkmcnt(0)":::"memory");SBAR();
    #define PK(k) (bf16x8){lo[k][0],lo[k][1],lo[k][2],lo[k][3],hi[k][0],hi[k][1],hi[k][2],hi[k][3]}
    o[d0]=__builtin_amdgcn_mfma_f32_32x32x16_bf16(pa0,PK(0),o[d0],0,0,0);
    o[d0]=__builtin_amdgcn_mfma_f32_32x32x16_bf16(pa1,PK(1),o[d0],0,0,0);
    o[d0]=__builtin_amdgcn_mfma_f32_32x32x16_bf16(pa2,PK(2),o[d0],0,0,0);
    o[d0]=__builtin_amdgcn_mfma_f32_32x32x16_bf16(pa3,PK(3),o[d0],0,0,0);
    #undef PK
  }
}

#ifndef ATTN_STORE16
#define ATTN_STORE16(p,v) (*(u32x4*)(p)=(v))
#endif
template<int THRL> __device__ __forceinline__ void attn_unit(int b,int h,int qb,const bf16*Q,const bf16*__restrict__ K,const bf16*__restrict__ V,bf16*O,char*shm,const __attribute__((address_space(3))) float* btab){
  int tid_l=threadIdx.x; asm volatile("":"+v"(tid_l)); const int tid=tid_l,lane=tid&63,r32=lane&31,hi=lane>>5; const int wid=__builtin_amdgcn_readfirstlane(tid>>6);
  const long rowbase=(long)b*SEQ; const int q0=qb*QB;
  const bf16*Qw=Q+(rowbase+q0+wid*QBLK)*DM+h*D;
  const bf16*Kh=K+rowbase*DM+h*D,*Vh=V+rowbase*DM+h*D;
  const unsigned lds0=(unsigned)(uintptr_t)shm;
  float*wsf=(float*)(shm+LDS_WS)+wid*64;
  const bf16*ksrc=Kh+(long)lane*DM+wid*8;
  const bf16*vsrc=Vh+(long)(16*(wid&3)+(lane>>2))*DM+(wid>>2)*32+(lane&3)*8;
  const unsigned kdst=lds0+LDS_K+wid*1024, vdst=lds0+LDS_V+wid*1024;
  #define DMA_K(t,slot) glds16(ksrc+(long)(t)*KVBLK*DM,(unsigned)__builtin_amdgcn_readfirstlane(kdst+(slot)))
  #define DMA_V(t,slot) glds16(vsrc+(long)(t)*KVBLK*DM,(unsigned)__builtin_amdgcn_readfirstlane(vdst+(slot)))
  const int vb0=(int)(lds0+LDS_V)+((lane>>4)&1)*32+(lane&3)*8+(4*hi+((lane&15)>>2))*64;
  const char*Kbase=shm+LDS_K; bf16x8 kf[8];
  const lds_cptr shm3=(lds_cptr)shm; const lds_cptr kp0=shm3+LDS_K+hi*1024+r32*16; const lds_cptr vp0=shm3+LDS_V+((lane>>4)&1)*32+(lane&3)*8+(4*hi+((lane&15)>>2))*64;
  const int NT=(q0+QB)/KVBLK;
  DMA_K(0,0);DMA_V(0,0);DMA_K(1,SLOTB);
  bf16x8 qr[4];
  #pragma unroll
  for(int d0=0;d0<4;++d0)qr[d0]=*reinterpret_cast<const bf16x8*>(&Qw[(long)r32*DM+d0*16+hi*8]);
  float mhat=0.f,l_reg=0.f;f32x16 o[2];o[0]=f32x16{};o[1]=f32x16{};const f32x16 zero16=f32x16{};
    const int qabs=q0+wid*QBLK+r32;
  #define CMASK(P0,P1,t) do{ const __attribute__((address_space(3))) float* bp_=btab+(BT_OFF-59+qabs-64*(t)-4*hi); \
    _Pragma("unroll") for(int r=0;r<16;++r){ const int x_=(r&3)+8*(r>>2); P0[r]=fadd_s(P0[r],fsub_s(bp_[59-x_],mhat)); P1[r]=fadd_s(P1[r],fsub_s(bp_[27-x_],mhat)); } }while(0)
  bool resc=false;
  #define START(P0,P1) do{ const float rm=rowmax(P0,P1); resc=false; \
    { const float dl=rm; mhat=fadd_s(mhat,dl); \
      _Pragma("unroll") for(int r=0;r<16;++r){P0[r]=fsub_s(P0[r],dl);P1[r]=fsub_s(P1[r],dl);} \
      } \
    _Pragma("unroll") for(int r=0;r<16;++r)P0[r]=__builtin_amdgcn_exp2f(P0[r]); }while(0)
  #define RESC() do{ if(resc){ asm volatile("s_waitcnt lgkmcnt(0)":::"memory"); \
      _Pragma("unroll") for(int d_=0;d_<2;++d_) _Pragma("unroll") for(int r=0;r<16;++r)o[d_][r]*=wsf[crow(r,hi)]; } }while(0)
  f32x16 pA0,pA1,pB0,pB1;
  int sl_prev=0,sl_cur=0,sl_next=SLOTB;
  #define ROT() do{sl_prev=sl_cur;sl_cur=sl_next;sl_next=(sl_next==(NSLOT-1)*SLOTB)?0:sl_next+SLOTB;}while(0)
  DMA_K(2,2*SLOTB);
  WAIT_BAR(3);
  qkt(pA0,pA1,Kbase,qr,zero16,r32,hi);asm volatile("s_nop 15\n\ts_nop 7":"+v"(pA0),"+v"(pA1));CMASK(pA0,pA1,0);
  START(pA0,pA1);
  _Pragma("unroll") for(int r=0;r<16;++r)pA1[r]=__builtin_amdgcn_exp2f(pA1[r]);
  WAIT_BAR(0);
  DMA_K(3,0);DMA_V(1,SLOTB);
  ROT();
  kload8(kf,kp0+sl_cur);
  WAIT_BAR(2);
  s16x4 vlo[8],vhi[8]; u32x4 pw0,pw1,pw2,pw3;
  #define PKW(P,B) cvtpk_s(P[B],P[B+1])
  #define PAF(k) __builtin_bit_cast(bf16x8,pw##k)
  #define VFR(i) (bf16x8){vlo[i][0],vlo[i][1],vlo[i][2],vlo[i][3],vhi[i][0],vhi[i][1],vhi[i][2],vhi[i][3]}
  #define PIN(x) asm volatile("":"+v"(x))
  #define MX3(a,b,c) __builtin_fmaxf(__builtin_fmaxf((a),(b)),(c))
  #define GAPA(MF,A0,A1,A2,A3,W0,W1,PW) do{ MF; sacc+=A0; sacc+=A1; sacc+=A2; sacc+=A3; PIN(sacc); W0; W1; PIN(PW); SBAR(); }while(0)
  #define EX(v) __builtin_amdgcn_exp2f(v)
  #define GAPB(MF,X,B) do{ MF; X[B]=EX(X[B]); X[B+1]=EX(X[B+1]); X[B+2]=EX(X[B+2]); X[B+3]=EX(X[B+3]); PIN(X); SBAR(); }while(0)
  #define VRD(i) do{ vlo[i]=vtr(vp_+(((i)>>2)*4096+((i)&3)*1024)); vhi[i]=vtr(vp_+(((i)>>2)*4096+((i)&3)*1024+512)); }while(0)
  #define KRD(G,j) do{ if(G){ kload2(kf,kp0+sl_next,j); SBAR(); } }while(0)
  #define STEP(C0,C1,P0,P1,t,GK,GV,GL) do{ SBAR(); \
    const lds_cptr vp_=vp0+sl_prev; \
    VRD(0); SBAR(); float sacc=(P0[0]+P0[1]); \
    GAPA(C0=__builtin_amdgcn_mfma_f32_32x32x16_bf16(kf[0],qr[0],zero16,0,0,0), P0[2],P0[3],P0[4],P0[5],     pw0[0]=PKW(P0,0), pw0[1]=PKW(P0,2), pw0); \
    VRD(4); SBAR(); GAPA(C1=__builtin_amdgcn_mfma_f32_32x32x16_bf16(kf[1],qr[0],zero16,0,0,0), P0[6],P0[7],P0[8],P0[9],     pw0[2]=PKW(P0,4), pw0[3]=PKW(P0,6), pw0); \
    VRD(1); SBAR(); GAPA(C0=__builtin_amdgcn_mfma_f32_32x32x16_bf16(kf[2],qr[1],C0,0,0,0),   P0[10],P0[11],P0[12],P0[13], pw1[0]=PKW(P0,8), pw1[1]=PKW(P0,10), pw1); \
    VRD(5); SBAR(); GAPA(C1=__builtin_amdgcn_mfma_f32_32x32x16_bf16(kf[3],qr[1],C1,0,0,0),   P0[14],P0[15],P1[0],P1[1],   pw1[2]=PKW(P0,12),pw1[3]=PKW(P0,14), pw1); \
    VRD(2); SBAR(); GAPA(C0=__builtin_amdgcn_mfma_f32_32x32x16_bf16(kf[4],qr[2],C0,0,0,0),   P1[2],P1[3],P1[4],P1[5],     pw2[0]=PKW(P1,0), pw2[1]=PKW(P1,2), pw2); \
    VRD(6); SBAR(); GAPA(C1=__builtin_amdgcn_mfma_f32_32x32x16_bf16(kf[5],qr[2],C1,0,0,0),   P1[6],P1[7],P1[8],P1[9],     pw2[2]=PKW(P1,4), pw2[3]=PKW(P1,6), pw2); \
    VRD(3); SBAR(); GAPA(C0=__builtin_amdgcn_mfma_f32_32x32x16_bf16(kf[6],qr[3],C0,0,0,0),   P1[10],P1[11],P1[12],P1[13], pw3[0]=PKW(P1,8), pw3[1]=PKW(P1,10), pw3); \
    VRD(7); SBAR(); GAPA(C1=__builtin_amdgcn_mfma_f32_32x32x16_bf16(kf[7],qr[3],C1,0,0,0),   P1[14],P1[15],0.f,0.f,       pw3[2]=PKW(P1,12),pw3[3]=PKW(P1,14), pw3); \
    l_reg+=sacc; \
    if(GK){DMA_K((t)+3,sl_cur);} if(GV){DMA_V((t)+1,sl_next);} \
    CMASK(C0,C1,t); \
    { float a=MX3(C0[0],C0[1],C1[0]),b=MX3(C0[2],C0[3],C1[1]); a=MX3(a,C1[2],C1[3]); \
      _Pragma("unroll") for(int r=4;r<16;r+=4){a=MX3(a,C0[r],C0[r+1]);b=MX3(b,C0[r+2],C0[r+3]);a=MX3(a,C1[r],C1[r+1]);b=MX3(b,C1[r+2],C1[r+3]);} \
      float rm=__builtin_fmaxf(a,b); { auto rr=__builtin_amdgcn_permlane32_swap(__float_as_uint(rm),__float_as_uint(rm),false,false); rm=__builtin_fmaxf(__uint_as_float(rr[0]),__uint_as_float(rr[1])); } \
      resc=false; \
      if(__builtin_expect(__any(rm>(float)THRL),0)){ const float dl=__builtin_fmaxf(rm,0.f); mhat+=dl; \
        _Pragma("unroll") for(int r=0;r<16;++r){C0[r]-=dl;C1[r]-=dl;} \
        const float f=__builtin_amdgcn_exp2f(-dl); l_reg*=f; if(hi==0)wsf[r32]=f; resc=true; } } \
    SBAR(); \
    GAPB(o[0]=__builtin_amdgcn_mfma_f32_32x32x16_bf16(PAF(0),VFR(0),o[0],0,0,0), C0,0); \
    GAPB(o[1]=__builtin_amdgcn_mfma_f32_32x32x16_bf16(PAF(0),VFR(4),o[1],0,0,0), C0,4); \
    KRD(GL,0); GAPB(o[0]=__builtin_amdgcn_mfma_f32_32x32x16_bf16(PAF(1),VFR(1),o[0],0,0,0), C0,8); \
    KRD(GL,1); GAPB(o[1]=__builtin_amdgcn_mfma_f32_32x32x16_bf16(PAF(1),VFR(5),o[1],0,0,0), C0,12); \
    KRD(GL,2); GAPB(o[0]=__builtin_amdgcn_mfma_f32_32x32x16_bf16(PAF(2),VFR(2),o[0],0,0,0), C1,0); \
    KRD(GL,3); GAPB(o[1]=__builtin_amdgcn_mfma_f32_32x32x16_bf16(PAF(2),VFR(6),o[1],0,0,0), C1,4); \
    GAPB(o[0]=__builtin_amdgcn_mfma_f32_32x32x16_bf16(PAF(3),VFR(3),o[0],0,0,0), C1,8); \
    GAPB(o[1]=__builtin_amdgcn_mfma_f32_32x32x16_bf16(PAF(3),VFR(7),o[1],0,0,0), C1,12); \
    }while(0)
  int t=1;
  for(;t+5<NT;t+=2){
    STEP(pB0,pB1,pA0,pA1,t,true,true,true);     WAIT_BAR(2); RESC(); ROT();
    STEP(pA0,pA1,pB0,pB1,t+1,true,true,true);   WAIT_BAR(2); RESC(); ROT();
  }
  #define ENDW(tt) do{ if((tt)+3<NT){WAIT_BAR(2);} else if((tt)+2<NT){WAIT_BAR(1);} else {WAIT_BAR(0);} }while(0)
  for(;t+1<NT;t+=2){
    STEP(pB0,pB1,pA0,pA1,t,(t+3<NT),(t+1<NT),(t+1<NT));       ENDW(t);   RESC(); ROT();
    STEP(pA0,pA1,pB0,pB1,t+1,(t+4<NT),(t+2<NT),(t+2<NT));     ENDW(t+1); RESC(); ROT();
  }
  STEP(pB0,pB1,pA0,pA1,NT-1,false,false,false); RESC();
  { float sacc=pB0[0]+pB0[1]; _Pragma("unroll") for(int r=2;r<16;++r)sacc+=pB0[r]; _Pragma("unroll") for(int r=0;r<16;++r)sacc+=pB1[r]; l_reg+=sacc;
    pw0=(u32x4){PKW(pB0,0),PKW(pB0,2),PKW(pB0,4),PKW(pB0,6)};pw1=(u32x4){PKW(pB0,8),PKW(pB0,10),PKW(pB0,12),PKW(pB0,14)};pw2=(u32x4){PKW(pB1,0),PKW(pB1,2),PKW(pB1,4),PKW(pB1,6)};pw3=(u32x4){PKW(pB1,8),PKW(pB1,10),PKW(pB1,12),PKW(pB1,14)};
    SBAR(); pv(o,vb0+sl_cur,PAF(0),PAF(1),PAF(2),PAF(3)); }
  #undef PKW
  #undef PAF
  #undef VFR
  #undef PIN
  #undef MX3
  #undef GAPA
  #undef GAPB
  #undef EX
  #undef VRD
  #undef KRD
  #undef STEP
  #undef ENDW
  {auto rr=__builtin_amdgcn_permlane32_swap(__float_as_uint(l_reg),__float_as_uint(l_reg),false,false);l_reg=__uint_as_float(rr[0])+__uint_as_float(rr[1]);}
  if(hi==0)wsf[32+r32]=l_reg;asm volatile("s_waitcnt lgkmcnt(0)":::"memory");
  float rli[16];
  #pragma unroll
  for(int r=0;r<16;++r)rli[r]=__builtin_amdgcn_rcpf(wsf[32+crow(r,hi)]);
  bf16*Ow=O+(rowbase+q0+wid*QBLK)*OPITCH+h*D;
  { bf16*stg=(bf16*)(shm+LDS_OST)+wid*2048;
    #pragma unroll
    for(int r=0;r<16;++r){const int orow=crow(r,hi);
      #pragma unroll
      for(int d0=0;d0<2;++d0)stg[orow*64+d0*32+r32]=__float2bfloat16(o[d0][r]*rli[r]);}
    asm volatile("s_waitcnt lgkmcnt(0)":::"memory");
    #pragma unroll
    for(int i=0;i<4;++i){const int row=i*8+(lane>>3),ch=lane&7; const u32x4 v=*(const u32x4*)(stg+row*64+ch*8); ATTN_STORE16(Ow+(long)row*OPITCH+ch*8,v);} }
  asm volatile("s_waitcnt lgkmcnt(0)\n\ts_barrier":::"memory");
  #undef DMA_K
  #undef DMA_V
  #undef CMASK
  #undef START
  #undef RESC
  #undef ROT
}
constexpr int ATTN_LDS_BYTES=LDS_BYTES;
struct AttnTensors { const bf16* Q; const bf16* K; const bf16* V; bf16* O; };
struct AttnUnit { int bh; int qb; };
struct StaticOrder {
  int vcu;
  __device__ __forceinline__ explicit StaticOrder(int grid,int block):vcu((block%8)*(grid/8)+block/8){}
  __device__ __forceinline__ bool next(int i,AttnUnit&u)const{ if(i>=2)return false; const int s=vcu&3; u.bh=vcu>>2; u.qb=(i==0)?s:7-s; return true; }
  __device__ __forceinline__ void a_ready(const AttnUnit&)const{}
  __device__ __forceinline__ void done(const AttnUnit&)const{}
};
constexpr int BT_LDS_OFF=86016, ATTN_LDS_TOTAL=BT_LDS_OFF+BT_N*4;
__device__ __forceinline__ int t5b(int n){ if(n<16)return n; int b=16; b+=(n>=22);b+=(n>=30);b+=(n>=40);b+=(n>=54);b+=(n>=73);b+=(n>=99);b+=(n>=134);b+=(n>=182);b+=(n>=246);b+=(n>=332);b+=(n>=450);b+=(n>=609);b+=(n>=825);b+=(n>=1117);b+=(n>=1513); return b; }
__device__ __forceinline__ void build_btab(__attribute__((address_space(3))) float* bt,const float*relb,int h){
  for(int i=threadIdx.x;i<BT_N;i+=NW*64){ const int dl=i-BT_OFF; float v=-INFINITY;
    if(dl>=0){ const int c=(dl<=128?1:0)+(((dl&3)==0&&dl<=512)?1:0)+(((dl&15)==0&&dl<=2048)?1:0);
      if(c>0) v=(relb[t5b(dl)*NHEAD+h]+(c==1?0.f:(c==2?0.6931471805599453f:1.0986122886681098f)))*1.4426950408889634f; }
    bt[i]=v; }
}
template<class Sched,int THRL=8> __device__ __forceinline__ void attn_phase(char*lds,const AttnTensors&T,const float*relb,const Sched&S){
  AttnUnit u; int cur_h=-1;
  __attribute__((address_space(3))) float* bt=(__attribute__((address_space(3))) float*)((__attribute__((address_space(3))) char*)lds+BT_LDS_OFF);
  for(int i=0;S.next(i,u);++i){ S.a_ready(u);
    const int h=u.bh%NHEAD;
    if(h!=cur_h){ asm volatile("s_waitcnt lgkmcnt(0)\n\ts_barrier":::"memory"); build_btab(bt,relb,h); asm volatile("s_waitcnt lgkmcnt(0)\n\ts_barrier":::"memory"); cur_h=h; }
    attn_unit<THRL>(u.bh/NHEAD,u.bh%NHEAD,u.qb,T.Q,T.K,T.V,T.O,lds,bt); S.done(u); }
}
#undef SBAR
#undef WAIT_BAR
}
#define GAS __attribute__((address_space(1)))
#define LAS __attribute__((address_space(3)))
typedef unsigned short bf16;
typedef unsigned v4u __attribute__((ext_vector_type(4)));
typedef float f32x4 __attribute__((ext_vector_type(4)));
typedef short bf16x8 __attribute__((ext_vector_type(8)));
typedef GAS unsigned gu32;
typedef GAS unsigned long long gu64;
#define RLX_AGENT __ATOMIC_RELAXED, __HIP_MEMORY_SCOPE_AGENT
#define LDS_WAIT() asm volatile("s_waitcnt lgkmcnt(0)" ::: "memory")
#define VM_WAIT() asm volatile("s_waitcnt vmcnt(0)" ::: "memory")
__device__ __forceinline__ unsigned long long rt() { return __builtin_amdgcn_s_memrealtime(); }
__device__ __forceinline__ unsigned f2bf(float f) { unsigned u = __builtin_bit_cast(unsigned, f); return (u + 0x7fffu + ((u >> 16) & 1u)) >> 16; }
__device__ __forceinline__ unsigned pk2(float lo, float hi) { return f2bf(lo) | (f2bf(hi) << 16); }
#define XB_TMO      128
#define XB_XCNT(j)  (256  + 64 * (j))
#define XB_XSUB(j)  (1280 + 64 * (j))
#define XB_XGEN(j)  (2304 + 64 * (j))
#define XB_TOP      3328
#define XB_TOPGEN   3392
#define XCD_BAR_WORDS 3456
#define XB_SPIN_CAP (1u << 18)

__device__ __forceinline__ unsigned xb_ld(unsigned* p)              { return __hip_atomic_load(p, __ATOMIC_RELAXED, __HIP_MEMORY_SCOPE_AGENT); }
__device__ __forceinline__ unsigned xb_add(unsigned* p, unsigned v) { return __hip_atomic_fetch_add(p, v, __ATOMIC_RELAXED, __HIP_MEMORY_SCOPE_AGENT); }
__device__ __forceinline__ unsigned xb_xcc_id() { return (unsigned)__builtin_amdgcn_s_getreg((3 << 11) | 20) & 0xFu; }
#define XB_SPIN(cond, bar) do { unsigned _sp = 0; while (cond) { __builtin_amdgcn_s_sleep(1); \
    if ((++_sp & 255u) == 0u) { if (xb_ld(&(bar)[XB_TMO])) break; if (_sp > XB_SPIN_CAP) { atomicAdd(&(bar)[XB_TMO], 1u); break; } } } } while (0)

struct XcdBarrier {
    unsigned* bar; unsigned x;
    volatile LAS unsigned* st;
};

__device__ __forceinline__ XcdBarrier xcd_barrier_post(unsigned* bar, volatile LAS unsigned* st) {
    XcdBarrier b; b.bar = bar; b.x = xb_xcc_id(); b.st = st;
    if (threadIdx.x == 0) (void)xb_add(&bar[XB_XCNT(b.x)], 1u);
    return b;
}
__device__ __forceinline__ void xcd_barrier_complete(unsigned* bar, unsigned x, unsigned& nloc, unsigned& nx) {
    const unsigned G = gridDim.x * gridDim.y * gridDim.z;
    unsigned sum, cnt, mine, sp = 0u;
    for (;;) {
        sum = 0u; cnt = 0u; mine = 0u;
#pragma unroll
        for (unsigned j = 0; j < 16; ++j) { const unsigned c = xb_ld(&bar[XB_XCNT(j)]); sum += c; cnt += (c > 0u) ? 1u : 0u; mine = (j == x) ? c : mine; }
        if (sum == G) break;
        __builtin_amdgcn_s_sleep(1);
        if ((++sp & 255u) == 0u) { if (xb_ld(&bar[XB_TMO])) break; if (sp > XB_SPIN_CAP) { atomicAdd(&bar[XB_TMO], 1u); break; } }
    }
    nloc = mine > 0u ? mine : 1u; nx = cnt > 0u ? cnt : 1u;
}

__device__ __forceinline__ void xcd_barrier(const XcdBarrier& b) {
    asm volatile("s_waitcnt vmcnt(0)" ::: "memory");
    __syncthreads();
    if (threadIdx.x == 0) {
        unsigned* bar = b.bar;
        __builtin_amdgcn_s_waitcnt(0);
        unsigned nloc = b.st[0], nx = b.st[1];
        if (nloc == 0u) { xcd_barrier_complete(bar, b.x, nloc, nx); b.st[0] = nloc; b.st[1] = nx; }
        const unsigned old = xb_add(&bar[XB_XSUB(b.x)], 1u);
        const unsigned gen = old / nloc;
        if (old + 1u == (gen + 1u) * nloc) {
            __builtin_amdgcn_fence(__ATOMIC_RELEASE, "agent");
            asm volatile("s_waitcnt vmcnt(0)" ::: "memory");
            const unsigned og = xb_add(&bar[XB_TOP], 1u);
            const unsigned tg = og / nx;
            if (og + 1u == (tg + 1u) * nx) xb_add(&bar[XB_TOPGEN], 1u);
            else XB_SPIN(xb_ld(&bar[XB_TOPGEN]) == tg, bar);
            __builtin_amdgcn_fence(__ATOMIC_ACQUIRE, "agent");
            xb_add(&bar[XB_XGEN(b.x)], 1u);
            asm volatile("s_waitcnt vmcnt(0)" ::: "memory");
        } else {
            XB_SPIN(xb_ld(&bar[XB_XGEN(b.x)]) == gen, bar);
            __builtin_amdgcn_fence(__ATOMIC_ACQUIRE, "agent");
            asm volatile("s_waitcnt vmcnt(0)" ::: "memory");
        }
    }
    __syncthreads();
}

constexpr int NWAVES = 8;
constexpr int DM = 1024, NB = 8, SEQ = 2048, DB = 128, DS = 4;
constexpr int MP = NB * SEQ, MS = DB * DS, M = MP + MS;
constexpr int FF = 2816, NGU = 2 * FF, NIN = 3600, NINP = 3840;
constexpr int NH = 8, HD = 64, AW = 512, GW = 512;
constexpr int C_AQ = 0, C_AK = 512, C_AV = 1024, C_GQKV = 1536, C_Z = 3072, C_B = 3584, C_A = 3592;
constexpr float LN_EPS = 1e-5f, RMS_EPS = 1e-6f, ALPHA = 1.189207115002721f;
constexpr size_t O_YP = 0, O_YS = 16777216, O_KP = 17301504, O_VP = 25690112, O_SGP = 34078720, O_SCP = 34340864, O_KS = 34377728, O_VS = 34639872, O_SGS = 34902016, O_SCS = 39096320, O_END = 39686144;
constexpr size_t MiB = 1u << 20;
constexpr size_t WS_CTL = 0, CTL_ZERO_BYTES = 1 * MiB, WS_WGU1 = 1 * MiB, WS_WD1 = 13 * MiB, WS_WIN = 19 * MiB, WS_WOUT = 27 * MiB, WS_WGU2 = 29 * MiB, WS_WD2 = 41 * MiB;
constexpr size_t WS_XB = 48 * MiB, WS_H = 82 * MiB, WS_T = 174 * MiB, WS_X1 = 240 * MiB, WS_X1B = 306 * MiB, WS_P = 340 * MiB, WS_HEADS = 588 * MiB;
constexpr size_t WS_GQ = 622 * MiB, WS_GK = 655 * MiB, WS_GV = 688 * MiB, WS_GG = 721 * MiB, WS_GB = 722 * MiB, WS_GO = 723 * MiB, WS_X2 = 756 * MiB, WS_X2B = 822 * MiB, WS_QB = 856 * MiB, WS_KB = 872 * MiB, WS_VB = 888 * MiB, WS_END = 904 * MiB;
constexpr int CW_BAR = 4096;
constexpr int RING_OFF = 0, RING_BYTES = 131072, LDSCTL_OFF = RING_BYTES, MISC_OFF = LDSCTL_OFF + 320, LDS_BYTES = 147456;

struct Args { const float* in[25]; float* out; unsigned char* ws; };

__device__ __forceinline__ float wave_sum(float v) {
#pragma unroll
    for (int o = 1; o < 64; o <<= 1) v += __shfl_xor(v, o);
    return v;
}
__device__ __forceinline__ float wave_max(float v) {
#pragma unroll
    for (int o = 1; o < 64; o <<= 1) v = fmaxf(v, __shfl_xor(v, o));
    return v;
}
__device__ __forceinline__ int t5_bucket(int n) {
    if (n < 16) return n;
    int b = 16;
    b += (n >= 22); b += (n >= 30); b += (n >= 40); b += (n >= 54); b += (n >= 73); b += (n >= 99); b += (n >= 134); b += (n >= 182);
    b += (n >= 246); b += (n >= 332); b += (n >= 450); b += (n >= 609); b += (n >= 825); b += (n >= 1117); b += (n >= 1513);
    return b;
}
__device__ __forceinline__ unsigned long long pk4(f32x4 v) { return (unsigned long long)pk2(v.x, v.y) | ((unsigned long long)pk2(v.z, v.w) << 32); }

__device__ __forceinline__ void p0_transpose_item(const float* W0, const float* W1, int K, int Nsrc, int Nd, int mode, bf16* WT, LAS float* scr, int item, int lane) {
    const int nblk = Nd / 32, kb = item / nblk, nb = item % nblk, k0 = 64 * kb, n0 = 32 * nb;
    const float* src = W0; int c0 = n0;
    if (mode == 1) { const int t = n0 / 256, w = n0 % 256; src = (w < 128) ? W0 : W1; c0 = t * 128 + (w & 127); }
    const bool okc = (c0 + (lane & 31)) < Nsrc;
#pragma unroll 8
    for (int i = 0; i < 32; ++i) { const int kk = 2 * i + (lane >> 5); scr[kk * 33 + (lane & 31)] = okc ? src[(size_t)(k0 + kk) * Nsrc + c0 + (lane & 31)] : 0.f; }
    LDS_WAIT(); asm volatile("" ::: "memory");
    const int c = lane & 7;
#pragma unroll
    for (int j = 0; j < 4; ++j) { const int n = (lane >> 3) + 8 * j; const LAS float* s = scr + (8 * c) * 33 + n;
        v4u o; o.x = pk2(s[0 * 33], s[1 * 33]); o.y = pk2(s[2 * 33], s[3 * 33]); o.z = pk2(s[4 * 33], s[5 * 33]); o.w = pk2(s[6 * 33], s[7 * 33]);
        *(GAS v4u*)(WT + (size_t)(n0 + n) * K + k0 + 8 * c) = o; }
    LDS_WAIT(); asm volatile("" ::: "memory");
}
__device__ __forceinline__ void p_transpose(const float* W0, const float* W1, int K, int Nsrc, int Nd, int mode, bf16* WT, LAS float* scr, int gw, int NGW, int lane) {
    const int nitems = (K / 64) * (Nd / 32);
    for (int it = gw; it < nitems; it += NGW) p0_transpose_item(W0, W1, K, Nsrc, Nd, mode, WT, scr, it, lane);
}
__device__ __forceinline__ void p_cvt_x(const float* xp, const float* xs, bf16* xb, int gw, int NGW, int lane) {
    for (int m = gw; m < M; m += NGW) { const float* s = (m < MP) ? xp + (size_t)m * DM : xs + (size_t)(m - MP) * DM;
#pragma unroll
        for (int j = 0; j < 4; ++j) { const f32x4 v = *(const f32x4*)(s + j * 256 + lane * 4); *(unsigned long long*)(xb + (size_t)m * DM + j * 256 + lane * 4) = pk4(v); } }
}
__device__ __forceinline__ void p_ln(const float* r0, const float* r1, const float* t, float s, const float* g, const float* b, float* o0, float* o1, bf16* ob, int gw, int NGW, int lane) {
    for (int m = gw; m < M; m += NGW) {
        const float* rr = (m < MP) ? r0 + (size_t)m * DM : r1 + (size_t)(m - MP) * DM;
        const float* tt = t + (size_t)m * DM;
        f32x4 v[4]; float sum = 0.f;
#pragma unroll
        for (int j = 0; j < 4; ++j) { const f32x4 a = *(const f32x4*)(rr + j * 256 + lane * 4), c = *(const f32x4*)(tt + j * 256 + lane * 4); v[j] = a * ALPHA + c * s; sum += (v[j].x + v[j].y) + (v[j].z + v[j].w); }
        const float mean = wave_sum(sum) * (1.f / DM); float s2 = 0.f;
#pragma unroll
        for (int j = 0; j < 4; ++j) { v[j] = v[j] - mean; s2 += (v[j].x * v[j].x + v[j].y * v[j].y) + (v[j].z * v[j].z + v[j].w * v[j].w); }
        const float rstd = 1.0f / sqrtf(wave_sum(s2) * (1.f / DM) + LN_EPS);
        float* oo = (m < MP) ? o0 + (size_t)m * DM : o1 + (size_t)(m - MP) * DM;
#pragma unroll
        for (int j = 0; j < 4; ++j) { const f32x4 gg = *(const f32x4*)(g + j * 256 + lane * 4), bb = *(const f32x4*)(b + j * 256 + lane * 4); const f32x4 y = v[j] * rstd * gg + bb;
            *(f32x4*)(oo + j * 256 + lane * 4) = y;
            if (ob) *(unsigned long long*)(ob + (size_t)m * DM + j * 256 + lane * 4) = pk4(y); }
    }
}
__device__ __forceinline__ void p_copy_out(const float* P, float* out, bf16* Qb, bf16* Kb, bf16* Vb, int gw, int NGW, int lane) {
    for (int m = gw; m < M; m += NGW) {
        const float* pr = P + (size_t)m * NINP;
        if (m < MP) {
#pragma unroll
            for (int j = 0; j < 2; ++j) { const int c = j * 256 + lane * 4; *(unsigned long long*)(Qb + (size_t)m * AW + c) = pk4(*(const f32x4*)(pr + C_AQ + c) * attn_body::C2);
                *(unsigned long long*)(Kb + (size_t)m * AW + c) = pk4(*(const f32x4*)(pr + C_AK + c)); *(unsigned long long*)(Vb + (size_t)m * AW + c) = pk4(*(const f32x4*)(pr + C_AV + c)); } }
        float* kd; float* vd;
        if (m < MP) { kd = out + O_KP + (size_t)m * AW; vd = out + O_VP + (size_t)m * AW; } else { kd = out + O_KS + (size_t)(m - MP) * AW; vd = out + O_VS + (size_t)(m - MP) * AW; }
#pragma unroll
        for (int j = 0; j < 2; ++j) { *(f32x4*)(kd + j * 256 + lane * 4) = *(const f32x4*)(pr + C_AK + j * 256 + lane * 4); *(f32x4*)(vd + j * 256 + lane * 4) = *(const f32x4*)(pr + C_AV + j * 256 + lane * 4); }
        float* sd = nullptr;
        if (m < MP) { const int b = m / SEQ, t = m % SEQ; if (t >= SEQ - 3) sd = out + O_SCP + ((size_t)b * 3 + (t - (SEQ - 3))) * 1536; }
        else { const int b = (m - MP) / DS, t = (m - MP) % DS; if (t >= 1) sd = out + O_SCS + ((size_t)b * 3 + (t - 1)) * 1536; }
        if (sd) {
#pragma unroll
            for (int j = 0; j < 6; ++j) *(f32x4*)(sd + j * 256 + lane * 4) = *(const f32x4*)(pr + C_GQKV + j * 256 + lane * 4); }
    }
}
__device__ __forceinline__ void p_attn_simple(const float* P, const float* ck, const float* cv, const float* relb, bf16* heads, LAS float* lds, int m0, int vcu, int G, int h, int lane) {
    LAS float* sq = lds + h * 64; LAS float* sp = lds + 8 * 64 + h * 392;
    for (int m = m0 + vcu; m < M; m += G) {
        const bool samp = m >= MP; int b, p;
        if (!samp) { b = m / SEQ; p = m % SEQ; } else { b = (m - MP) / DS; p = SEQ + (m - MP) % DS; }
        sq[lane] = P[(size_t)m * NINP + C_AQ + h * 64 + lane] * 0.125f;
        LDS_WAIT(); asm volatile("" ::: "memory");
        float lg[7]; float mx = -INFINITY;
#pragma unroll
        for (int i = 0; i < 7; ++i) {
            const int e = i * 64 + lane; float v = -INFINITY;
            if (e < 387) { const int g = e / 129, j = e % 129, dil = (g == 0) ? 1 : (g == 1 ? 4 : 16), delta = j * dil, pos = p - delta;
                if (pos >= 0) {
                    const float* kp;
                    if (!samp) kp = P + (size_t)(b * SEQ + pos) * NINP + C_AK + h * 64;
                    else if (pos >= SEQ) kp = P + (size_t)(MP + b * DS + (pos - SEQ)) * NINP + C_AK + h * 64;
                    else kp = ck + (((size_t)b * SEQ + pos) * NH + h) * HD;
                    float acc = 0.f;
#pragma unroll
                    for (int d = 0; d < 64; d += 4) { const f32x4 kv = *(const f32x4*)(kp + d); acc += kv.x * sq[d] + kv.y * sq[d + 1] + kv.z * sq[d + 2] + kv.w * sq[d + 3]; }
                    v = acc + relb[t5_bucket(delta) * NH + h]; } }
            lg[i] = v; mx = fmaxf(mx, v); }
        mx = wave_max(mx);
        float sum = 0.f;
#pragma unroll
        for (int i = 0; i < 7; ++i) { const int e = i * 64 + lane; const float pe = (lg[i] == -INFINITY) ? 0.f : __expf(lg[i] - mx); if (e < 387) sp[e] = pe; sum += pe; }
        sum = wave_sum(sum);
        LDS_WAIT(); asm volatile("" ::: "memory");
        float o = 0.f;
        for (int e = 0; e < 387; ++e) { const float pe = sp[e]; if (pe == 0.f) continue;
            const int g = e / 129, j = e % 129, dil = (g == 0) ? 1 : (g == 1 ? 4 : 16), pos = p - j * dil;
            const float* vp;
            if (!samp) vp = P + (size_t)(b * SEQ + pos) * NINP + C_AV + h * 64;
            else if (pos >= SEQ) vp = P + (size_t)(MP + b * DS + (pos - SEQ)) * NINP + C_AV + h * 64;
            else vp = cv + (((size_t)b * SEQ + pos) * NH + h) * HD;
            o += pe * vp[lane]; }
        heads[(size_t)m * DM + h * 64 + lane] = (bf16)f2bf(o / sum);
        LDS_WAIT(); asm volatile("" ::: "memory");
    }
}
__device__ __forceinline__ void p_gdn_prep(const float* P, const float* sconv, const float* convw, const float* alog, const float* dtb, float* GQ, float* GK, float* GV, float* GG, float* GB, int vcu, int G, int h, int lane) {
    for (int m = vcu; m < M; m += G) {
        const bool samp = m >= MP; int b, t;
        if (!samp) { b = m / SEQ; t = m % SEQ; } else { b = (m - MP) / DS; t = (m - MP) % DS; }
        float r[3];
#pragma unroll
        for (int part = 0; part < 3; ++part) {
            const int c = part * 512 + h * 64 + lane; float acc = 0.f;
#pragma unroll
            for (int j = 0; j < 4; ++j) { const int tt = t - 3 + j; float x;
                if (tt >= 0) x = P[(size_t)(m - t + tt) * NINP + C_GQKV + c]; else x = samp ? sconv[((size_t)b * 3 + (tt + 3)) * 1536 + c] : 0.f;
                acc += x * convw[j * 1536 + c]; }
            r[part] = acc / (1.0f + __expf(-acc)); }
        const float qn = wave_sum(r[0] * r[0]), kn = wave_sum(r[1] * r[1]);
        GQ[(size_t)m * GW + h * 64 + lane] = r[0] * (1.0f / sqrtf(qn + RMS_EPS)) * 0.125f;
        GK[(size_t)m * GW + h * 64 + lane] = r[1] * (1.0f / sqrtf(kn + RMS_EPS));
        GV[(size_t)m * GW + h * 64 + lane] = r[2];
        if (lane == 0) { const float bb = P[(size_t)m * NINP + C_B + h], aa = P[(size_t)m * NINP + C_A + h] + dtb[h];
            GB[(size_t)m * NH + h] = 1.0f / (1.0f + __expf(-bb));
            const float sp = (aa > 20.f) ? aa : log1pf(__expf(aa));
            GG[(size_t)m * NH + h] = -__expf(alog[h]) * sp; }
    }
}
__device__ __forceinline__ void gdn_scan_task(int task, const float* GQ, const float* GK, const float* GV, const float* GG, const float* GB, const float* s0, const float* P, const float* nw, bf16* heads, float* out, int lane) {
    const int seq = task / NH, h = task % NH;
    float S[64]; int row0, L; float* sdst;
    if (seq < NB) { row0 = seq * SEQ; L = SEQ; sdst = out + O_SGP + ((size_t)seq * NH + h) * 4096;
#pragma unroll
        for (int d = 0; d < 64; ++d) S[d] = 0.f; }
    else { const int b = seq - NB; row0 = MP + b * DS; L = DS; sdst = out + O_SGS + ((size_t)b * NH + h) * 4096; const float* sp = s0 + ((size_t)b * NH + h) * 4096;
#pragma unroll
        for (int d = 0; d < 64; ++d) S[d] = sp[d * 64 + lane]; }
    const float nwl = nw[lane];
    size_t o = (size_t)row0 * GW + h * 64 + lane;
    float qn = GQ[o], kn = GK[o], vn = GV[o], gn = GG[(size_t)row0 * NH + h], bn = GB[(size_t)row0 * NH + h], zn = P[(size_t)row0 * NINP + C_Z + h * 64 + lane];
    for (int t = 0; t < L; ++t) {
        const float qv = qn, kv = kn, vv = vn, eg = __expf(gn), beta = bn, z = zn; const int m = row0 + t;
        if (t + 1 < L) { o += GW; qn = GQ[o]; kn = GK[o]; vn = GV[o]; gn = GG[(size_t)(m + 1) * NH + h]; bn = GB[(size_t)(m + 1) * NH + h]; zn = P[(size_t)(m + 1) * NINP + C_Z + h * 64 + lane]; }
        float k0 = 0.f, k1 = 0.f, k2 = 0.f, k3 = 0.f;
#pragma unroll
        for (int d = 0; d < 64; d += 4) {
            k0 += __builtin_bit_cast(float, __builtin_amdgcn_readlane(__builtin_bit_cast(int, kv), d)) * S[d];
            k1 += __builtin_bit_cast(float, __builtin_amdgcn_readlane(__builtin_bit_cast(int, kv), d + 1)) * S[d + 1];
            k2 += __builtin_bit_cast(float, __builtin_amdgcn_readlane(__builtin_bit_cast(int, kv), d + 2)) * S[d + 2];
            k3 += __builtin_bit_cast(float, __builtin_amdgcn_readlane(__builtin_bit_cast(int, kv), d + 3)) * S[d + 3]; }
        const float ks = (k0 + k1) + (k2 + k3);
        const float c = beta * (vv - eg * ks);
        float o0 = 0.f, o1 = 0.f, o2 = 0.f, o3 = 0.f;
#pragma unroll
        for (int d = 0; d < 64; d += 4) {
#pragma unroll
            for (int e = 0; e < 4; ++e) { const float kd = __builtin_bit_cast(float, __builtin_amdgcn_readlane(__builtin_bit_cast(int, kv), d + e)); S[d + e] = fmaf(kd, c, eg * S[d + e]); }
            o0 += __builtin_bit_cast(float, __builtin_amdgcn_readlane(__builtin_bit_cast(int, qv), d)) * S[d];
            o1 += __builtin_bit_cast(float, __builtin_amdgcn_readlane(__builtin_bit_cast(int, qv), d + 1)) * S[d + 1];
            o2 += __builtin_bit_cast(float, __builtin_amdgcn_readlane(__builtin_bit_cast(int, qv), d + 2)) * S[d + 2];
            o3 += __builtin_bit_cast(float, __builtin_amdgcn_readlane(__builtin_bit_cast(int, qv), d + 3)) * S[d + 3]; }
        const float ov = (o0 + o1) + (o2 + o3);
        const float ms = wave_sum(ov * ov) * (1.f / 64.f);
        const float y = ov * (1.0f / sqrtf(ms + RMS_EPS)) * nwl * (z / (1.0f + __expf(-z)));
        heads[(size_t)m * DM + AW + h * 64 + lane] = (bf16)f2bf(y);
    }
#pragma unroll
    for (int d = 0; d < 64; ++d) sdst[d * 64 + lane] = S[d];
}

__global__ void __launch_bounds__(NWAVES * 64, 2) mega_fwd(Args args) {
    extern __shared__ __attribute__((aligned(16))) unsigned char lds[];
    LAS unsigned char* L = (LAS unsigned char*)lds;
    volatile LAS unsigned* MISC = (volatile LAS unsigned*)(L + MISC_OFF);
    const int tid = threadIdx.x, lane = tid & 63, wave = __builtin_amdgcn_readfirstlane(tid >> 6);
    const int G = gridDim.x; const int bx = blockIdx.x; const int vcu = (G % 8 == 0) ? (bx % 8) * (G / 8) + bx / 8 : bx;
    unsigned char* ws = args.ws; float* out = args.out;
    gu32* ctl = (gu32*)(ws + WS_CTL);
    for (int u = tid; u < (LDS_BYTES - LDSCTL_OFF) / 4; u += NWAVES * 64) ((LAS unsigned*)(L + LDSCTL_OFF))[u] = 0u;
    __syncthreads();
    XcdBarrier bar = xcd_barrier_post((unsigned*)(ctl + CW_BAR), MISC + 8);
#define GRID_BAR() xcd_barrier(bar)
    const float* const* in = args.in;
    bf16 *Wgu1 = (bf16*)(ws + WS_WGU1), *Wd1 = (bf16*)(ws + WS_WD1), *Win = (bf16*)(ws + WS_WIN), *Wout = (bf16*)(ws + WS_WOUT), *Wgu2 = (bf16*)(ws + WS_WGU2), *Wd2 = (bf16*)(ws + WS_WD2);
    bf16 *XB = (bf16*)(ws + WS_XB), *H = (bf16*)(ws + WS_H), *X1B = (bf16*)(ws + WS_X1B), *HEADS = (bf16*)(ws + WS_HEADS), *X2B = (bf16*)(ws + WS_X2B);
    float *T = (float*)(ws + WS_T), *X1 = (float*)(ws + WS_X1), *P = (float*)(ws + WS_P), *GQ = (float*)(ws + WS_GQ), *GK = (float*)(ws + WS_GK), *GV = (float*)(ws + WS_GV), *GG = (float*)(ws + WS_GG), *GB = (float*)(ws + WS_GB), *X2 = (float*)(ws + WS_X2);
    const int gw = vcu * NWAVES + wave, NGW = G * NWAVES;

    {   LAS float* scr = (LAS float*)(L + RING_OFF + wave * 16384);
        p_transpose(in[9], in[10], DM, FF, NGU, 1, Wgu1, scr, gw, NGW, lane);
        p_transpose(in[11], nullptr, FF, DM, DM, 0, Wd1, scr, gw, NGW, lane);
        p_transpose(in[12], nullptr, DM, NIN, NINP, 0, Win, scr, gw, NGW, lane);
        p_transpose(in[13], nullptr, DM, DM, DM, 0, Wout, scr, gw, NGW, lane);
        p_transpose(in[20], in[21], DM, FF, NGU, 1, Wgu2, scr, gw, NGW, lane);
        p_transpose(in[22], nullptr, FF, DM, DM, 0, Wd2, scr, gw, NGW, lane);
        p_cvt_x(in[0], in[1], XB, gw, NGW, lane);
        GRID_BAR(); }
    {   pg8::Gemm g{XB, Wgu1, M, NGU, DM, 0}; pg8::StaticOrder S; S.init(M, NGU, G, bx); pg8::EpiSwiGLU E{H, FF, 0};
        pg8::gemm_phase<pg8::EpiSwiGLU, pg8::StaticOrder, true, true>(L + RING_OFF, g, S, E); GRID_BAR(); }
    {   pg8::Gemm g{H, Wd1, M, DM, FF, 0}; pg8::StaticOrder S; S.init(M, DM, G, bx); pg8::EpiF32 E{T, DM, 0};
        pg8::gemm_phase<pg8::EpiF32, pg8::StaticOrder, true, true>(L + RING_OFF, g, S, E); GRID_BAR(); }
    p_ln(in[0], in[1], T, 0.5f, in[7], in[8], X1, X1 + (size_t)MP * DM, X1B, gw, NGW, lane); GRID_BAR();
    {   pg8::Gemm g{X1B, Win, M, NINP, DM, 0}; pg8::StaticOrder S; S.init(M, NINP, G, bx); pg8::EpiF32 E{P, NINP, 0};
        pg8::gemm_phase<pg8::EpiF32, pg8::StaticOrder, true, true>(L + RING_OFF, g, S, E); GRID_BAR(); }
    bf16 *Qb = (bf16*)(ws + WS_QB), *Kb = (bf16*)(ws + WS_KB), *Vb = (bf16*)(ws + WS_VB);
    p_copy_out(P, out, Qb, Kb, Vb, gw, NGW, lane);
    p_gdn_prep(P, in[5], in[14], in[15], in[16], GQ, GK, GV, GG, GB, vcu, G, wave, lane);
    GRID_BAR();
    {   const attn_body::AttnTensors AT{(const attn_body::bf16*)Qb, (const attn_body::bf16*)Kb, (const attn_body::bf16*)Vb, (attn_body::bf16*)HEADS};
        const attn_body::StaticOrder S(G, bx);
        attn_body::attn_phase<attn_body::StaticOrder>((char*)lds + RING_OFF, AT, in[6], S); }
    p_attn_simple(P, in[2], in[3], in[6], HEADS, (LAS float*)(L + RING_OFF), MP, vcu, G, wave, lane);
    for (int task = wave * G + bx; task < (NB + DB) * NH; task += NGW) gdn_scan_task(task, GQ, GK, GV, GG, GB, in[4], P, in[17], HEADS, out, lane);
    GRID_BAR();
    {   pg8::Gemm g{HEADS, Wout, M, DM, DM, 0}; pg8::StaticOrder S; S.init(M, DM, G, bx); pg8::EpiF32 E{T, DM, 0};
        pg8::gemm_phase<pg8::EpiF32, pg8::StaticOrder, true, true>(L + RING_OFF, g, S, E); GRID_BAR(); }
    p_ln(X1, X1 + (size_t)MP * DM, T, 1.0f, in[18], in[19], X2, X2 + (size_t)MP * DM, X2B, gw, NGW, lane); GRID_BAR();
    {   pg8::Gemm g{X2B, Wgu2, M, NGU, DM, 0}; pg8::StaticOrder S; S.init(M, NGU, G, bx); pg8::EpiSwiGLU E{H, FF, 0};
        pg8::gemm_phase<pg8::EpiSwiGLU, pg8::StaticOrder, true, true>(L + RING_OFF, g, S, E); GRID_BAR(); }
    {   pg8::Gemm g{H, Wd2, M, DM, FF, 0}; pg8::StaticOrder S; S.init(M, DM, G, bx); pg8::EpiF32 E{T, DM, 0};
        pg8::gemm_phase<pg8::EpiF32, pg8::StaticOrder, true, true>(L + RING_OFF, g, S, E); GRID_BAR(); }
    p_ln(X2, X2 + (size_t)MP * DM, T, 0.5f, in[23], in[24], out + O_YP, out + O_YS, nullptr, gw, NGW, lane);
}

extern "C" void kernel_launch(void* const* d_in, const int* in_sizes, int n_in, void* d_out, int out_size, void* d_ws, size_t ws_size, hipStream_t stream) {
    static int grid = 0;
    if (grid == 0) {
        if (n_in != 25 || out_size != (int)O_END || ws_size < WS_END) { fprintf(stderr, "kernel_launch: unexpected shapes (n_in %d out %d ws %zu)\n", n_in, out_size, ws_size); grid = -1; return; }
        int dev = 0, cus = 0, per_cu = 0;
        if (hipGetDevice(&dev) != hipSuccess || hipDeviceGetAttribute(&cus, hipDeviceAttributeMultiprocessorCount, dev) != hipSuccess) { grid = -1; return; }
        if (hipFuncSetAttribute((const void*)mega_fwd, hipFuncAttributeMaxDynamicSharedMemorySize, LDS_BYTES) != hipSuccess) { fprintf(stderr, "kernel_launch: hipFuncSetAttribute failed\n"); grid = -1; return; }
        if (hipOccupancyMaxActiveBlocksPerMultiprocessor(&per_cu, (const void*)mega_fwd, NWAVES * 64, LDS_BYTES) != hipSuccess || per_cu < 1) { fprintf(stderr, "kernel_launch: occupancy query reports %d\n", per_cu); }
        (void)hipGetLastError();
        grid = cus;
    }
    if (grid < 0) return;
    if (hipMemsetAsync((char*)d_ws + WS_CTL, 0, CTL_ZERO_BYTES, stream) != hipSuccess) return;
    Args a; memset(&a, 0, sizeof(a));
    for (int i = 0; i < 25; ++i) a.in[i] = (const float*)d_in[i];
    a.out = (float*)d_out; a.ws = (unsigned char*)d_ws;
    hipLaunchKernelGGL(mega_fwd, dim3(grid), dim3(NWAVES * 64), LDS_BYTES, stream, a);
}
```

```cpp
#include <hip/hip_runtime.h>
#include <cstdio>
#include <cstdint>
#include <cstring>
#include <cmath>
namespace pg8 {
#define PG8_LAS __attribute__((address_space(3)))
typedef unsigned short bf16_t;
typedef short bf16x8 __attribute__((ext_vector_type(8)));
typedef float f32x4 __attribute__((ext_vector_type(4)));
typedef unsigned u32x4 __attribute__((ext_vector_type(4)));
constexpr int BM = 256, BK = 64, HALF = 128, HTB = HALF * BK * 2  , STAGE_BYTES = 8 * HTB, NXCD = 8, WGM = 8;

__host__ __device__ __forceinline__ int lds_byte(int r, int c) { const int st = (r >> 4) * 2 + (c >> 5), rr = r & 15, cc = c & 31, ob = rr * 64 + cc * 2; return st * 1024 + (ob ^ (((ob >> 9) & 1) << 5)); }
__host__ __device__ __forceinline__ void stage_rc(int b, int& R, int& C) { const int st = b / 1024, sb = b % 1024, swz = sb ^ (((sb >> 9) & 1) << 5); R = (st >> 1) * 16 + swz / 64; C = (st & 1) * 32 + (swz % 64) / 2; }
__host__ __device__ __forceinline__ int perm32(int rho) { const int n = rho >> 4, i = rho & 15; return 8 * (i >> 2) + 4 * n + (i & 3); }

struct Unit { int pm, pn; };
struct Gemm { const bf16_t* A; const bf16_t* Bt; int M, N, K, pad; };

struct StaticOrder {
    int nM, nN, nwg, G, c;
    __host__ __device__ void init(int M, int N, int G_, int c_) { nM = M / BM; nN = N / BM; nwg = nM * nN; G = G_; c = c_; }
    __host__ __device__ bool next(int i, Unit& u) const {
        const long L = (long)i * G + c; if (L >= nwg) return false;
        int wgid = (int)L; { const int q = nwg / NXCD, r = nwg % NXCD, xcd = wgid % NXCD, off = wgid / NXCD; wgid = (xcd < r ? xcd * (q + 1) : r * (q + 1) + (xcd - r) * q) + off; }
        const int nig = WGM * nN, gid = wgid / nig, fm = gid * WGM, gsz = (nM - fm) < WGM ? (nM - fm) : WGM;
        u.pm = fm + ((wgid % nig) % gsz); u.pn = (wgid % nig) / gsz; return true;
    }
    __device__ __forceinline__ void a_ready(const Unit&) const {}
    __device__ __forceinline__ void done(const Unit&) const {}
};

__device__ __forceinline__ unsigned cvt_pk_bf16(float lo, float hi) { unsigned r; asm volatile("v_cvt_pk_bf16_f32 %0, %1, %2" : "=v"(r) : "v"(lo), "v"(hi)); return r; }
typedef float f32x2 __attribute__((ext_vector_type(2)));
struct EpiF32 {
    static constexpr bool PERM = false, AFTER_DRAIN = false;
    float* C; int ldc, pad;
    __device__ __forceinline__ void operator()(const f32x4 (&acc)[2][2][4][2], const Unit& u, int wr, int wc, int fr, int fq) const {
        const int row0 = u.pm * BM + wr * 64 + fr, col0 = u.pn * BM + wc * 32 + 4 * fq;
#pragma unroll
        for (int ai = 0; ai < 2; ++ai)
#pragma unroll
            for (int m = 0; m < 4; ++m) { float* rowp = C + (size_t)(row0 + ai * HALF + m * 16) * ldc + col0;
#pragma unroll
                for (int bj = 0; bj < 2; ++bj)
#pragma unroll
                    for (int n = 0; n < 2; ++n) *(f32x4*)(rowp + bj * HALF + n * 16) = acc[ai][bj][m][n]; }
    }
};
__device__ __forceinline__ float silu_f(float x) { return x * __builtin_amdgcn_rcpf(1.0f + __builtin_amdgcn_exp2f(-1.4426950408889634f * x)); }
struct EpiSwiGLU {
    static constexpr bool PERM = true, AFTER_DRAIN = false;
    bf16_t* H; int ldc, pad;
    __device__ __forceinline__ void operator()(const f32x4 (&acc)[2][2][4][2], const Unit& u, int wr, int wc, int fr, int fq) const {
        const int row0 = u.pm * BM + wr * 64 + fr, col0 = u.pn * HALF + wc * 32 + 8 * fq;
#pragma unroll
        for (int ai = 0; ai < 2; ++ai)
#pragma unroll
            for (int m = 0; m < 4; ++m) { bf16_t* rowp = H + (size_t)(row0 + ai * HALF + m * 16) * ldc + col0;
                const f32x4 g0 = acc[ai][0][m][0], g1 = acc[ai][0][m][1], u0 = acc[ai][1][m][0], u1 = acc[ai][1][m][1];
                u32x4 w;
                w.x = cvt_pk_bf16(silu_f(g0[0]) * u0[0], silu_f(g0[1]) * u0[1]); w.y = cvt_pk_bf16(silu_f(g0[2]) * u0[2], silu_f(g0[3]) * u0[3]);
                w.z = cvt_pk_bf16(silu_f(g1[0]) * u1[0], silu_f(g1[1]) * u1[1]); w.w = cvt_pk_bf16(silu_f(g1[2]) * u1[2], silu_f(g1[3]) * u1[3]);
                *(u32x4*)rowp = w; }
    }
};
template <class Epi, class Sched, bool ALIGN_EPI = false, bool SP2 = false>
__device__ __forceinline__ void gemm_phase(PG8_LAS unsigned char* lds, const Gemm g, const Sched& S, const Epi& E) {
    int tid_l = threadIdx.x; asm volatile("" : "+v"(tid_l));
    const int tid = tid_l, wid = __builtin_amdgcn_readfirstlane(tid >> 6), lane = tid & 63, wr = wid >> 2, wc = wid & 3, fr = lane & 15, fq = lane >> 4;
    const int K = g.K, nt = K / BK;
    unsigned voffA[2], voffB[2];
#pragma unroll
    for (int i = 0; i < 2; ++i) { int R, C; stage_rc(tid * 16 + i * 8192, R, C); const int Rb = Epi::PERM ? ((R & ~31) + perm32(R & 31)) : R;
        voffA[i] = (unsigned)(R * K + C) * 2u; voffB[i] = (unsigned)(Rb * K + C) * 2u; }
    const size_t kstep = (size_t)(BK * 2);
    const size_t hstep = (size_t)HALF * K * 2;
    const size_t tstep = 2 * hstep;
    const unsigned ldsw = (unsigned)wid * 1024u;
    const int aoff = lds_byte(wr * 64 + fr, fq * 8), boff = lds_byte(wc * 32 + fr, fq * 8);
#define PG8_SA(b, h) (((b) * 2 + (h)) * HTB)
#define PG8_SB(b, h) ((4 + (b) * 2 + (h)) * HTB)
#define PG8_STAGE(bufoff, gbase, voff) do { _Pragma("unroll") for (int _i = 0; _i < 2; ++_i) \
        __builtin_amdgcn_global_load_lds((const unsigned*)((const char*)(gbase) + (voff)[_i]), (PG8_LAS unsigned*)(lds + (bufoff) + ldsw + _i * 8192), 16, 0, 0); } while (0)
#define PG8_LDA(dst, b, h) do { _Pragma("unroll") for (int m = 0; m < 4; ++m) _Pragma("unroll") for (int k = 0; k < 2; ++k) dst[m][k] = *(const PG8_LAS bf16x8*)(lds + PG8_SA(b, h) + aoff + m * 2048 + k * 1024); } while (0)
#define PG8_LDB(dst, b, h) do { _Pragma("unroll") for (int n = 0; n < 2; ++n) _Pragma("unroll") for (int k = 0; k < 2; ++k) dst[n][k] = *(const PG8_LAS bf16x8*)(lds + PG8_SB(b, h) + boff + n * 2048 + k * 1024); } while (0)
#define PG8_MMA(ai, bj, At, Bt) do { __builtin_amdgcn_s_setprio(1); _Pragma("unroll") for (int m = 0; m < 4; ++m) _Pragma("unroll") for (int n = 0; n < 2; ++n) _Pragma("unroll") for (int k = 0; k < 2; ++k) \
        acc[ai][bj][m][n] = __builtin_amdgcn_mfma_f32_16x16x32_bf16(Bt[n][k], At[m][k], acc[ai][bj][m][n], 0, 0, 0); __builtin_amdgcn_s_setprio(0); } while (0)
#define PG8_WAIT_V(n) asm volatile("s_waitcnt vmcnt(" #n ")" ::: "memory")
#define PG8_WAIT_L(n) asm volatile("s_waitcnt lgkmcnt(" #n ")" ::: "memory")
#define PG8_BAR __builtin_amdgcn_s_barrier()
#define PG8_SCHED __builtin_amdgcn_sched_barrier(0)
    Unit cur, nxt; int ui = 0;
    if (!S.next(0, cur)) return;
    f32x4 acc[2][2][4][2];
#pragma unroll
    for (int a = 0; a < 2; ++a)
#pragma unroll
        for (int b = 0; b < 2; ++b)
#pragma unroll
            for (int m = 0; m < 4; ++m)
#pragma unroll
                for (int n = 0; n < 2; ++n) acc[a][b][m][n] = (f32x4){0.f, 0.f, 0.f, 0.f};
    bf16x8 At[4][2], B0[2][2], B1[2][2];
    const char* cA = (const char*)g.A + (size_t)cur.pm * tstep; const char* cB = (const char*)g.Bt + (size_t)cur.pn * tstep;
    S.a_ready(cur);
    if constexpr (SP2) {
        PG8_STAGE(PG8_SB(0, 0), cB, voffB); PG8_STAGE(PG8_SB(0, 1), cB + hstep, voffB); PG8_STAGE(PG8_SA(0, 0), cA, voffA); PG8_STAGE(PG8_SA(0, 1), cA + hstep, voffA);
        if (wr == 1) PG8_BAR;
        PG8_WAIT_V(2); PG8_BAR;
        PG8_STAGE(PG8_SB(1, 0), cB + kstep, voffB); PG8_STAGE(PG8_SA(1, 0), cA + kstep, voffA); PG8_STAGE(PG8_SB(1, 1), cB + hstep + kstep, voffB);
        PG8_WAIT_V(6); PG8_BAR;
    } else {
        PG8_STAGE(PG8_SB(0, 0), cB, voffB); PG8_STAGE(PG8_SA(0, 0), cA, voffA); PG8_STAGE(PG8_SB(0, 1), cB + hstep, voffB); PG8_STAGE(PG8_SA(0, 1), cA + hstep, voffA);
        if (wr == 1) PG8_BAR;
        PG8_WAIT_V(4); PG8_BAR;
        PG8_STAGE(PG8_SB(1, 0), cB + kstep, voffB); PG8_STAGE(PG8_SA(1, 0), cA + kstep, voffA); PG8_STAGE(PG8_SB(1, 1), cB + hstep + kstep, voffB);
        PG8_WAIT_V(6); PG8_BAR;
    }
    for (;;) {
        const bool has_next = S.next(ui + 1, nxt);
        const char* nA = has_next ? (const char*)g.A + (size_t)nxt.pm * tstep : cA; const char* nB = has_next ? (const char*)g.Bt + (size_t)nxt.pn * tstep : cB;
        for (int t = 0; t < nt; t += 2) {
            const bool last = (t == nt - 2);
            const char* a1 = cA + (size_t)(t + 1) * kstep;
            const char* a2 = last ? nA : cA + (size_t)(t + 2) * kstep; const char* b2 = last ? nB : cB + (size_t)(t + 2) * kstep;
            const char* a3 = a2 + kstep; const char* b3 = b2 + kstep;
            if (last && has_next) S.a_ready(nxt);
            if constexpr (SP2) {
            PG8_LDB(B0, 0, 0); PG8_LDB(B1, 0, 1); PG8_SCHED; PG8_LDA(At, 0, 0); PG8_STAGE(PG8_SA(1, 1), a1 + hstep, voffA);
            PG8_WAIT_V(8); PG8_WAIT_L(0); PG8_BAR; PG8_MMA(0, 0, At, B0); PG8_MMA(0, 1, At, B1); PG8_BAR; PG8_SCHED;
            PG8_LDA(At, 0, 1); PG8_STAGE(PG8_SB(0, 0), b2, voffB); PG8_STAGE(PG8_SB(0, 1), b2 + hstep, voffB); PG8_STAGE(PG8_SA(0, 0), a2, voffA);
            PG8_WAIT_V(8); PG8_WAIT_L(0); PG8_BAR; PG8_MMA(1, 0, At, B0); PG8_MMA(1, 1, At, B1); PG8_BAR; PG8_SCHED;
            PG8_LDB(B0, 1, 0); PG8_LDB(B1, 1, 1); PG8_SCHED; PG8_LDA(At, 1, 0); PG8_STAGE(PG8_SA(0, 1), a2 + hstep, voffA);
            PG8_WAIT_V(8); PG8_WAIT_L(0); PG8_BAR; PG8_MMA(0, 0, At, B0); PG8_MMA(0, 1, At, B1); PG8_BAR; PG8_SCHED;
            PG8_LDA(At, 1, 1); PG8_STAGE(PG8_SB(1, 0), b3, voffB); PG8_STAGE(PG8_SB(1, 1), b3 + hstep, voffB); PG8_STAGE(PG8_SA(1, 0), a3, voffA);
            PG8_WAIT_V(8); PG8_WAIT_L(0); PG8_BAR; PG8_MMA(1, 0, At, B0); PG8_MMA(1, 1, At, B1); PG8_BAR; PG8_SCHED;
            } else {
            PG8_LDB(B0, 0, 0); PG8_SCHED; PG8_LDA(At, 0, 0); PG8_STAGE(PG8_SA(1, 1), a1 + hstep, voffA);
            PG8_WAIT_L(8); PG8_BAR; PG8_WAIT_L(0); PG8_MMA(0, 0, At, B0); PG8_BAR; PG8_SCHED;
            PG8_LDB(B1, 0, 1); PG8_STAGE(PG8_SB(0, 0), b2, voffB);
            PG8_BAR; PG8_WAIT_L(0); PG8_MMA(0, 1, At, B1); PG8_BAR;
            PG8_LDA(At, 0, 1); PG8_STAGE(PG8_SA(0, 0), a2, voffA);
            PG8_BAR; PG8_WAIT_L(0); PG8_MMA(1, 0, At, B0); PG8_BAR; PG8_SCHED;
            PG8_STAGE(PG8_SB(0, 1), b2 + hstep, voffB);
            PG8_WAIT_V(6); PG8_BAR; PG8_MMA(1, 1, At, B1); PG8_BAR;
            PG8_LDB(B0, 1, 0); PG8_SCHED; PG8_LDA(At, 1, 0); PG8_STAGE(PG8_SA(0, 1), a2 + hstep, voffA);
            PG8_WAIT_L(8); PG8_BAR; PG8_WAIT_L(0); PG8_MMA(0, 0, At, B0); PG8_BAR; PG8_SCHED;
            PG8_LDB(B1, 1, 1); PG8_STAGE(PG8_SB(1, 0), b3, voffB);
            PG8_BAR; PG8_WAIT_L(0); PG8_MMA(0, 1, At, B1); PG8_BAR;
            PG8_LDA(At, 1, 1); PG8_STAGE(PG8_SA(1, 0), a3, voffA);
            PG8_BAR; PG8_WAIT_L(0); PG8_MMA(1, 0, At, B0); PG8_BAR; PG8_SCHED;
            PG8_STAGE(PG8_SB(1, 1), b3 + hstep, voffB);
            PG8_WAIT_V(6); PG8_BAR; PG8_MMA(1, 1, At, B1); PG8_BAR;
            }
        }
        if constexpr (ALIGN_EPI) { if (wr == 0) PG8_BAR; }
        if constexpr (!Epi::AFTER_DRAIN) { E(acc, cur, wr, wc, fr, fq); S.done(cur); }
        if (!has_next) break;
#pragma unroll
        for (int a = 0; a < 2; ++a)
#pragma unroll
            for (int b = 0; b < 2; ++b)
#pragma unroll
                for (int m = 0; m < 4; ++m)
#pragma unroll
                    for (int n = 0; n < 2; ++n) acc[a][b][m][n] = (f32x4){0.f, 0.f, 0.f, 0.f};
        cur = nxt; cA = nA; cB = nB; ++ui;
        if constexpr (ALIGN_EPI) { if (wr == 1) PG8_BAR; }
    }
    PG8_WAIT_V(0);
    if constexpr (!ALIGN_EPI) { if (wr == 0) PG8_BAR; }
    PG8_BAR;
    if constexpr (Epi::AFTER_DRAIN) { E.fused(acc, cur, wr, wc, fr, fq, lds, wid, lane); S.done(cur); }
#undef PG8_SA
#undef PG8_SB
#undef PG8_STAGE
#undef PG8_LDA
#undef PG8_LDB
#undef PG8_MMA
#undef PG8_WAIT_V
#undef PG8_WAIT_L
#undef PG8_BAR
#undef PG8_SCHED
}
}
#include <hip/hip_bf16.h>
#include <cmath>
namespace attn_body {
using bf16=__hip_bfloat16;
using bf16x8=__attribute__((ext_vector_type(8)))short;
using s16x4=__attribute__((ext_vector_type(4)))short;
using f32x16=__attribute__((ext_vector_type(16)))float;
using u32x4=__attribute__((ext_vector_type(4)))unsigned;
constexpr int BATCH=8,NHEAD=8,SEQ=2048,D=64,DM=NHEAD*D,OPITCH=1024,BT_OFF=256,BT_N=2304;
constexpr int NW=8,QBLK=32,QB=QBLK*NW,KVBLK=64,NQB=SEQ/QB;
constexpr int ATTN_PITCH=DM, ATTN_UNIT_ROWS=QB;
__device__ __forceinline__ int crow(int r,int hi){return (r&3)+8*(r>>2)+4*hi;}
#define SBAR() __builtin_amdgcn_sched_barrier(0)
__device__ __forceinline__ void cmask(f32x16&p0,f32x16&p1,int jb,int qrel,int hi){
  const float NEG=-INFINITY; int kb=64*jb+4*hi;
  #pragma unroll
  for(int r=0;r<16;++r){int kv=kb+(r&3)+8*(r>>2); if(kv>qrel)p0[r]=NEG; if(kv+32>qrel)p1[r]=NEG;}
}

constexpr int NSLOT=3, SLOTB=8192;
constexpr int LDS_K=0, LDS_V=NSLOT*SLOTB, LDS_WS=2*NSLOT*SLOTB, LDS_OST=LDS_WS+NW*64*4, LDS_BYTES=LDS_OST+NW*4096;
constexpr float C2=0.125f*1.4426950408889634f;
__device__ __forceinline__ void glds16(const void*gsrc,unsigned lds_dst){unsigned keep;
  asm volatile("s_mov_b32 %0, m0\n\ts_mov_b32 m0, %2\n\ts_nop 0\n\tglobal_load_lds_dwordx4 %1, off\n\ts_mov_b32 m0, %0":"=&s"(keep):"v"(gsrc),"s"(lds_dst):"memory");}
__device__ __forceinline__ float max3f(float a,float b,float c){float r;asm("v_max3_f32 %0, %1, %2, %3":"=v"(r):"v"(a),"v"(b),"v"(c));return r;}
__device__ __forceinline__ float max2f(float a,float b){float r;asm("v_max_f32_e32 %0, %1, %2":"=v"(r):"v"(a),"v"(b));return r;}
__device__ __forceinline__ float fadd_s(float a,float b){float r;asm("v_add_f32_e32 %0, %1, %2":"=v"(r):"v"(a),"v"(b));return r;}
__device__ __forceinline__ float fsub_s(float a,float b){float r;asm("v_sub_f32_e32 %0, %1, %2":"=v"(r):"v"(a),"v"(b));return r;}
typedef float f32x2_t __attribute__((ext_vector_type(2))); typedef __bf16 bf16x2_t __attribute__((ext_vector_type(2)));
__device__ __forceinline__ unsigned cvtpk_s(float lo,float hi){f32x2_t v={lo,hi};bf16x2_t b=__builtin_convertvector(v,bf16x2_t);return __builtin_bit_cast(unsigned,b);}
#define WAIT_BAR(N) asm volatile("s_waitcnt vmcnt(" #N ") lgkmcnt(0)\n\ts_barrier":::"memory")

__device__ __forceinline__ void qkt(f32x16&p0,f32x16&p1,const char*Kslot,const bf16x8*qr,const f32x16&negm,int r32,int hi){
  const char*kb=Kslot+hi*1024+r32*16;
  #pragma unroll
  for(int d0=0;d0<4;++d0){
    const bf16x8 b0=*reinterpret_cast<const bf16x8*>(kb+d0*2048);
    const bf16x8 b1=*reinterpret_cast<const bf16x8*>(kb+d0*2048+512);
    if(d0==0){p0=__builtin_amdgcn_mfma_f32_32x32x16_bf16(b0,qr[0],negm,0,0,0);p1=__builtin_amdgcn_mfma_f32_32x32x16_bf16(b1,qr[0],negm,0,0,0);}
    else{p0=__builtin_amdgcn_mfma_f32_32x32x16_bf16(b0,qr[d0],p0,0,0,0);p1=__builtin_amdgcn_mfma_f32_32x32x16_bf16(b1,qr[d0],p1,0,0,0);}}
}
typedef __attribute__((address_space(3))) const char* lds_cptr;
typedef short v4i16_t __attribute__((ext_vector_type(4)));
__device__ __forceinline__ void kload8(bf16x8*kf,lds_cptr kp){
  kf[0]=*(const __attribute__((address_space(3))) bf16x8*)(kp);      kf[1]=*(const __attribute__((address_space(3))) bf16x8*)(kp+512);
  kf[2]=*(const __attribute__((address_space(3))) bf16x8*)(kp+2048); kf[3]=*(const __attribute__((address_space(3))) bf16x8*)(kp+2560);
  kf[4]=*(const __attribute__((address_space(3))) bf16x8*)(kp+4096); kf[5]=*(const __attribute__((address_space(3))) bf16x8*)(kp+4608);
  kf[6]=*(const __attribute__((address_space(3))) bf16x8*)(kp+6144); kf[7]=*(const __attribute__((address_space(3))) bf16x8*)(kp+6656);
}
__device__ __forceinline__ void kload2(bf16x8*kf,lds_cptr kp,int j){ kf[2*j]=*(const __attribute__((address_space(3))) bf16x8*)(kp+j*2048); kf[2*j+1]=*(const __attribute__((address_space(3))) bf16x8*)(kp+j*2048+512); }
__device__ __forceinline__ s16x4 vtr(lds_cptr p){ return __builtin_bit_cast(s16x4,__builtin_amdgcn_ds_read_tr16_b64_v4i16((__attribute__((address_space(3))) v4i16_t*)p)); }
__device__ __forceinline__ float rowmax(const f32x16&p0,const f32x16&p1){
  float a=max3f(p0[0],p0[1],p1[0]),b=max3f(p0[2],p0[3],p1[1]);a=max3f(a,p1[2],p1[3]);
  #pragma unroll
  for(int r=4;r<16;r+=4){a=max3f(a,p0[r],p0[r+1]);b=max3f(b,p0[r+2],p0[r+3]);a=max3f(a,p1[r],p1[r+1]);b=max3f(b,p1[r+2],p1[r+3]);}
  const float m=max2f(a,b);
  auto rr=__builtin_amdgcn_permlane32_swap(__float_as_uint(m),__float_as_uint(m),false,false);
  return max2f(__uint_as_float(rr[0]),__uint_as_float(rr[1]));
}
__device__ __forceinline__ void pv(f32x16*o,int vb,bf16x8 pa0,bf16x8 pa1,bf16x8 pa2,bf16x8 pa3){
  #pragma unroll
  for(int d0=0;d0<2;++d0){s16x4 lo[4],hi[4];
    #pragma unroll
    for(int ks=0;ks<4;++ks){
      asm volatile("ds_read_b64_tr_b16 %0,%1 offset:%c2":"=&v"(lo[ks]):"v"(vb),"i"(d0*4096+ks*1024):"memory");
      asm volatile("ds_read_b64_tr_b16 %0,%1 offset:%c2":"=&v"(hi[ks]):"v"(vb),"i"(d0*4096+ks*1024+512):"memory");}
    asm volatile("s_waitcnt lgkmcnt(0)":::"memory");SBAR();
    #define PK(k) (bf16x8){lo[k][0],lo[k][1],lo[k][2],lo[k][3],hi[k][0],hi[k][1],hi[k][2],hi[k][3]}
    o[d0]=__builtin_amdgcn_mfma_f32_32x32x16_bf16(pa0,PK(0),o[d0],0,0,0);
    o[d0]=__builtin_amdgcn_mfma_f32_32x32x16_bf16(pa1,PK(1),o[d0],0,0,0);
    o[d0]=__builtin_amdgcn_mfma_f32_32x32x16_bf16(pa2,PK(2),o[d0],0,0,0);
    o[d0]=__builtin_amdgcn_mfma_f32_32x32x16_bf16(pa3,PK(3),o[d0],0,0,0);
    #undef PK
  }
}

#ifndef ATTN_STORE16
#define ATTN_STORE16(p,v) (*(u32x4*)(p)=(v))
#endif
template<int THRL> __device__ __forceinline__ void attn_unit(int b,int h,int qb,const bf16*Q,const bf16*__restrict__ K,const bf16*__restrict__ V,bf16*O,char*shm,const __attribute__((address_space(3))) float* btab){
  int tid_l=threadIdx.x; asm volatile("":"+v"(tid_l)); const int tid=tid_l,lane=tid&63,r32=lane&31,hi=lane>>5; const int wid=__builtin_amdgcn_readfirstlane(tid>>6);
  const long rowbase=(long)b*SEQ; const int q0=qb*QB;
  const bf16*Qw=Q+(rowbase+q0+wid*QBLK)*DM+h*D;
  const bf16*Kh=K+rowbase*DM+h*D,*Vh=V+rowbase*DM+h*D;
  const unsigned lds0=(unsigned)(uintptr_t)shm;
  float*wsf=(float*)(shm+LDS_WS)+wid*64;
  const bf16*ksrc=Kh+(long)lane*DM+wid*8;
  const bf16*vsrc=Vh+(long)(16*(wid&3)+(lane>>2))*DM+(wid>>2)*32+(lane&3)*8;
  const unsigned kdst=lds0+LDS_K+wid*1024, vdst=lds0+LDS_V+wid*1024;
  #define DMA_K(t,slot) glds16(ksrc+(long)(t)*KVBLK*DM,(unsigned)__builtin_amdgcn_readfirstlane(kdst+(slot)))
  #define DMA_V(t,slot) glds16(vsrc+(long)(t)*KVBLK*DM,(unsigned)__builtin_amdgcn_readfirstlane(vdst+(slot)))
  const int vb0=(int)(lds0+LDS_V)+((lane>>4)&1)*32+(lane&3)*8+(4*hi+((lane&15)>>2))*64;
  const char*Kbase=shm+LDS_K; bf16x8 kf[8];
  const lds_cptr shm3=(lds_cptr)shm; const lds_cptr kp0=shm3+LDS_K+hi*1024+r32*16; const lds_cptr vp0=shm3+LDS_V+((lane>>4)&1)*32+(lane&3)*8+(4*hi+((lane&15)>>2))*64;
  const int NT=(q0+QB)/KVBLK;
  DMA_K(0,0);DMA_V(0,0);DMA_K(1,SLOTB);
  bf16x8 qr[4];
  #pragma unroll
  for(int d0=0;d0<4;++d0)qr[d0]=*reinterpret_cast<const bf16x8*>(&Qw[(long)r32*DM+d0*16+hi*8]);
  float mhat=0.f,l_reg=0.f;f32x16 o[2];o[0]=f32x16{};o[1]=f32x16{};const f32x16 zero16=f32x16{};
    const int qabs=q0+wid*QBLK+r32;
  #define CMASK(P0,P1,t) do{ const __attribute__((address_space(3))) float* bp_=btab+(BT_OFF-59+qabs-64*(t)-4*hi); \
    _Pragma("unroll") for(int r=0;r<16;++r){ const int x_=(r&3)+8*(r>>2); P0[r]=fadd_s(P0[r],fsub_s(bp_[59-x_],mhat)); P1[r]=fadd_s(P1[r],fsub_s(bp_[27-x_],mhat)); } }while(0)
  bool resc=false;
  #define START(P0,P1) do{ const float rm=rowmax(P0,P1); resc=false; \
    { const float dl=rm; mhat=fadd_s(mhat,dl); \
      _Pragma("unroll") for(int r=0;r<16;++r){P0[r]=fsub_s(P0[r],dl);P1[r]=fsub_s(P1[r],dl);} \
      } \
    _Pragma("unroll") for(int r=0;r<16;++r)P0[r]=__builtin_amdgcn_exp2f(P0[r]); }while(0)
  #define RESC() do{ if(resc){ asm volatile("s_waitcnt lgkmcnt(0)":::"memory"); \
      _Pragma("unroll") for(int d_=0;d_<2;++d_) _Pragma("unroll") for(int r=0;r<16;++r)o[d_][r]*=wsf[crow(r,hi)]; } }while(0)
  f32x16 pA0,pA1,pB0,pB1;
  int sl_prev=0,sl_cur=0,sl_next=SLOTB;
  #define ROT() do{sl_prev=sl_cur;sl_cur=sl_next;sl_next=(sl_next==(NSLOT-1)*SLOTB)?0:sl_next+SLOTB;}while(0)
  DMA_K(2,2*SLOTB);
  WAIT_BAR(3);
  qkt(pA0,pA1,Kbase,qr,zero16,r32,hi);asm volatile("s_nop 15\n\ts_nop 7":"+v"(pA0),"+v"(pA1));CMASK(pA0,pA1,0);
  START(pA0,pA1);
  _Pragma("unroll") for(int r=0;r<16;++r)pA1[r]=__builtin_amdgcn_exp2f(pA1[r]);
  WAIT_BAR(0);
  DMA_K(3,0);DMA_V(1,SLOTB);
  ROT();
  kload8(kf,kp0+sl_cur);
  WAIT_BAR(2);
  s16x4 vlo[8],vhi[8]; u32x4 pw0,pw1,pw2,pw3;
  #define PKW(P,B) cvtpk_s(P[B],P[B+1])
  #define PAF(k) __builtin_bit_cast(bf16x8,pw##k)
  #define VFR(i) (bf16x8){vlo[i][0],vlo[i][1],vlo[i][2],vlo[i][3],vhi[i][0],vhi[i][1],vhi[i][2],vhi[i][3]}
  #define PIN(x) asm volatile("":"+v"(x))
  #define MX3(a,b,c) __builtin_fmaxf(__builtin_fmaxf((a),(b)),(c))
  #define GAPA(MF,A0,A1,A2,A3,W0,W1,PW) do{ MF; sacc+=A0; sacc+=A1; sacc+=A2; sacc+=A3; PIN(sacc); W0; W1; PIN(PW); SBAR(); }while(0)
  #define EX(v) __builtin_amdgcn_exp2f(v)
  #define GAPB(MF,X,B) do{ MF; X[B]=EX(X[B]); X[B+1]=EX(X[B+1]); X[B+2]=EX(X[B+2]); X[B+3]=EX(X[B+3]); PIN(X); SBAR(); }while(0)
  #define VRD(i) do{ vlo[i]=vtr(vp_+(((i)>>2)*4096+((i)&3)*1024)); vhi[i]=vtr(vp_+(((i)>>2)*4096+((i)&3)*1024+512)); }while(0)
  #define KRD(G,j) do{ if(G){ kload2(kf,kp0+sl_next,j); SBAR(); } }while(0)
  #define STEP(C0,C1,P0,P1,t,GK,GV,GL) do{ SBAR(); \
    const lds_cptr vp_=vp0+sl_prev; \
    VRD(0); SBAR(); float sacc=(P0[0]+P0[1]); \
    GAPA(C0=__builtin_amdgcn_mfma_f32_32x32x16_bf16(kf[0],qr[0],zero16,0,0,0), P0[2],P0[3],P0[4],P0[5],     pw0[0]=PKW(P0,0), pw0[1]=PKW(P0,2), pw0); \
    VRD(4); SBAR(); GAPA(C1=__builtin_amdgcn_mfma_f32_32x32x16_bf16(kf[1],qr[0],zero16,0,0,0), P0[6],P0[7],P0[8],P0[9],     pw0[2]=PKW(P0,4), pw0[3]=PKW(P0,6), pw0); \
    VRD(1); SBAR(); GAPA(C0=__builtin_amdgcn_mfma_f32_32x32x16_bf16(kf[2],qr[1],C0,0,0,0),   P0[10],P0[11],P0[12],P0[13], pw1[0]=PKW(P0,8), pw1[1]=PKW(P0,10), pw1); \
    VRD(5); SBAR(); GAPA(C1=__builtin_amdgcn_mfma_f32_32x32x16_bf16(kf[3],qr[1],C1,0,0,0),   P0[14],P0[15],P1[0],P1[1],   pw1[2]=PKW(P0,12),pw1[3]=PKW(P0,14), pw1); \
    VRD(2); SBAR(); GAPA(C0=__builtin_amdgcn_mfma_f32_32x32x16_bf16(kf[4],qr[2],C0,0,0,0),   P1[2],P1[3],P1[4],P1[5],     pw2[0]=PKW(P1,0), pw2[1]=PKW(P1,2), pw2); \
    VRD(6); SBAR(); GAPA(C1=__builtin_amdgcn_mfma_f32_32x32x16_bf16(kf[5],qr[2],C1,0,0,0),   P1[6],P1[7],P1[8],P1[9],     pw2[2]=PKW(P1,4), pw2[3]=PKW(P1,6), pw2); \
    VRD(3); SBAR(); GAPA(C0=__builtin_amdgcn_mfma_f32_32x32x16_bf16(kf[6],qr[3],C0,0,0,0),   P1[10],P1[11],P1[12],P1[13], pw3[0]=PKW(P1,8), pw3[1]=PKW(P1,10), pw3); \
    VRD(7); SBAR(); GAPA(C1=__builtin_amdgcn_mfma_f32_32x32x16_bf16(kf[7],qr[3],C1,0,0,0),   P1[14],P1[15],0.f,0.f,       pw3[2]=PKW(P1,12),pw3[3]=PKW(P1,14), pw3); \
    l_reg+=sacc; \
    if(GK){DMA_K((t)+3,sl_cur);} if(GV){DMA_V((t)+1,sl_next);} \
    CMASK(C0,C1,t); \
    { float a=MX3(C0[0],C0[1],C1[0]),b=MX3(C0[2],C0[3],C1[1]); a=MX3(a,C1[2],C1[3]); \
      _Pragma("unroll") for(int r=4;r<16;r+=4){a=MX3(a,C0[r],C0[r+1]);b=MX3(b,C0[r+2],C0[r+3]);a=MX3(a,C1[r],C1[r+1]);b=MX3(b,C1[r+2],C1[r+3]);} \
      float rm=__builtin_fmaxf(a,b); { auto rr=__builtin_amdgcn_permlane32_swap(__float_as_uint(rm),__float_as_uint(rm),false,false); rm=__builtin_fmaxf(__uint_as_float(rr[0]),__uint_as_float(rr[1])); } \
      resc=false; \
      if(__builtin_expect(__any(rm>(float)THRL),0)){ const float dl=__builtin_fmaxf(rm,0.f); mhat+=dl; \
        _Pragma("unroll") for(int r=0;r<16;++r){C0[r]-=dl;C1[r]-=dl;} \
        const float f=__builtin_amdgcn_exp2f(-dl); l_reg*=f; if(hi==0)wsf[r32]=f; resc=true; } } \
    SBAR(); \
    GAPB(o[0]=__builtin_amdgcn_mfma_f32_32x32x16_bf16(PAF(0),VFR(0),o[0],0,0,0), C0,0); \
    GAPB(o[1]=__builtin_amdgcn_mfma_f32_32x32x16_bf16(PAF(0),VFR(4),o[1],0,0,0), C0,4); \
    KRD(GL,0); GAPB(o[0]=__builtin_amdgcn_mfma_f32_32x32x16_bf16(PAF(1),VFR(1),o[0],0,0,0), C0,8); \
    KRD(GL,1); GAPB(o[1]=__builtin_amdgcn_mfma_f32_32x32x16_bf16(PAF(1),VFR(5),o[1],0,0,0), C0,12); \
    KRD(GL,2); GAPB(o[0]=__builtin_amdgcn_mfma_f32_32x32x16_bf16(PAF(2),VFR(2),o[0],0,0,0), C1,0); \
    KRD(GL,3); GAPB(o[1]=__builtin_amdgcn_mfma_f32_32x32x16_bf16(PAF(2),VFR(6),o[1],0,0,0), C1,4); \
    GAPB(o[0]=__builtin_amdgcn_mfma_f32_32x32x16_bf16(PAF(3),VFR(3),o[0],0,0,0), C1,8); \
    GAPB(o[1]=__builtin_amdgcn_mfma_f32_32x32x16_bf16(PAF(3),VFR(7),o[1],0,0,0), C1,12); \
    }while(0)
  int t=1;
  for(;t+5<NT;t+=2){
    STEP(pB0,pB1,pA0,pA1,t,true,true,true);     WAIT_BAR(2); RESC(); ROT();
    STEP(pA0,pA1,pB0,pB1,t+1,true,true,true);   WAIT_BAR(2); RESC(); ROT();
  }
  #define ENDW(tt) do{ if((tt)+3<NT){WAIT_BAR(2);} else if((tt)+2<NT){WAIT_BAR(1);} else {WAIT_BAR(0);} }while(0)
  for(;t+1<NT;t+=2){
    STEP(pB0,pB1,pA0,pA1,t,(t+3<NT),(t+1<NT),(t+1<NT));       ENDW(t);   RESC(); ROT();
    STEP(pA0,pA1,pB0,pB1,t+1,(t+4<NT),(t+2<NT),(t+2<NT));     ENDW(t+1); RESC(); ROT();
  }
  STEP(pB0,pB1,pA0,pA1,NT-1,false,false,false); RESC();
  { float sacc=pB0[0]+pB0[1]; _Pragma("unroll") for(int r=2;r<16;++r)sacc+=pB0[r]; _Pragma("unroll") for(int r=0;r<16;++r)sacc+=pB1[r]; l_reg+=sacc;
    pw0=(u32x4){PKW(pB0,0),PKW(pB0,2),PKW(pB0,4),PKW(pB0,6)};pw1=(u32x4){PKW(pB0,8),PKW(pB0,10),PKW(pB0,12),PKW(pB0,14)};pw2=(u32x4){PKW(pB1,0),PKW(pB1,2),PKW(pB1,4),PKW(pB1,6)};pw3=(u32x4){PKW(pB1,8),PKW(pB1,10),PKW(pB1,12),PKW(pB1,14)};
    SBAR(); pv(o,vb0+sl_cur,PAF(0),PAF(1),PAF(2),PAF(3)); }
  #undef PKW
  #undef PAF
  #undef VFR
  #undef PIN
  #undef MX3
  #undef GAPA
  #undef GAPB
  #undef EX
  #undef VRD
  #undef KRD
  #undef STEP
  #undef ENDW
  {auto rr=__builtin_amdgcn_permlane32_swap(__float_as_uint(l_reg),__float_as_uint(l_reg),false,false);l_reg=__uint_as_float(rr[0])+__uint_as_float(rr[1]);}
  if(hi==0)wsf[32+r32]=l_reg;asm volatile("s_waitcnt lgkmcnt(0)":::"memory");
  float rli[16];
  #pragma unroll
  for(int r=0;r<16;++r)rli[r]=__builtin_amdgcn_rcpf(wsf[32+crow(r,hi)]);
  bf16*Ow=O+(rowbase+q0+wid*QBLK)*OPITCH+h*D;
  { bf16*stg=(bf16*)(shm+LDS_OST)+wid*2048;
    #pragma unroll
    for(int r=0;r<16;++r){const int orow=crow(r,hi);
      #pragma unroll
      for(int d0=0;d0<2;++d0)stg[orow*64+d0*32+r32]=__float2bfloat16(o[d0][r]*rli[r]);}
    asm volatile("s_waitcnt lgkmcnt(0)":::"memory");
    #pragma unroll
    for(int i=0;i<4;++i){const int row=i*8+(lane>>3),ch=lane&7; const u32x4 v=*(const u32x4*)(stg+row*64+ch*8); ATTN_STORE16(Ow+(long)row*OPITCH+ch*8,v);} }
  asm volatile("s_waitcnt lgkmcnt(0)\n\ts_barrier":::"memory");
  #undef DMA_K
  #undef DMA_V
  #undef CMASK
  #undef START
  #undef RESC
  #undef ROT
}
constexpr int ATTN_LDS_BYTES=LDS_BYTES;
struct AttnTensors { const bf16* Q; const bf16* K; const bf16* V; bf16* O; };
struct AttnUnit { int bh; int qb; };
struct StaticOrder {
  int vcu;
  __device__ __forceinline__ explicit StaticOrder(int grid,int block):vcu((block%8)*(grid/8)+block/8){}
  __device__ __forceinline__ bool next(int i,AttnUnit&u)const{ if(i>=2)return false; const int s=vcu&3; u.bh=vcu>>2; u.qb=(i==0)?s:7-s; return true; }
  __device__ __forceinline__ void a_ready(const AttnUnit&)const{}
  __device__ __forceinline__ void done(const AttnUnit&)const{}
};
constexpr int BT_LDS_OFF=86016, ATTN_LDS_TOTAL=BT_LDS_OFF+BT_N*4;
__device__ __forceinline__ int t5b(int n){ if(n<16)return n; int b=16; b+=(n>=22);b+=(n>=30);b+=(n>=40);b+=(n>=54);b+=(n>=73);b+=(n>=99);b+=(n>=134);b+=(n>=182);b+=(n>=246);b+=(n>=332);b+=(n>=450);b+=(n>=609);b+=(n>=825);b+=(n>=1117);b+=(n>=1513); return b; }
__device__ __forceinline__ void build_btab(__attribute__((address_space(3))) float* bt,const float*relb,int h){
  for(int i=threadIdx.x;i<BT_N;i+=NW*64){ const int dl=i-BT_OFF; float v=-INFINITY;
    if(dl>=0){ const int c=(dl<=128?1:0)+(((dl&3)==0&&dl<=512)?1:0)+(((dl&15)==0&&dl<=2048)?1:0);
      if(c>0) v=(relb[t5b(dl)*NHEAD+h]+(c==1?0.f:(c==2?0.6931471805599453f:1.0986122886681098f)))*1.4426950408889634f; }
    bt[i]=v; }
}
template<class Sched,int THRL=8> __device__ __forceinline__ void attn_phase(char*lds,const AttnTensors&T,const float*relb,const Sched&S){
  AttnUnit u; int cur_h=-1;
  __attribute__((address_space(3))) float* bt=(__attribute__((address_space(3))) float*)((__attribute__((address_space(3))) char*)lds+BT_LDS_OFF);
  for(int i=0;S.next(i,u);++i){ S.a_ready(u);
    const int h=u.bh%NHEAD;
    if(h!=cur_h){ asm volatile("s_waitcnt lgkmcnt(0)\n\ts_barrier":::"memory"); build_btab(bt,relb,h); asm volatile("s_waitcnt lgkmcnt(0)\n\ts_barrier":::"memory"); cur_h=h; }
    attn_unit<THRL>(u.bh/NHEAD,u.bh%NHEAD,u.qb,T.Q,T.K,T.V,T.O,lds,bt); S.done(u); }
}
#undef SBAR
#undef WAIT_BAR
}
#define GAS __attribute__((address_space(1)))
#define LAS __attribute__((address_space(3)))
typedef unsigned short bf16;
typedef unsigned v4u __attribute__((ext_vector_type(4)));
typedef float f32x4 __attribute__((ext_vector_type(4)));
typedef short bf16x8 __attribute__((ext_vector_type(8)));
typedef GAS unsigned gu32;
typedef GAS unsigned long long gu64;
#define RLX_AGENT __ATOMIC_RELAXED, __HIP_MEMORY_SCOPE_AGENT
#define LDS_WAIT() asm volatile("s_waitcnt lgkmcnt(0)" ::: "memory")
#define VM_WAIT() asm volatile("s_waitcnt vmcnt(0)" ::: "memory")
__device__ __forceinline__ unsigned long long rt() { return __builtin_amdgcn_s_memrealtime(); }
__device__ __forceinline__ unsigned f2bf(float f) { unsigned u = __builtin_bit_cast(unsigned, f); return (u + 0x7fffu + ((u >> 16) & 1u)) >> 16; }
__device__ __forceinline__ unsigned pk2(float lo, float hi) { return f2bf(lo) | (f2bf(hi) << 16); }
#define XB_TMO      128
#define XB_XCNT(j)  (256  + 64 * (j))
#define XB_XSUB(j)  (1280 + 64 * (j))
#define XB_XGEN(j)  (2304 + 64 * (j))
#define XB_TOP      3328
#define XB_TOPGEN   3392
#define XCD_BAR_WORDS 3456
#define XB_SPIN_CAP (1u << 18)

__device__ __forceinline__ unsigned xb_ld(unsigned* p)              { return __hip_atomic_load(p, __ATOMIC_RELAXED, __HIP_MEMORY_SCOPE_AGENT); }
__device__ __forceinline__ unsigned xb_add(unsigned* p, unsigned v) { return __hip_atomic_fetch_add(p, v, __ATOMIC_RELAXED, __HIP_MEMORY_SCOPE_AGENT); }
__device__ __forceinline__ unsigned xb_xcc_id() { return (unsigned)__builtin_amdgcn_s_getreg((3 << 11) | 20) & 0xFu; }
#define XB_SPIN(cond, bar) do { unsigned _sp = 0; while (cond) { __builtin_amdgcn_s_sleep(1); \
    if ((++_sp & 255u) == 0u) { if (xb_ld(&(bar)[XB_TMO])) break; if (_sp > XB_SPIN_CAP) { atomicAdd(&(bar)[XB_TMO], 1u); break; } } } } while (0)

struct XcdBarrier {
    unsigned* bar; unsigned x;
    volatile LAS unsigned* st;
};

__device__ __forceinline__ XcdBarrier xcd_barrier_post(unsigned* bar, volatile LAS unsigned* st) {
    XcdBarrier b; b.bar = bar; b.x = xb_xcc_id(); b.st = st;
    if (threadIdx.x == 0) (void)xb_add(&bar[XB_XCNT(b.x)], 1u);
    return b;
}
__device__ __forceinline__ void xcd_barrier_complete(unsigned* bar, unsigned x, unsigned& nloc, unsigned& nx) {
    const unsigned G = gridDim.x * gridDim.y * gridDim.z;
    unsigned sum, cnt, mine, sp = 0u;
    for (;;) {
        sum = 0u; cnt = 0u; mine = 0u;
#pragma unroll
        for (unsigned j = 0; j < 16; ++j) { const unsigned c = xb_ld(&bar[XB_XCNT(j)]); sum += c; cnt += (c > 0u) ? 1u : 0u; mine = (j == x) ? c : mine; }
        if (sum == G) break;
        __builtin_amdgcn_s_sleep(1);
        if ((++sp & 255u) == 0u) { if (xb_ld(&bar[XB_TMO])) break; if (sp > XB_SPIN_CAP) { atomicAdd(&bar[XB_TMO], 1u); break; } }
    }
    nloc = mine > 0u ? mine : 1u; nx = cnt > 0u ? cnt : 1u;
}

__device__ __forceinline__ void xcd_barrier(const XcdBarrier& b) {
    asm volatile("s_waitcnt vmcnt(0)" ::: "memory");
    __syncthreads();
    if (threadIdx.x == 0) {
        unsigned* bar = b.bar;
        __builtin_amdgcn_s_waitcnt(0);
        unsigned nloc = b.st[0], nx = b.st[1];
        if (nloc == 0u) { xcd_barrier_complete(bar, b.x, nloc, nx); b.st[0] = nloc; b.st[1] = nx; }
        const unsigned old = xb_add(&bar[XB_XSUB(b.x)], 1u);
        const unsigned gen = old / nloc;
        if (old + 1u == (gen + 1u) * nloc) {
            __builtin_amdgcn_fence(__ATOMIC_RELEASE, "agent");
            asm volatile("s_waitcnt vmcnt(0)" ::: "memory");
            const unsigned og = xb_add(&bar[XB_TOP], 1u);
            const unsigned tg = og / nx;
            if (og + 1u == (tg + 1u) * nx) xb_add(&bar[XB_TOPGEN], 1u);
            else XB_SPIN(xb_ld(&bar[XB_TOPGEN]) == tg, bar);
            __builtin_amdgcn_fence(__ATOMIC_ACQUIRE, "agent");
            xb_add(&bar[XB_XGEN(b.x)], 1u);
            asm volatile("s_waitcnt vmcnt(0)" ::: "memory");
        } else {
            XB_SPIN(xb_ld(&bar[XB_XGEN(b.x)]) == gen, bar);
            __builtin_amdgcn_fence(__ATOMIC_ACQUIRE, "agent");
            asm volatile("s_waitcnt vmcnt(0)" ::: "memory");
        }
    }
    __syncthreads();
}
namespace gdn {
#define GLAS __attribute__((address_space(3)))
typedef short bf16x8 __attribute__((ext_vector_type(8)));
typedef float f32x16 __attribute__((ext_vector_type(16)));
typedef float f32x2_t __attribute__((ext_vector_type(2))); typedef __bf16 bf16x2_t __attribute__((ext_vector_type(2)));
typedef unsigned u32x4 __attribute__((ext_vector_type(4)));
typedef unsigned u32x2 __attribute__((ext_vector_type(2)));
typedef float f32x4 __attribute__((ext_vector_type(4)));
#define GDI __device__ __forceinline__
#define GMFMA(a, b, c) __builtin_amdgcn_mfma_f32_32x32x16_bf16((a), (b), (c), 0, 0, 0)
GDI unsigned cvtpk(float lo, float hi) { f32x2_t v = {lo, hi}; bf16x2_t b = __builtin_convertvector(v, bf16x2_t); return __builtin_bit_cast(unsigned, b); }
GDI unsigned short cvt1(float x) { return (unsigned short)(cvtpk(x, 0.f) & 0xffffu); }
GDI constexpr int crow(int r, int hi) { return (r & 3) + 8 * (r >> 2) + 4 * hi; }
template <class T> GDI T* uni_ptr(T* p) { const unsigned long long u = (unsigned long long)p; const unsigned lo = __builtin_amdgcn_readfirstlane((unsigned)u), hi = __builtin_amdgcn_readfirstlane((unsigned)(u >> 32)); return (T*)(((unsigned long long)hi << 32) | lo); }
GDI float rdl(float v, int l) { return __builtin_bit_cast(float, __builtin_amdgcn_readlane(__builtin_bit_cast(int, v), l)); }
#define GDPP(x, ctrl, rmask) __builtin_bit_cast(float, __builtin_amdgcn_update_dpp(0, __builtin_bit_cast(int, (x)), (ctrl), (rmask), 0xF, false))
GDI float wsum(float v) {
    v += GDPP(v, 0xB1, 0xF); v += GDPP(v, 0x4E, 0xF); v += GDPP(v, 0x141, 0xF); v += GDPP(v, 0x140, 0xF);
    v += GDPP(v, 0x142, 0xA); v += GDPP(v, 0x143, 0xC);
    return rdl(v, 63);
}
constexpr int R_NEGW = 0, R_Q = 8192, R_INTRA = 16384, R_KT = 24576, R_U = 32768, R_SC = 49152, R_BYTES = 50176, R_TMP = 50176, R_STRIDE = 66560;
constexpr int NCH = 32, CH = 64, NIN_P = 3840, C_GQKV_ = 1536, C_B_ = 3584, C_A_ = 3592, SEQ_ = 2048;
GDI int frag_off(int R, int K) { return ((((R >> 5) * 4 + (K >> 4)) * 2 + ((K >> 2) & 1)) * 32 + (R & 31)) * 16 + ((((K >> 3) & 1) * 4) + (K & 3)) * 2; }
GDI int img_off(int row, int d) { return row * 128 + ((((d >> 3) ^ (row & 7))) << 4) + (d & 7) * 2; }
GDI bf16x8 img_frag(const GLAS unsigned char* img, int row0, int ks, int lane) {
    const int r = lane & 31, hh = lane >> 5, row = row0 + r;
    return *(const GLAS bf16x8*)(img + row * 128 + ((((2 * ks + hh) ^ (row & 7))) << 4));
}

GDI void pre_unit(int unit, const float* __restrict__ P, const float* __restrict__ convw, const float* __restrict__ alog, const float* __restrict__ dtb, unsigned char* __restrict__ rec_base, GLAS unsigned char* lw, int lane_in) {
    int lane = lane_in; asm volatile("" : "+v"(lane));
    const int bh = unit >> 5, c = unit & 31, b = bh >> 3, h = bh & 7;
    const int m0 = b * SEQ_ + c * CH;
    unsigned char* rec = uni_ptr(rec_base + (size_t)unit * R_STRIDE);
    GLAS unsigned char* q16 = lw; GLAS unsigned char* k16 = lw + 8192; GLAS float* AT = (GLAS float*)lw;
    float bt_v, gc_v, eg_v;
    {   const float* pr = P + (size_t)(m0 + lane) * NIN_P;
        const float aa = pr[C_A_ + h] + dtb[h], bb = pr[C_B_ + h];
        const float sp = (aa > 20.f) ? aa : log1pf(__expf(aa));
        const float g = -__expf(alog[h]) * sp;
        bt_v = 1.0f / (1.0f + __expf(-bb));
        float s = g;
#pragma unroll
        for (int o = 1; o < 64; o <<= 1) { const float t = __shfl_up(s, o); if (lane >= o) s += t; }
        gc_v = s; eg_v = __expf(gc_v);
        const float gcl = rdl(gc_v, 63);
        float* sc = (float*)(rec + R_SC);
        sc[lane] = eg_v; sc[64 + lane] = __expf(gcl - gc_v); if (lane == 0) sc[128] = __expf(gcl);
    }
    float W[64];
    float* ug = (float*)(rec + R_U); float* tg = (float*)(rec + R_TMP);
    {   const int ch = h * 64 + lane;
        float wq[4], wk[4], wv[4];
#pragma unroll
        for (int j = 0; j < 4; ++j) { wq[j] = convw[j * 1536 + ch]; wk[j] = convw[j * 1536 + 512 + ch]; wv[j] = convw[j * 1536 + 1024 + ch]; }
        const float* pbs = uni_ptr(P + (size_t)m0 * NIN_P + C_GQKV_ + h * 64 + 512);
        float q1 = 0.f, q2 = 0.f, q3 = 0.f, k1 = 0.f, k2 = 0.f, k3 = 0.f, v1 = 0.f, v2 = 0.f, v3 = 0.f;
        if (c > 0) { const float* p3 = pbs - 3 * NIN_P; const float* p2 = pbs - 2 * NIN_P; const float* p1 = pbs - NIN_P;
            q1 = p3[lane - 512]; k1 = p3[lane]; v1 = p3[lane + 512]; q2 = p2[lane - 512]; k2 = p2[lane]; v2 = p2[lane + 512]; q3 = p1[lane - 512]; k3 = p1[lane]; v3 = p1[lane + 512]; }
        float kwin[16];
#pragma unroll
        for (int t8 = 0; t8 < 64; t8 += 4) {
            asm volatile("" ::: "memory");
            float xq[4], xk[4], xv[4];
#pragma unroll
            for (int u = 0; u < 4; ++u) { const float* rp = pbs + (size_t)(t8 + u) * NIN_P; xq[u] = rp[lane - 512]; xk[u] = rp[lane]; xv[u] = rp[lane + 512]; }
#pragma unroll
            for (int u = 0; u < 4; ++u) { const int t = t8 + u;
                float cq = wq[0] * q1 + wq[1] * q2 + wq[2] * q3 + wq[3] * xq[u];
                float ck = wk[0] * k1 + wk[1] * k2 + wk[2] * k3 + wk[3] * xk[u];
                float cv = wv[0] * v1 + wv[1] * v2 + wv[2] * v3 + wv[3] * xv[u];
                q1 = q2; q2 = q3; q3 = xq[u]; k1 = k2; k2 = k3; k3 = xk[u]; v1 = v2; v2 = v3; v3 = xv[u];
                cq = cq / (1.0f + __expf(-cq)); ck = ck / (1.0f + __expf(-ck)); cv = cv / (1.0f + __expf(-cv));
                const float qn = wsum(cq * cq), kn = wsum(ck * ck);
                const float qv = cq * (1.0f / sqrtf(qn + 1e-6f)) * 0.125f, kv = ck * (1.0f / sqrtf(kn + 1e-6f));
                *(GLAS unsigned short*)(q16 + img_off(t, lane)) = cvt1(qv);
                *(GLAS unsigned short*)(k16 + img_off(t, lane)) = cvt1(kv);
                const float bt = rdl(bt_v, t), eg = rdl(eg_v, t);
                W[t] = bt * cv; { float* tb = uni_ptr(tg + (t >> 4) * 1024); tb[(t & 15) * 64 + lane] = bt * eg * kv; }
                kwin[t & 15] = kv;
                if ((t & 15) == 15) {
                    const int s = t >> 4, rt = lane >> 5, r = lane & 31;
                    u32x4 f0, f1;
                    f0.x = cvtpk(kwin[0], kwin[1]); f0.y = cvtpk(kwin[2], kwin[3]); f0.z = cvtpk(kwin[8], kwin[9]); f0.w = cvtpk(kwin[10], kwin[11]);
                    f1.x = cvtpk(kwin[4], kwin[5]); f1.y = cvtpk(kwin[6], kwin[7]); f1.z = cvtpk(kwin[12], kwin[13]); f1.w = cvtpk(kwin[14], kwin[15]);
                    *(u32x4*)(rec + R_KT + (((rt * 4 + s) * 2 + 0) * 32 + r) * 16) = f0;
                    *(u32x4*)(rec + R_KT + (((rt * 4 + s) * 2 + 1) * 32 + r) * 16) = f1;
                }
            }
        }
    }
    asm volatile("s_waitcnt lgkmcnt(0)" ::: "memory");
    const int r31 = lane & 31, hi = lane >> 5;
#pragma unroll
    for (int tile = 0; tile < 3; ++tile) { const int jt = (tile == 2) ? 1 : 0, it = (tile == 0) ? 0 : 1;
        f32x16 acc = {};
#pragma unroll
        for (int ks = 0; ks < 4; ++ks) acc = GMFMA(img_frag(k16, 32 * jt, ks, lane), img_frag(q16, 32 * it, ks, lane), acc);
        const int i = 32 * it + r31; const float gci = __shfl(gc_v, i);
        float vals[16];
#pragma unroll
        for (int rr = 0; rr < 16; ++rr) { const int j0 = 32 * jt + crow(rr, 0); const float gcj0 = rdl(gc_v, j0), gcj1 = rdl(gc_v, j0 + 4); const float gcj = hi ? gcj1 : gcj0; const int j = j0 + 4 * hi;
            vals[rr] = (i >= j) ? acc[rr] * __expf(gci - gcj) : 0.f; }
#pragma unroll
        for (int s = 0; s < 2; ++s) { u32x4 f; f.x = cvtpk(vals[8 * s], vals[8 * s + 1]); f.y = cvtpk(vals[8 * s + 2], vals[8 * s + 3]); f.z = cvtpk(vals[8 * s + 4], vals[8 * s + 5]); f.w = cvtpk(vals[8 * s + 6], vals[8 * s + 7]);
            *(u32x4*)(rec + R_INTRA + (((it * 4 + 2 * jt + s) * 2 + hi) * 32 + r31) * 16) = f; }
    }
#pragma unroll
    for (int rt = 0; rt < 2; ++rt)
#pragma unroll
        for (int ks = 0; ks < 4; ++ks) { const int row = 32 * rt + r31;
            const u32x2 lo = *(const GLAS u32x2*)(q16 + row * 128 + ((((2 * ks) ^ (row & 7))) << 4) + 8 * hi), hh = *(const GLAS u32x2*)(q16 + row * 128 + ((((2 * ks + 1) ^ (row & 7))) << 4) + 8 * hi);
            u32x4 f; f.x = lo.x; f.y = lo.y; f.z = hh.x; f.w = hh.y;
            *(u32x4*)(rec + R_Q + (((rt * 4 + ks) * 2 + hi) * 32 + r31) * 16) = f; }
    {   const float gc_lo = __shfl(gc_v, r31), gc_hi2 = __shfl(gc_v, 32 + r31), bt_lo = __shfl(bt_v, r31), bt_hi2 = __shfl(bt_v, 32 + r31);
        asm volatile("s_waitcnt lgkmcnt(0)" ::: "memory");
        {   f32x16 d00 = {}, d01 = {};
#pragma unroll
            for (int ks = 0; ks < 4; ++ks) { const bf16x8 f0 = img_frag(k16, 0, ks, lane), f1 = img_frag(k16, 32, ks, lane); d00 = GMFMA(f0, f0, d00); d01 = GMFMA(f0, f1, d01); }
#pragma unroll
            for (int rr = 0; rr < 16; ++rr) { const int i0 = crow(rr, 0); const float gci0 = rdl(gc_v, i0), gci1 = rdl(gc_v, i0 + 4); const float gci = hi ? gci1 : gci0; const int ia = i0 + 4 * hi;
                AT[ia * 64 + r31] = (r31 > ia) ? bt_lo * d00[rr] * __expf(gc_lo - gci) : 0.f;
                AT[ia * 64 + 32 + r31] = bt_hi2 * d01[rr] * __expf(gc_hi2 - gci); } }
        {   f32x16 d11 = {};
#pragma unroll
            for (int ks = 0; ks < 4; ++ks) { const bf16x8 f1 = img_frag(k16, 32, ks, lane); d11 = GMFMA(f1, f1, d11); }
            asm volatile("s_waitcnt lgkmcnt(0)" ::: "memory");
#pragma unroll
            for (int rr = 0; rr < 16; ++rr) { const int i0 = crow(rr, 0); const float gci0 = rdl(gc_v, 32 + i0), gci1 = rdl(gc_v, 32 + i0 + 4); const float gci = hi ? gci1 : gci0; const int ib = 32 + i0 + 4 * hi;
                AT[ib * 64 + 32 + r31] = (32 + r31 > ib) ? bt_hi2 * d11[rr] * __expf(gc_hi2 - gci) : 0.f; } }
    }
    asm volatile("s_waitcnt lgkmcnt(0)" ::: "memory");
#define GSUBST(X, ATP) _Pragma("unroll") for (int i = 0; i < 63; ++i) { unsigned ao_ = (unsigned)(i * 256); asm volatile("" : "+v"(ao_) : "v"(X[i]));     \
        _Pragma("unroll") for (int q4 = (i + 1) >> 2; q4 < 16; ++q4) { \
        const f32x4 a = *(const GLAS f32x4*)((const GLAS unsigned char*)(ATP) + ao_ + 16 * q4); \
        _Pragma("unroll") for (int e = 0; e < 4; ++e) { const int ip = 4 * q4 + e; if (ip > i) X[ip] = fmaf(-a[e], X[i], X[ip]); } } }
#pragma unroll 1
    for (int pass = 0; pass < 2; ++pass) {
        GSUBST(W, AT)
        if (pass == 0) {
#pragma unroll
            for (int i = 0; i < 64; ++i) { float* ub = uni_ptr(ug + (i >> 4) * 1024); ub[(i & 15) * 64 + lane] = W[i]; }
            asm volatile("s_waitcnt vmcnt(0)" ::: "memory");
#pragma unroll
            for (int i = 0; i < 64; ++i) { const float* tb = uni_ptr(tg + (i >> 4) * 1024); W[i] = tb[(i & 15) * 64 + lane]; }
        }
    }
#undef GSUBST
    {   asm volatile("s_waitcnt lgkmcnt(0)" ::: "memory");
#pragma unroll
        for (int i = 0; i < 64; ++i) *(GLAS unsigned short*)(lw + frag_off(i, lane)) = cvt1(-W[i]);
        asm volatile("s_waitcnt lgkmcnt(0)" ::: "memory");
#pragma unroll
        for (int x = 0; x < 8; ++x) *(u32x4*)(rec + R_NEGW + x * 1024 + lane * 16) = *(const GLAS u32x4*)(lw + x * 1024 + lane * 16);
        asm volatile("s_waitcnt lgkmcnt(0)" ::: "memory");
    }
}

GDI void scan_wg(int bh, const unsigned char* __restrict__ rec_base, float* __restrict__ GO, float* __restrict__ sg_out, GLAS unsigned char* lds, int tid_in) {
    int tid = tid_in; asm volatile("" : "+v"(tid));
    const int wave = __builtin_amdgcn_readfirstlane(tid >> 6), lane = tid & 63, r31 = lane & 31, hi = lane >> 5;
    const int b = bh >> 3, h = bh & 7;
    const unsigned char* rec0 = rec_base + (size_t)bh * NCH * R_STRIDE;
    for (int x = tid; x < R_BYTES / 16; x += 512) *(GLAS u32x4*)(lds + x * 16) = *(const u32x4*)(rec0 + (size_t)x * 16);
    __syncthreads();
    f32x16 S0 = {}, S1 = {};
    for (int c = 0; c < NCH; ++c) {
        GLAS unsigned char* buf = lds + (c & 1) * R_BYTES;
        if (wave >= 2) {
            if (c + 1 < NCH) { const unsigned char* src = rec0 + (size_t)(c + 1) * R_STRIDE; GLAS unsigned char* dst = lds + ((c + 1) & 1) * R_BYTES;
                for (int x = tid - 128; x < R_BYTES / 16; x += 384) *(GLAS u32x4*)(dst + x * 16) = *(const u32x4*)(src + (size_t)x * 16); }
        } else {
            const int dv = 32 * wave + r31;
            const GLAS float* sc = (const GLAS float*)(buf + R_SC);
            const float gl = sc[128];
#define GFRAG(base, rt, ks) (*(const GLAS bf16x8*)(buf + (base) + ((((rt) * 4 + (ks)) * 2 + hi) * 32 + r31) * 16))
            bf16x8 sb[4];
#pragma unroll
            for (int s = 0; s < 2; ++s) { u32x4 f; f.x = cvtpk(S0[8 * s], S0[8 * s + 1]); f.y = cvtpk(S0[8 * s + 2], S0[8 * s + 3]); f.z = cvtpk(S0[8 * s + 4], S0[8 * s + 5]); f.w = cvtpk(S0[8 * s + 6], S0[8 * s + 7]); sb[s] = __builtin_bit_cast(bf16x8, f);
                u32x4 g; g.x = cvtpk(S1[8 * s], S1[8 * s + 1]); g.y = cvtpk(S1[8 * s + 2], S1[8 * s + 3]); g.z = cvtpk(S1[8 * s + 4], S1[8 * s + 5]); g.w = cvtpk(S1[8 * s + 6], S1[8 * s + 7]); sb[2 + s] = __builtin_bit_cast(bf16x8, g); }
            f32x16 vn[2], x2[2];
            const GLAS float* ul = (const GLAS float*)(buf + R_U);
#pragma unroll
            for (int ct = 0; ct < 2; ++ct) {
#pragma unroll
                for (int rr = 0; rr < 16; ++rr) vn[ct][rr] = ul[(32 * ct + crow(rr, 0) + 4 * hi) * 64 + dv];
                x2[ct] = f32x16{};
#pragma unroll
                for (int ks = 0; ks < 4; ++ks) { vn[ct] = GMFMA(GFRAG(R_NEGW, ct, ks), sb[ks], vn[ct]); x2[ct] = GMFMA(GFRAG(R_Q, ct, ks), sb[ks], x2[ct]); }
            }
            bf16x8 vb[4], vs[4];
#pragma unroll
            for (int ct = 0; ct < 2; ++ct) {
                float sv[16];
#pragma unroll
                for (int rr = 0; rr < 16; ++rr) { const int row = 32 * ct + crow(rr, 0) + 4 * hi; sv[rr] = vn[ct][rr] * sc[64 + row]; x2[ct][rr] *= sc[row]; }
#pragma unroll
                for (int s = 0; s < 2; ++s) { u32x4 f; f.x = cvtpk(vn[ct][8 * s], vn[ct][8 * s + 1]); f.y = cvtpk(vn[ct][8 * s + 2], vn[ct][8 * s + 3]); f.z = cvtpk(vn[ct][8 * s + 4], vn[ct][8 * s + 5]); f.w = cvtpk(vn[ct][8 * s + 6], vn[ct][8 * s + 7]); vb[2 * ct + s] = __builtin_bit_cast(bf16x8, f);
                    u32x4 g; g.x = cvtpk(sv[8 * s], sv[8 * s + 1]); g.y = cvtpk(sv[8 * s + 2], sv[8 * s + 3]); g.z = cvtpk(sv[8 * s + 4], sv[8 * s + 5]); g.w = cvtpk(sv[8 * s + 6], sv[8 * s + 7]); vs[2 * ct + s] = __builtin_bit_cast(bf16x8, g); }
            }
            x2[0] = GMFMA(GFRAG(R_INTRA, 0, 0), vb[0], x2[0]); x2[0] = GMFMA(GFRAG(R_INTRA, 0, 1), vb[1], x2[0]);
#pragma unroll
            for (int ks = 0; ks < 4; ++ks) x2[1] = GMFMA(GFRAG(R_INTRA, 1, ks), vb[ks], x2[1]);
#pragma unroll
            for (int rr = 0; rr < 16; ++rr) { S0[rr] *= gl; S1[rr] *= gl; }
#pragma unroll
            for (int ks = 0; ks < 4; ++ks) { S0 = GMFMA(GFRAG(R_KT, 0, ks), vs[ks], S0); S1 = GMFMA(GFRAG(R_KT, 1, ks), vs[ks], S1); }
#undef GFRAG
            float* go = GO + (size_t)(b * SEQ_ + c * CH) * 512 + h * 64 + dv;
#pragma unroll
            for (int ct = 0; ct < 2; ++ct)
#pragma unroll
                for (int rr = 0; rr < 16; ++rr) go[(size_t)(32 * ct + crow(rr, 0) + 4 * hi) * 512] = x2[ct][rr];
        }
        __syncthreads();
    }
    if (wave < 2) { float* so = sg_out + (size_t)bh * 4096 + 32 * wave + r31;
#pragma unroll
        for (int rr = 0; rr < 16; ++rr) { so[(crow(rr, 0) + 4 * hi) * 64] = S0[rr]; so[(32 + crow(rr, 0) + 4 * hi) * 64] = S1[rr]; } }
}
#undef GMFMA
#undef GDI
}

constexpr int NWAVES = 8;
constexpr int DM = 1024, NB = 8, SEQ = 2048, DB = 128, DS = 4;
constexpr int MP = NB * SEQ, MS = DB * DS, M = MP + MS;
constexpr int FF = 2816, NGU = 2 * FF, NIN = 3600, NINP = 3840;
constexpr int NH = 8, HD = 64, AW = 512, GW = 512;
constexpr int C_AQ = 0, C_AK = 512, C_AV = 1024, C_GQKV = 1536, C_Z = 3072, C_B = 3584, C_A = 3592;
constexpr float LN_EPS = 1e-5f, RMS_EPS = 1e-6f, ALPHA = 1.189207115002721f;
constexpr size_t O_YP = 0, O_YS = 16777216, O_KP = 17301504, O_VP = 25690112, O_SGP = 34078720, O_SCP = 34340864, O_KS = 34377728, O_VS = 34639872, O_SGS = 34902016, O_SCS = 39096320, O_END = 39686144;
constexpr size_t MiB = 1u << 20;
constexpr size_t WS_CTL = 0, CTL_ZERO_BYTES = 1 * MiB, WS_WGU1 = 1 * MiB, WS_WD1 = 13 * MiB, WS_WIN = 19 * MiB, WS_WOUT = 27 * MiB, WS_WGU2 = 29 * MiB, WS_WD2 = 41 * MiB;
constexpr size_t WS_XB = 48 * MiB, WS_H = 82 * MiB, WS_T = 174 * MiB, WS_X1 = 240 * MiB, WS_X1B = 306 * MiB, WS_P = 340 * MiB, WS_HEADS = 588 * MiB;
constexpr size_t WS_GQ = 622 * MiB, WS_GK = 655 * MiB, WS_GV = 688 * MiB, WS_GG = 721 * MiB, WS_GB = 722 * MiB, WS_GO = 723 * MiB, WS_X2 = 756 * MiB, WS_X2B = 822 * MiB, WS_QB = 856 * MiB, WS_KB = 872 * MiB, WS_VB = 888 * MiB, WS_REC = 904 * MiB, WS_END = 1036 * MiB;
constexpr int CW_BAR = 4096;
constexpr int RING_OFF = 0, RING_BYTES = 131072, LDSCTL_OFF = RING_BYTES, MISC_OFF = LDSCTL_OFF + 320, LDS_BYTES = 147456;

struct Args { const float* in[25]; float* out; unsigned char* ws; };

__device__ __forceinline__ float wave_sum(float v) {
#pragma unroll
    for (int o = 1; o < 64; o <<= 1) v += __shfl_xor(v, o);
    return v;
}
__device__ __forceinline__ float wave_max(float v) {
#pragma unroll
    for (int o = 1; o < 64; o <<= 1) v = fmaxf(v, __shfl_xor(v, o));
    return v;
}
__device__ __forceinline__ int t5_bucket(int n) {
    if (n < 16) return n;
    int b = 16;
    b += (n >= 22); b += (n >= 30); b += (n >= 40); b += (n >= 54); b += (n >= 73); b += (n >= 99); b += (n >= 134); b += (n >= 182);
    b += (n >= 246); b += (n >= 332); b += (n >= 450); b += (n >= 609); b += (n >= 825); b += (n >= 1117); b += (n >= 1513);
    return b;
}
__device__ __forceinline__ unsigned long long pk4(f32x4 v) { return (unsigned long long)pk2(v.x, v.y) | ((unsigned long long)pk2(v.z, v.w) << 32); }

__device__ __forceinline__ void p0_transpose_item(const float* W0, const float* W1, int K, int Nsrc, int Nd, int mode, bf16* WT, LAS float* scr, int item, int lane) {
    const int nblk = Nd / 32, kb = item / nblk, nb = item % nblk, k0 = 64 * kb, n0 = 32 * nb;
    const float* src = W0; int c0 = n0;
    if (mode == 1) { const int t = n0 / 256, w = n0 % 256; src = (w < 128) ? W0 : W1; c0 = t * 128 + (w & 127); }
    const bool okc = (c0 + (lane & 31)) < Nsrc;
#pragma unroll 8
    for (int i = 0; i < 32; ++i) { const int kk = 2 * i + (lane >> 5); scr[kk * 33 + (lane & 31)] = okc ? src[(size_t)(k0 + kk) * Nsrc + c0 + (lane & 31)] : 0.f; }
    LDS_WAIT(); asm volatile("" ::: "memory");
    const int c = lane & 7;
#pragma unroll
    for (int j = 0; j < 4; ++j) { const int n = (lane >> 3) + 8 * j; const LAS float* s = scr + (8 * c) * 33 + n;
        v4u o; o.x = pk2(s[0 * 33], s[1 * 33]); o.y = pk2(s[2 * 33], s[3 * 33]); o.z = pk2(s[4 * 33], s[5 * 33]); o.w = pk2(s[6 * 33], s[7 * 33]);
        *(GAS v4u*)(WT + (size_t)(n0 + n) * K + k0 + 8 * c) = o; }
    LDS_WAIT(); asm volatile("" ::: "memory");
}
__device__ __forceinline__ void p_transpose(const float* W0, const float* W1, int K, int Nsrc, int Nd, int mode, bf16* WT, LAS float* scr, int gw, int NGW, int lane) {
    const int nitems = (K / 64) * (Nd / 32);
    for (int it = gw; it < nitems; it += NGW) p0_transpose_item(W0, W1, K, Nsrc, Nd, mode, WT, scr, it, lane);
}
__device__ __forceinline__ void p_cvt_x(const float* xp, const float* xs, bf16* xb, int gw, int NGW, int lane) {
    for (int m = gw; m < M; m += NGW) { const float* s = (m < MP) ? xp + (size_t)m * DM : xs + (size_t)(m - MP) * DM;
#pragma unroll
        for (int j = 0; j < 4; ++j) { const f32x4 v = *(const f32x4*)(s + j * 256 + lane * 4); *(unsigned long long*)(xb + (size_t)m * DM + j * 256 + lane * 4) = pk4(v); } }
}
__device__ __forceinline__ void p_ln(const float* r0, const float* r1, const float* t, float s, const float* g, const float* b, float* o0, float* o1, bf16* ob, int gw, int NGW, int lane) {
    for (int m = gw; m < M; m += NGW) {
        const float* rr = (m < MP) ? r0 + (size_t)m * DM : r1 + (size_t)(m - MP) * DM;
        const float* tt = t + (size_t)m * DM;
        f32x4 v[4]; float sum = 0.f;
#pragma unroll
        for (int j = 0; j < 4; ++j) { const f32x4 a = *(const f32x4*)(rr + j * 256 + lane * 4), c = *(const f32x4*)(tt + j * 256 + lane * 4); v[j] = a * ALPHA + c * s; sum += (v[j].x + v[j].y) + (v[j].z + v[j].w); }
        const float mean = wave_sum(sum) * (1.f / DM); float s2 = 0.f;
#pragma unroll
        for (int j = 0; j < 4; ++j) { v[j] = v[j] - mean; s2 += (v[j].x * v[j].x + v[j].y * v[j].y) + (v[j].z * v[j].z + v[j].w * v[j].w); }
        const float rstd = 1.0f / sqrtf(wave_sum(s2) * (1.f / DM) + LN_EPS);
        float* oo = (m < MP) ? o0 + (size_t)m * DM : o1 + (size_t)(m - MP) * DM;
#pragma unroll
        for (int j = 0; j < 4; ++j) { const f32x4 gg = *(const f32x4*)(g + j * 256 + lane * 4), bb = *(const f32x4*)(b + j * 256 + lane * 4); const f32x4 y = v[j] * rstd * gg + bb;
            *(f32x4*)(oo + j * 256 + lane * 4) = y;
            if (ob) *(unsigned long long*)(ob + (size_t)m * DM + j * 256 + lane * 4) = pk4(y); }
    }
}
__device__ __forceinline__ void p_copy_out(const float* P, float* out, bf16* Qb, bf16* Kb, bf16* Vb, int gw, int NGW, int lane) {
    for (int m = gw; m < M; m += NGW) {
        const float* pr = P + (size_t)m * NINP;
        if (m < MP) {
#pragma unroll
            for (int j = 0; j < 2; ++j) { const int c = j * 256 + lane * 4; *(unsigned long long*)(Qb + (size_t)m * AW + c) = pk4(*(const f32x4*)(pr + C_AQ + c) * attn_body::C2);
                *(unsigned long long*)(Kb + (size_t)m * AW + c) = pk4(*(const f32x4*)(pr + C_AK + c)); *(unsigned long long*)(Vb + (size_t)m * AW + c) = pk4(*(const f32x4*)(pr + C_AV + c)); } }
        float* kd; float* vd;
        if (m < MP) { kd = out + O_KP + (size_t)m * AW; vd = out + O_VP + (size_t)m * AW; } else { kd = out + O_KS + (size_t)(m - MP) * AW; vd = out + O_VS + (size_t)(m - MP) * AW; }
#pragma unroll
        for (int j = 0; j < 2; ++j) { *(f32x4*)(kd + j * 256 + lane * 4) = *(const f32x4*)(pr + C_AK + j * 256 + lane * 4); *(f32x4*)(vd + j * 256 + lane * 4) = *(const f32x4*)(pr + C_AV + j * 256 + lane * 4); }
        float* sd = nullptr;
        if (m < MP) { const int b = m / SEQ, t = m % SEQ; if (t >= SEQ - 3) sd = out + O_SCP + ((size_t)b * 3 + (t - (SEQ - 3))) * 1536; }
        else { const int b = (m - MP) / DS, t = (m - MP) % DS; if (t >= 1) sd = out + O_SCS + ((size_t)b * 3 + (t - 1)) * 1536; }
        if (sd) {
#pragma unroll
            for (int j = 0; j < 6; ++j) *(f32x4*)(sd + j * 256 + lane * 4) = *(const f32x4*)(pr + C_GQKV + j * 256 + lane * 4); }
    }
}
__device__ __forceinline__ void p_attn_simple(const float* P, const float* ck, const float* cv, const float* relb, bf16* heads, LAS float* lds, int m0, int vcu, int G, int h, int lane) {
    LAS float* sq = lds + h * 64; LAS float* sp = lds + 8 * 64 + h * 392;
    for (int m = m0 + vcu; m < M; m += G) {
        const bool samp = m >= MP; int b, p;
        if (!samp) { b = m / SEQ; p = m % SEQ; } else { b = (m - MP) / DS; p = SEQ + (m - MP) % DS; }
        sq[lane] = P[(size_t)m * NINP + C_AQ + h * 64 + lane] * 0.125f;
        LDS_WAIT(); asm volatile("" ::: "memory");
        float lg[7]; float mx = -INFINITY;
#pragma unroll
        for (int i = 0; i < 7; ++i) {
            const int e = i * 64 + lane; float v = -INFINITY;
            if (e < 387) { const int g = e / 129, j = e % 129, dil = (g == 0) ? 1 : (g == 1 ? 4 : 16), delta = j * dil, pos = p - delta;
                if (pos >= 0) {
                    const float* kp;
                    if (!samp) kp = P + (size_t)(b * SEQ + pos) * NINP + C_AK + h * 64;
                    else if (pos >= SEQ) kp = P + (size_t)(MP + b * DS + (pos - SEQ)) * NINP + C_AK + h * 64;
                    else kp = ck + (((size_t)b * SEQ + pos) * NH + h) * HD;
                    float acc = 0.f;
#pragma unroll
                    for (int d = 0; d < 64; d += 4) { const f32x4 kv = *(const f32x4*)(kp + d); acc += kv.x * sq[d] + kv.y * sq[d + 1] + kv.z * sq[d + 2] + kv.w * sq[d + 3]; }
                    v = acc + relb[t5_bucket(delta) * NH + h]; } }
            lg[i] = v; mx = fmaxf(mx, v); }
        mx = wave_max(mx);
        float sum = 0.f;
#pragma unroll
        for (int i = 0; i < 7; ++i) { const int e = i * 64 + lane; const float pe = (lg[i] == -INFINITY) ? 0.f : __expf(lg[i] - mx); if (e < 387) sp[e] = pe; sum += pe; }
        sum = wave_sum(sum);
        LDS_WAIT(); asm volatile("" ::: "memory");
        float o = 0.f;
        for (int e = 0; e < 387; ++e) { const float pe = sp[e]; if (pe == 0.f) continue;
            const int g = e / 129, j = e % 129, dil = (g == 0) ? 1 : (g == 1 ? 4 : 16), pos = p - j * dil;
            const float* vp;
            if (!samp) vp = P + (size_t)(b * SEQ + pos) * NINP + C_AV + h * 64;
            else if (pos >= SEQ) vp = P + (size_t)(MP + b * DS + (pos - SEQ)) * NINP + C_AV + h * 64;
            else vp = cv + (((size_t)b * SEQ + pos) * NH + h) * HD;
            o += pe * vp[lane]; }
        heads[(size_t)m * DM + h * 64 + lane] = (bf16)f2bf(o / sum);
        LDS_WAIT(); asm volatile("" ::: "memory");
    }
}
__device__ __forceinline__ void p_gdn_prep(const float* P, const float* sconv, const float* convw, const float* alog, const float* dtb, float* GQ, float* GK, float* GV, float* GG, float* GB, int m0, int vcu, int G, int h, int lane) {
    for (int m = m0 + vcu; m < M; m += G) {
        const bool samp = m >= MP; int b, t;
        if (!samp) { b = m / SEQ; t = m % SEQ; } else { b = (m - MP) / DS; t = (m - MP) % DS; }
        float r[3];
#pragma unroll
        for (int part = 0; part < 3; ++part) {
            const int c = part * 512 + h * 64 + lane; float acc = 0.f;
#pragma unroll
            for (int j = 0; j < 4; ++j) { const int tt = t - 3 + j; float x;
                if (tt >= 0) x = P[(size_t)(m - t + tt) * NINP + C_GQKV + c]; else x = samp ? sconv[((size_t)b * 3 + (tt + 3)) * 1536 + c] : 0.f;
                acc += x * convw[j * 1536 + c]; }
            r[part] = acc / (1.0f + __expf(-acc)); }
        const float qn = wave_sum(r[0] * r[0]), kn = wave_sum(r[1] * r[1]);
        GQ[(size_t)m * GW + h * 64 + lane] = r[0] * (1.0f / sqrtf(qn + RMS_EPS)) * 0.125f;
        GK[(size_t)m * GW + h * 64 + lane] = r[1] * (1.0f / sqrtf(kn + RMS_EPS));
        GV[(size_t)m * GW + h * 64 + lane] = r[2];
        if (lane == 0) { const float bb = P[(size_t)m * NINP + C_B + h], aa = P[(size_t)m * NINP + C_A + h] + dtb[h];
            GB[(size_t)m * NH + h] = 1.0f / (1.0f + __expf(-bb));
            const float sp = (aa > 20.f) ? aa : log1pf(__expf(aa));
            GG[(size_t)m * NH + h] = -__expf(alog[h]) * sp; }
    }
}
__device__ __forceinline__ void gdn_scan_task(int task, const float* GQ, const float* GK, const float* GV, const float* GG, const float* GB, const float* s0, const float* P, const float* nw, bf16* heads, float* out, int lane) {
    const int seq = task / NH, h = task % NH;
    float S[64]; int row0, L; float* sdst;
    if (seq < NB) { row0 = seq * SEQ; L = SEQ; sdst = out + O_SGP + ((size_t)seq * NH + h) * 4096;
#pragma unroll
        for (int d = 0; d < 64; ++d) S[d] = 0.f; }
    else { const int b = seq - NB; row0 = MP + b * DS; L = DS; sdst = out + O_SGS + ((size_t)b * NH + h) * 4096; const float* sp = s0 + ((size_t)b * NH + h) * 4096;
#pragma unroll
        for (int d = 0; d < 64; ++d) S[d] = sp[d * 64 + lane]; }
    const float nwl = nw[lane];
    size_t o = (size_t)row0 * GW + h * 64 + lane;
    float qn = GQ[o], kn = GK[o], vn = GV[o], gn = GG[(size_t)row0 * NH + h], bn = GB[(size_t)row0 * NH + h], zn = P[(size_t)row0 * NINP + C_Z + h * 64 + lane];
    for (int t = 0; t < L; ++t) {
        const float qv = qn, kv = kn, vv = vn, eg = __expf(gn), beta = bn, z = zn; const int m = row0 + t;
        if (t + 1 < L) { o += GW; qn = GQ[o]; kn = GK[o]; vn = GV[o]; gn = GG[(size_t)(m + 1) * NH + h]; bn = GB[(size_t)(m + 1) * NH + h]; zn = P[(size_t)(m + 1) * NINP + C_Z + h * 64 + lane]; }
        float k0 = 0.f, k1 = 0.f, k2 = 0.f, k3 = 0.f;
#pragma unroll
        for (int d = 0; d < 64; d += 4) {
            k0 += __builtin_bit_cast(float, __builtin_amdgcn_readlane(__builtin_bit_cast(int, kv), d)) * S[d];
            k1 += __builtin_bit_cast(float, __builtin_amdgcn_readlane(__builtin_bit_cast(int, kv), d + 1)) * S[d + 1];
            k2 += __builtin_bit_cast(float, __builtin_amdgcn_readlane(__builtin_bit_cast(int, kv), d + 2)) * S[d + 2];
            k3 += __builtin_bit_cast(float, __builtin_amdgcn_readlane(__builtin_bit_cast(int, kv), d + 3)) * S[d + 3]; }
        const float ks = (k0 + k1) + (k2 + k3);
        const float c = beta * (vv - eg * ks);
        float o0 = 0.f, o1 = 0.f, o2 = 0.f, o3 = 0.f;
#pragma unroll
        for (int d = 0; d < 64; d += 4) {
#pragma unroll
            for (int e = 0; e < 4; ++e) { const float kd = __builtin_bit_cast(float, __builtin_amdgcn_readlane(__builtin_bit_cast(int, kv), d + e)); S[d + e] = fmaf(kd, c, eg * S[d + e]); }
            o0 += __builtin_bit_cast(float, __builtin_amdgcn_readlane(__builtin_bit_cast(int, qv), d)) * S[d];
            o1 += __builtin_bit_cast(float, __builtin_amdgcn_readlane(__builtin_bit_cast(int, qv), d + 1)) * S[d + 1];
            o2 += __builtin_bit_cast(float, __builtin_amdgcn_readlane(__builtin_bit_cast(int, qv), d + 2)) * S[d + 2];
            o3 += __builtin_bit_cast(float, __builtin_amdgcn_readlane(__builtin_bit_cast(int, qv), d + 3)) * S[d + 3]; }
        const float ov = (o0 + o1) + (o2 + o3);
        const float ms = wave_sum(ov * ov) * (1.f / 64.f);
        const float y = ov * (1.0f / sqrtf(ms + RMS_EPS)) * nwl * (z / (1.0f + __expf(-z)));
        heads[(size_t)m * DM + AW + h * 64 + lane] = (bf16)f2bf(y);
    }
#pragma unroll
    for (int d = 0; d < 64; ++d) sdst[d * 64 + lane] = S[d];
}

__device__ __forceinline__ void p_gdn_out(const float* GO, const float* P, const float* nw, bf16* heads, int gw, int NGW, int lane) {
    const float nwl = nw[lane];
    for (int m = gw; m < MP; m += NGW) {
#pragma unroll
        for (int h = 0; h < NH; ++h) { const float o = GO[(size_t)m * GW + h * 64 + lane]; const float ms = wave_sum(o * o) * (1.f / 64.f); const float z = P[(size_t)m * NINP + C_Z + h * 64 + lane];
            heads[(size_t)m * DM + AW + h * 64 + lane] = (bf16)f2bf(o * (1.0f / sqrtf(ms + RMS_EPS)) * nwl * (z / (1.0f + __expf(-z)))); }
    }
}
__global__ void __launch_bounds__(NWAVES * 64, 2) mega_fwd(Args args) {
    extern __shared__ __attribute__((aligned(16))) unsigned char lds[];
    LAS unsigned char* L = (LAS unsigned char*)lds;
    volatile LAS unsigned* MISC = (volatile LAS unsigned*)(L + MISC_OFF);
    const int tid = threadIdx.x, lane = tid & 63, wave = __builtin_amdgcn_readfirstlane(tid >> 6);
    const int G = gridDim.x; const int bx = blockIdx.x; const int vcu = (G % 8 == 0) ? (bx % 8) * (G / 8) + bx / 8 : bx;
    unsigned char* ws = args.ws; float* out = args.out;
    gu32* ctl = (gu32*)(ws + WS_CTL);
    for (int u = tid; u < (LDS_BYTES - LDSCTL_OFF) / 4; u += NWAVES * 64) ((LAS unsigned*)(L + LDSCTL_OFF))[u] = 0u;
    __syncthreads();
    XcdBarrier bar = xcd_barrier_post((unsigned*)(ctl + CW_BAR), MISC + 8);
#define GRID_BAR() xcd_barrier(bar)
    const float* const* in = args.in;
    bf16 *Wgu1 = (bf16*)(ws + WS_WGU1), *Wd1 = (bf16*)(ws + WS_WD1), *Win = (bf16*)(ws + WS_WIN), *Wout = (bf16*)(ws + WS_WOUT), *Wgu2 = (bf16*)(ws + WS_WGU2), *Wd2 = (bf16*)(ws + WS_WD2);
    bf16 *XB = (bf16*)(ws + WS_XB), *H = (bf16*)(ws + WS_H), *X1B = (bf16*)(ws + WS_X1B), *HEADS = (bf16*)(ws + WS_HEADS), *X2B = (bf16*)(ws + WS_X2B);
    float *T = (float*)(ws + WS_T), *X1 = (float*)(ws + WS_X1), *P = (float*)(ws + WS_P), *GQ = (float*)(ws + WS_GQ), *GK = (float*)(ws + WS_GK), *GV = (float*)(ws + WS_GV), *GG = (float*)(ws + WS_GG), *GB = (float*)(ws + WS_GB), *X2 = (float*)(ws + WS_X2);
    const int gw = vcu * NWAVES + wave, NGW = G * NWAVES;

    {   LAS float* scr = (LAS float*)(L + RING_OFF + wave * 16384);
        p_transpose(in[9], in[10], DM, FF, NGU, 1, Wgu1, scr, gw, NGW, lane);
        p_transpose(in[11], nullptr, FF, DM, DM, 0, Wd1, scr, gw, NGW, lane);
        p_transpose(in[12], nullptr, DM, NIN, NINP, 0, Win, scr, gw, NGW, lane);
        p_transpose(in[13], nullptr, DM, DM, DM, 0, Wout, scr, gw, NGW, lane);
        p_transpose(in[20], in[21], DM, FF, NGU, 1, Wgu2, scr, gw, NGW, lane);
        p_transpose(in[22], nullptr, FF, DM, DM, 0, Wd2, scr, gw, NGW, lane);
        p_cvt_x(in[0], in[1], XB, gw, NGW, lane);
        GRID_BAR(); }
    {   pg8::Gemm g{XB, Wgu1, M, NGU, DM, 0}; pg8::StaticOrder S; S.init(M, NGU, G, bx); pg8::EpiSwiGLU E{H, FF, 0};
        pg8::gemm_phase<pg8::EpiSwiGLU, pg8::StaticOrder, true, true>(L + RING_OFF, g, S, E); GRID_BAR(); }
    {   pg8::Gemm g{H, Wd1, M, DM, FF, 0}; pg8::StaticOrder S; S.init(M, DM, G, bx); pg8::EpiF32 E{T, DM, 0};
        pg8::gemm_phase<pg8::EpiF32, pg8::StaticOrder, true, true>(L + RING_OFF, g, S, E); GRID_BAR(); }
    p_ln(in[0], in[1], T, 0.5f, in[7], in[8], X1, X1 + (size_t)MP * DM, X1B, gw, NGW, lane); GRID_BAR();
    {   pg8::Gemm g{X1B, Win, M, NINP, DM, 0}; pg8::StaticOrder S; S.init(M, NINP, G, bx); pg8::EpiF32 E{P, NINP, 0};
        pg8::gemm_phase<pg8::EpiF32, pg8::StaticOrder, true, true>(L + RING_OFF, g, S, E); GRID_BAR(); }
    bf16 *Qb = (bf16*)(ws + WS_QB), *Kb = (bf16*)(ws + WS_KB), *Vb = (bf16*)(ws + WS_VB);
    p_copy_out(P, out, Qb, Kb, Vb, gw, NGW, lane);
    p_gdn_prep(P, in[5], in[14], in[15], in[16], GQ, GK, GV, GG, GB, MP, vcu, G, wave, lane);
    unsigned char* REC = ws + WS_REC; float* GO = (float*)(ws + WS_GO);
    for (int unit = gw; unit < NB * NH * 32; unit += NGW) gdn::pre_unit(unit, P, in[14], in[15], in[16], REC, L + RING_OFF + wave * 16384, lane);
    GRID_BAR();
    {   const attn_body::AttnTensors AT{(const attn_body::bf16*)Qb, (const attn_body::bf16*)Kb, (const attn_body::bf16*)Vb, (attn_body::bf16*)HEADS};
        const attn_body::StaticOrder S(G, bx);
        attn_body::attn_phase<attn_body::StaticOrder>((char*)lds + RING_OFF, AT, in[6], S); }
    p_attn_simple(P, in[2], in[3], in[6], HEADS, (LAS float*)(L + RING_OFF), MP, vcu, G, wave, lane);
    for (int task = NB * NH + wave * G + bx; task < (NB + DB) * NH; task += NGW) gdn_scan_task(task, GQ, GK, GV, GG, GB, in[4], P, in[17], HEADS, out, lane);
    if (vcu < NB * NH) gdn::scan_wg(vcu, REC, GO, out + O_SGP, L + RING_OFF, tid);
    GRID_BAR();
    p_gdn_out(GO, P, in[17], HEADS, gw, NGW, lane);
    GRID_BAR();
    {   pg8::Gemm g{HEADS, Wout, M, DM, DM, 0}; pg8::StaticOrder S; S.init(M, DM, G, bx); pg8::EpiF32 E{T, DM, 0};
        pg8::gemm_phase<pg8::EpiF32, pg8::StaticOrder, true, true>(L + RING_OFF, g, S, E); GRID_BAR(); }
    p_ln(X1, X1 + (size_t)MP * DM, T, 1.0f, in[18], in[19], X2, X2 + (size_t)MP * DM, X2B, gw, NGW, lane); GRID_BAR();
    {   pg8::Gemm g{X2B, Wgu2, M, NGU, DM, 0}; pg8::StaticOrder S; S.init(M, NGU, G, bx); pg8::EpiSwiGLU E{H, FF, 0};
        pg8::gemm_phase<pg8::EpiSwiGLU, pg8::StaticOrder, true, true>(L + RING_OFF, g, S, E); GRID_BAR(); }
    {   pg8::Gemm g{H, Wd2, M, DM, FF, 0}; pg8::StaticOrder S; S.init(M, DM, G, bx); pg8::EpiF32 E{T, DM, 0};
        pg8::gemm_phase<pg8::EpiF32, pg8::StaticOrder, true, true>(L + RING_OFF, g, S, E); GRID_BAR(); }
    p_ln(X2, X2 + (size_t)MP * DM, T, 0.5f, in[23], in[24], out + O_YP, out + O_YS, nullptr, gw, NGW, lane);
}

extern "C" void kernel_launch(void* const* d_in, const int* in_sizes, int n_in, void* d_out, int out_size, void* d_ws, size_t ws_size, hipStream_t stream) {
    static int grid = 0;
    if (grid == 0) {
        if (n_in != 25 || out_size != (int)O_END || ws_size < WS_END) { fprintf(stderr, "kernel_launch: unexpected shapes (n_in %d out %d ws %zu)\n", n_in, out_size, ws_size); grid = -1; return; }
        int dev = 0, cus = 0, per_cu = 0;
        if (hipGetDevice(&dev) != hipSuccess || hipDeviceGetAttribute(&cus, hipDeviceAttributeMultiprocessorCount, dev) != hipSuccess) { grid = -1; return; }
        if (hipFuncSetAttribute((const void*)mega_fwd, hipFuncAttributeMaxDynamicSharedMemorySize, LDS_BYTES) != hipSuccess) { fprintf(stderr, "kernel_launch: hipFuncSetAttribute failed\n"); grid = -1; return; }
        if (hipOccupancyMaxActiveBlocksPerMultiprocessor(&per_cu, (const void*)mega_fwd, NWAVES * 64, LDS_BYTES) != hipSuccess || per_cu < 1) { fprintf(stderr, "kernel_launch: occupancy query reports %d\n", per_cu); }
        (void)hipGetLastError();
        grid = cus;
    }
    if (grid < 0) return;
    if (hipMemsetAsync((char*)d_ws + WS_CTL, 0, CTL_ZERO_BYTES, stream) != hipSuccess) return;
    Args a; memset(&a, 0, sizeof(a));
    for (int i = 0; i < 25; ++i) a.in[i] = (const float*)d_in[i];
    a.out = (float*)d_out; a.ws = (unsigned char*)d_ws;
    hipLaunchKernelGGL(mega_fwd, dim3(grid), dim3(NWAVES * 64), LDS_BYTES, stream, a);
}
```

```cpp
#include <hip/hip_runtime.h>
#include <cstdio>
#include <cstdint>
#include <cstring>
#include <cmath>
namespace pg8 {
#define PG8_LAS __attribute__((address_space(3)))
typedef unsigned short bf16_t;
typedef short bf16x8 __attribute__((ext_vector_type(8)));
typedef float f32x4 __attribute__((ext_vector_type(4)));
typedef unsigned u32x4 __attribute__((ext_vector_type(4)));
constexpr int BM = 256, BK = 64, HALF = 128, HTB = HALF * BK * 2  , STAGE_BYTES = 8 * HTB, NXCD = 8, WGM = 8;

__host__ __device__ __forceinline__ int lds_byte(int r, int c) { const int st = (r >> 4) * 2 + (c >> 5), rr = r & 15, cc = c & 31, ob = rr * 64 + cc * 2; return st * 1024 + (ob ^ (((ob >> 9) & 1) << 5)); }
__host__ __device__ __forceinline__ void stage_rc(int b, int& R, int& C) { const int st = b / 1024, sb = b % 1024, swz = sb ^ (((sb >> 9) & 1) << 5); R = (st >> 1) * 16 + swz / 64; C = (st & 1) * 32 + (swz % 64) / 2; }
__host__ __device__ __forceinline__ int perm32(int rho) { const int n = rho >> 4, i = rho & 15; return 8 * (i >> 2) + 4 * n + (i & 3); }

struct Unit { int pm, pn; };
struct Gemm { const bf16_t* A; const bf16_t* Bt; int M, N, K, pad; };

struct StaticOrder {
    int nM, nN, nwg, G, c;
    __host__ __device__ void init(int M, int N, int G_, int c_) { nM = M / BM; nN = N / BM; nwg = nM * nN; G = G_; c = c_; }
    __host__ __device__ bool next(int i, Unit& u) const {
        const long L = (long)i * G + c; if (L >= nwg) return false;
        int wgid = (int)L; { const int q = nwg / NXCD, r = nwg % NXCD, xcd = wgid % NXCD, off = wgid / NXCD; wgid = (xcd < r ? xcd * (q + 1) : r * (q + 1) + (xcd - r) * q) + off; }
        const int nig = WGM * nN, gid = wgid / nig, fm = gid * WGM, gsz = (nM - fm) < WGM ? (nM - fm) : WGM;
        u.pm = fm + ((wgid % nig) % gsz); u.pn = (wgid % nig) / gsz; return true;
    }
    __device__ __forceinline__ void a_ready(const Unit&) const {}
    __device__ __forceinline__ void done(const Unit&) const {}
};

__device__ __forceinline__ unsigned cvt_pk_bf16(float lo, float hi) { unsigned r; asm volatile("v_cvt_pk_bf16_f32 %0, %1, %2" : "=v"(r) : "v"(lo), "v"(hi)); return r; }
typedef float f32x2 __attribute__((ext_vector_type(2)));
struct EpiF32 {
    static constexpr bool PERM = false, AFTER_DRAIN = false;
    float* C; int ldc, pad;
    __device__ __forceinline__ void operator()(const f32x4 (&acc)[2][2][4][2], const Unit& u, int wr, int wc, int fr, int fq) const {
        const int row0 = u.pm * BM + wr * 64 + fr, col0 = u.pn * BM + wc * 32 + 4 * fq;
#pragma unroll
        for (int ai = 0; ai < 2; ++ai)
#pragma unroll
            for (int m = 0; m < 4; ++m) { float* rowp = C + (size_t)(row0 + ai * HALF + m * 16) * ldc + col0;
#pragma unroll
                for (int bj = 0; bj < 2; ++bj)
#pragma unroll
                    for (int n = 0; n < 2; ++n) *(f32x4*)(rowp + bj * HALF + n * 16) = acc[ai][bj][m][n]; }
    }
};
__device__ __forceinline__ float silu_f(float x) { return x * __builtin_amdgcn_rcpf(1.0f + __builtin_amdgcn_exp2f(-1.4426950408889634f * x)); }
struct EpiSwiGLU {
    static constexpr bool PERM = true, AFTER_DRAIN = false;
    bf16_t* H; int ldc, pad;
    __device__ __forceinline__ void operator()(const f32x4 (&acc)[2][2][4][2], const Unit& u, int wr, int wc, int fr, int fq) const {
        const int row0 = u.pm * BM + wr * 64 + fr, col0 = u.pn * HALF + wc * 32 + 8 * fq;
#pragma unroll
        for (int ai = 0; ai < 2; ++ai)
#pragma unroll
            for (int m = 0; m < 4; ++m) { bf16_t* rowp = H + (size_t)(row0 + ai * HALF + m * 16) * ldc + col0;
                const f32x4 g0 = acc[ai][0][m][0], g1 = acc[ai][0][m][1], u0 = acc[ai][1][m][0], u1 = acc[ai][1][m][1];
                u32x4 w;
                w.x = cvt_pk_bf16(silu_f(g0[0]) * u0[0], silu_f(g0[1]) * u0[1]); w.y = cvt_pk_bf16(silu_f(g0[2]) * u0[2], silu_f(g0[3]) * u0[3]);
                w.z = cvt_pk_bf16(silu_f(g1[0]) * u1[0], silu_f(g1[1]) * u1[1]); w.w = cvt_pk_bf16(silu_f(g1[2]) * u1[2], silu_f(g1[3]) * u1[3]);
                *(u32x4*)rowp = w; }
    }
};
template <class Epi, class Sched, bool ALIGN_EPI = false, bool SP2 = false>
__device__ __forceinline__ void gemm_phase(PG8_LAS unsigned char* lds, const Gemm g, const Sched& S, const Epi& E) {
    int tid_l = threadIdx.x; asm volatile("" : "+v"(tid_l));
    const int tid = tid_l, wid = __builtin_amdgcn_readfirstlane(tid >> 6), lane = tid & 63, wr = wid >> 2, wc = wid & 3, fr = lane & 15, fq = lane >> 4;
    const int K = g.K, nt = K / BK;
    unsigned voffA[2], voffB[2];
#pragma unroll
    for (int i = 0; i < 2; ++i) { int R, C; stage_rc(tid * 16 + i * 8192, R, C); const int Rb = Epi::PERM ? ((R & ~31) + perm32(R & 31)) : R;
        voffA[i] = (unsigned)(R * K + C) * 2u; voffB[i] = (unsigned)(Rb * K + C) * 2u; }
    const size_t kstep = (size_t)(BK * 2);
    const size_t hstep = (size_t)HALF * K * 2;
    const size_t tstep = 2 * hstep;
    const unsigned ldsw = (unsigned)wid * 1024u;
    const int aoff = lds_byte(wr * 64 + fr, fq * 8), boff = lds_byte(wc * 32 + fr, fq * 8);
#define PG8_SA(b, h) (((b) * 2 + (h)) * HTB)
#define PG8_SB(b, h) ((4 + (b) * 2 + (h)) * HTB)
#define PG8_STAGE(bufoff, gbase, voff) do { _Pragma("unroll") for (int _i = 0; _i < 2; ++_i) \
        __builtin_amdgcn_global_load_lds((const unsigned*)((const char*)(gbase) + (voff)[_i]), (PG8_LAS unsigned*)(lds + (bufoff) + ldsw + _i * 8192), 16, 0, 0); } while (0)
#define PG8_LDA(dst, b, h) do { _Pragma("unroll") for (int m = 0; m < 4; ++m) _Pragma("unroll") for (int k = 0; k < 2; ++k) dst[m][k] = *(const PG8_LAS bf16x8*)(lds + PG8_SA(b, h) + aoff + m * 2048 + k * 1024); } while (0)
#define PG8_LDB(dst, b, h) do { _Pragma("unroll") for (int n = 0; n < 2; ++n) _Pragma("unroll") for (int k = 0; k < 2; ++k) dst[n][k] = *(const PG8_LAS bf16x8*)(lds + PG8_SB(b, h) + boff + n * 2048 + k * 1024); } while (0)
#define PG8_MMA(ai, bj, At, Bt) do { __builtin_amdgcn_s_setprio(1); _Pragma("unroll") for (int m = 0; m < 4; ++m) _Pragma("unroll") for (int n = 0; n < 2; ++n) _Pragma("unroll") for (int k = 0; k < 2; ++k) \
        acc[ai][bj][m][n] = __builtin_amdgcn_mfma_f32_16x16x32_bf16(Bt[n][k], At[m][k], acc[ai][bj][m][n], 0, 0, 0); __builtin_amdgcn_s_setprio(0); } while (0)
#define PG8_WAIT_V(n) asm volatile("s_waitcnt vmcnt(" #n ")" ::: "memory")
#define PG8_WAIT_L(n) asm volatile("s_waitcnt lgkmcnt(" #n ")" ::: "memory")
#define PG8_BAR __builtin_amdgcn_s_barrier()
#define PG8_SCHED __builtin_amdgcn_sched_barrier(0)
    Unit cur, nxt; int ui = 0;
    if (!S.next(0, cur)) return;
    f32x4 acc[2][2][4][2];
#pragma unroll
    for (int a = 0; a < 2; ++a)
#pragma unroll
        for (int b = 0; b < 2; ++b)
#pragma unroll
            for (int m = 0; m < 4; ++m)
#pragma unroll
                for (int n = 0; n < 2; ++n) acc[a][b][m][n] = (f32x4){0.f, 0.f, 0.f, 0.f};
    bf16x8 At[4][2], B0[2][2], B1[2][2];
    const char* cA = (const char*)g.A + (size_t)cur.pm * tstep; const char* cB = (const char*)g.Bt + (size_t)cur.pn * tstep;
    S.a_ready(cur);
    if constexpr (SP2) {
        PG8_STAGE(PG8_SB(0, 0), cB, voffB); PG8_STAGE(PG8_SB(0, 1), cB + hstep, voffB); PG8_STAGE(PG8_SA(0, 0), cA, voffA); PG8_STAGE(PG8_SA(0, 1), cA + hstep, voffA);
        if (wr == 1) PG8_BAR;
        PG8_WAIT_V(2); PG8_BAR;
        PG8_STAGE(PG8_SB(1, 0), cB + kstep, voffB); PG8_STAGE(PG8_SA(1, 0), cA + kstep, voffA); PG8_STAGE(PG8_SB(1, 1), cB + hstep + kstep, voffB);
        PG8_WAIT_V(6); PG8_BAR;
    } else {
        PG8_STAGE(PG8_SB(0, 0), cB, voffB); PG8_STAGE(PG8_SA(0, 0), cA, voffA); PG8_STAGE(PG8_SB(0, 1), cB + hstep, voffB); PG8_STAGE(PG8_SA(0, 1), cA + hstep, voffA);
        if (wr == 1) PG8_BAR;
        PG8_WAIT_V(4); PG8_BAR;
        PG8_STAGE(PG8_SB(1, 0), cB + kstep, voffB); PG8_STAGE(PG8_SA(1, 0), cA + kstep, voffA); PG8_STAGE(PG8_SB(1, 1), cB + hstep + kstep, voffB);
        PG8_WAIT_V(6); PG8_BAR;
    }
    for (;;) {
        const bool has_next = S.next(ui + 1, nxt);
        const char* nA = has_next ? (const char*)g.A + (size_t)nxt.pm * tstep : cA; const char* nB = has_next ? (const char*)g.Bt + (size_t)nxt.pn * tstep : cB;
        for (int t = 0; t < nt; t += 2) {
            const bool last = (t == nt - 2);
            const char* a1 = cA + (size_t)(t + 1) * kstep;
            const char* a2 = last ? nA : cA + (size_t)(t + 2) * kstep; const char* b2 = last ? nB : cB + (size_t)(t + 2) * kstep;
            const char* a3 = a2 + kstep; const char* b3 = b2 + kstep;
            if (last && has_next) S.a_ready(nxt);
            if constexpr (SP2) {
            PG8_LDB(B0, 0, 0); PG8_LDB(B1, 0, 1); PG8_SCHED; PG8_LDA(At, 0, 0); PG8_STAGE(PG8_SA(1, 1), a1 + hstep, voffA);
            PG8_WAIT_V(8); PG8_WAIT_L(0); PG8_BAR; PG8_MMA(0, 0, At, B0); PG8_MMA(0, 1, At, B1); PG8_BAR; PG8_SCHED;
            PG8_LDA(At, 0, 1); PG8_STAGE(PG8_SB(0, 0), b2, voffB); PG8_STAGE(PG8_SB(0, 1), b2 + hstep, voffB); PG8_STAGE(PG8_SA(0, 0), a2, voffA);
            PG8_WAIT_V(8); PG8_WAIT_L(0); PG8_BAR; PG8_MMA(1, 0, At, B0); PG8_MMA(1, 1, At, B1); PG8_BAR; PG8_SCHED;
            PG8_LDB(B0, 1, 0); PG8_LDB(B1, 1, 1); PG8_SCHED; PG8_LDA(At, 1, 0); PG8_STAGE(PG8_SA(0, 1), a2 + hstep, voffA);
            PG8_WAIT_V(8); PG8_WAIT_L(0); PG8_BAR; PG8_MMA(0, 0, At, B0); PG8_MMA(0, 1, At, B1); PG8_BAR; PG8_SCHED;
            PG8_LDA(At, 1, 1); PG8_STAGE(PG8_SB(1, 0), b3, voffB); PG8_STAGE(PG8_SB(1, 1), b3 + hstep, voffB); PG8_STAGE(PG8_SA(1, 0), a3, voffA);
            PG8_WAIT_V(8); PG8_WAIT_L(0); PG8_BAR; PG8_MMA(1, 0, At, B0); PG8_MMA(1, 1, At, B1); PG8_BAR; PG8_SCHED;
            } else {
            PG8_LDB(B0, 0, 0); PG8_SCHED; PG8_LDA(At, 0, 0); PG8_STAGE(PG8_SA(1, 1), a1 + hstep, voffA);
            PG8_WAIT_L(8); PG8_BAR; PG8_WAIT_L(0); PG8_MMA(0, 0, At, B0); PG8_BAR; PG8_SCHED;
            PG8_LDB(B1, 0, 1); PG8_STAGE(PG8_SB(0, 0), b2, voffB);
            PG8_BAR; PG8_WAIT_L(0); PG8_MMA(0, 1, At, B1); PG8_BAR;
            PG8_LDA(At, 0, 1); PG8_STAGE(PG8_SA(0, 0), a2, voffA);
            PG8_BAR; PG8_WAIT_L(0); PG8_MMA(1, 0, At, B0); PG8_BAR; PG8_SCHED;
            PG8_STAGE(PG8_SB(0, 1), b2 + hstep, voffB);
            PG8_WAIT_V(6); PG8_BAR; PG8_MMA(1, 1, At, B1); PG8_BAR;
            PG8_LDB(B0, 1, 0); PG8_SCHED; PG8_LDA(At, 1, 0); PG8_STAGE(PG8_SA(0, 1), a2 + hstep, voffA);
            PG8_WAIT_L(8); PG8_BAR; PG8_WAIT_L(0); PG8_MMA(0, 0, At, B0); PG8_BAR; PG8_SCHED;
            PG8_LDB(B1, 1, 1); PG8_STAGE(PG8_SB(1, 0), b3, voffB);
            PG8_BAR; PG8_WAIT_L(0); PG8_MMA(0, 1, At, B1); PG8_BAR;
            PG8_LDA(At, 1, 1); PG8_STAGE(PG8_SA(1, 0), a3, voffA);
            PG8_BAR; PG8_WAIT_L(0); PG8_MMA(1, 0, At, B0); PG8_BAR; PG8_SCHED;
            PG8_STAGE(PG8_SB(1, 1), b3 + hstep, voffB);
            PG8_WAIT_V(6); PG8_BAR; PG8_MMA(1, 1, At, B1); PG8_BAR;
            }
        }
        if constexpr (ALIGN_EPI) { if (wr == 0) PG8_BAR; }
        if constexpr (!Epi::AFTER_DRAIN) { E(acc, cur, wr, wc, fr, fq); S.done(cur); }
        if (!has_next) break;
#pragma unroll
        for (int a = 0; a < 2; ++a)
#pragma unroll
            for (int b = 0; b < 2; ++b)
#pragma unroll
                for (int m = 0; m < 4; ++m)
#pragma unroll
                    for (int n = 0; n < 2; ++n) acc[a][b][m][n] = (f32x4){0.f, 0.f, 0.f, 0.f};
        cur = nxt; cA = nA; cB = nB; ++ui;
        if constexpr (ALIGN_EPI) { if (wr == 1) PG8_BAR; }
    }
    PG8_WAIT_V(0);
    if constexpr (!ALIGN_EPI) { if (wr == 0) PG8_BAR; }
    PG8_BAR;
    if constexpr (Epi::AFTER_DRAIN) { E.fused(acc, cur, wr, wc, fr, fq, lds, wid, lane); S.done(cur); }
#undef PG8_SA
#undef PG8_SB
#undef PG8_STAGE
#undef PG8_LDA
#undef PG8_LDB
#undef PG8_MMA
#undef PG8_WAIT_V
#undef PG8_WAIT_L
#undef PG8_BAR
#undef PG8_SCHED
}
}
#include <hip/hip_bf16.h>
#include <cmath>
namespace attn_body {
using bf16=__hip_bfloat16;
using bf16x8=__attribute__((ext_vector_type(8)))short;
using s16x4=__attribute__((ext_vector_type(4)))short;
using f32x16=__attribute__((ext_vector_type(16)))float;
using u32x4=__attribute__((ext_vector_type(4)))unsigned;
constexpr int BATCH=8,NHEAD=8,SEQ=2048,D=64,DM=NHEAD*D,OPITCH=1024,BT_OFF=256,BT_N=2304;
constexpr int NW=8,QBLK=32,QB=QBLK*NW,KVBLK=64,NQB=SEQ/QB;
constexpr int ATTN_PITCH=DM, ATTN_UNIT_ROWS=QB;
__device__ __forceinline__ int crow(int r,int hi){return (r&3)+8*(r>>2)+4*hi;}
#define SBAR() __builtin_amdgcn_sched_barrier(0)
__device__ __forceinline__ void cmask(f32x16&p0,f32x16&p1,int jb,int qrel,int hi){
  const float NEG=-INFINITY; int kb=64*jb+4*hi;
  #pragma unroll
  for(int r=0;r<16;++r){int kv=kb+(r&3)+8*(r>>2); if(kv>qrel)p0[r]=NEG; if(kv+32>qrel)p1[r]=NEG;}
}

constexpr int NSLOT=3, SLOTB=8192;
constexpr int LDS_K=0, LDS_V=NSLOT*SLOTB, LDS_WS=2*NSLOT*SLOTB, LDS_OST=LDS_WS+NW*64*4, LDS_BYTES=LDS_OST+NW*4096;
constexpr float C2=0.125f*1.4426950408889634f;
__device__ __forceinline__ void glds16(const void*gsrc,unsigned lds_dst){unsigned keep;
  asm volatile("s_mov_b32 %0, m0\n\ts_mov_b32 m0, %2\n\ts_nop 0\n\tglobal_load_lds_dwordx4 %1, off\n\ts_mov_b32 m0, %0":"=&s"(keep):"v"(gsrc),"s"(lds_dst):"memory");}
__device__ __forceinline__ float max3f(float a,float b,float c){float r;asm("v_max3_f32 %0, %1, %2, %3":"=v"(r):"v"(a),"v"(b),"v"(c));return r;}
__device__ __forceinline__ float max2f(float a,float b){float r;asm("v_max_f32_e32 %0, %1, %2":"=v"(r):"v"(a),"v"(b));return r;}
__device__ __forceinline__ float fadd_s(float a,float b){float r;asm("v_add_f32_e32 %0, %1, %2":"=v"(r):"v"(a),"v"(b));return r;}
__device__ __forceinline__ float fsub_s(float a,float b){float r;asm("v_sub_f32_e32 %0, %1, %2":"=v"(r):"v"(a),"v"(b));return r;}
typedef float f32x2_t __attribute__((ext_vector_type(2))); typedef __bf16 bf16x2_t __attribute__((ext_vector_type(2)));
__device__ __forceinline__ unsigned cvtpk_s(float lo,float hi){f32x2_t v={lo,hi};bf16x2_t b=__builtin_convertvector(v,bf16x2_t);return __builtin_bit_cast(unsigned,b);}
#define WAIT_BAR(N) asm volatile("s_waitcnt vmcnt(" #N ") lgkmcnt(0)\n\ts_barrier":::"memory")

__device__ __forceinline__ void qkt(f32x16&p0,f32x16&p1,const char*Kslot,const bf16x8*qr,const f32x16&negm,int r32,int hi){
  const char*kb=Kslot+hi*1024+r32*16;
  #pragma unroll
  for(int d0=0;d0<4;++d0){
    const bf16x8 b0=*reinterpret_cast<const bf16x8*>(kb+d0*2048);
    const bf16x8 b1=*reinterpret_cast<const bf16x8*>(kb+d0*2048+512);
    if(d0==0){p0=__builtin_amdgcn_mfma_f32_32x32x16_bf16(b0,qr[0],negm,0,0,0);p1=__builtin_amdgcn_mfma_f32_32x32x16_bf16(b1,qr[0],negm,0,0,0);}
    else{p0=__builtin_amdgcn_mfma_f32_32x32x16_bf16(b0,qr[d0],p0,0,0,0);p1=__builtin_amdgcn_mfma_f32_32x32x16_bf16(b1,qr[d0],p1,0,0,0);}}
}
typedef __attribute__((address_space(3))) const char* lds_cptr;
typedef short v4i16_t __attribute__((ext_vector_type(4)));
__device__ __forceinline__ void kload8(bf16x8*kf,lds_cptr kp){
  kf[0]=*(const __attribute__((address_space(3))) bf16x8*)(kp);      kf[1]=*(const __attribute__((address_space(3))) bf16x8*)(kp+512);
  kf[2]=*(const __attribute__((address_space(3))) bf16x8*)(kp+2048); kf[3]=*(const __attribute__((address_space(3))) bf16x8*)(kp+2560);
  kf[4]=*(const __attribute__((address_space(3))) bf16x8*)(kp+4096); kf[5]=*(const __attribute__((address_space(3))) bf16x8*)(kp+4608);
  kf[6]=*(const __attribute__((address_space(3))) bf16x8*)(kp+6144); kf[7]=*(const __attribute__((address_space(3))) bf16x8*)(kp+6656);
}
__device__ __forceinline__ void kload2(bf16x8*kf,lds_cptr kp,int j){ kf[2*j]=*(const __attribute__((address_space(3))) bf16x8*)(kp+j*2048); kf[2*j+1]=*(const __attribute__((address_space(3))) bf16x8*)(kp+j*2048+512); }
__device__ __forceinline__ s16x4 vtr(lds_cptr p){ return __builtin_bit_cast(s16x4,__builtin_amdgcn_ds_read_tr16_b64_v4i16((__attribute__((address_space(3))) v4i16_t*)p)); }
__device__ __forceinline__ float rowmax(const f32x16&p0,const f32x16&p1){
  float a=max3f(p0[0],p0[1],p1[0]),b=max3f(p0[2],p0[3],p1[1]);a=max3f(a,p1[2],p1[3]);
  #pragma unroll
  for(int r=4;r<16;r+=4){a=max3f(a,p0[r],p0[r+1]);b=max3f(b,p0[r+2],p0[r+3]);a=max3f(a,p1[r],p1[r+1]);b=max3f(b,p1[r+2],p1[r+3]);}
  const float m=max2f(a,b);
  auto rr=__builtin_amdgcn_permlane32_swap(__float_as_uint(m),__float_as_uint(m),false,false);
  return max2f(__uint_as_float(rr[0]),__uint_as_float(rr[1]));
}
__device__ __forceinline__ void pv(f32x16*o,int vb,bf16x8 pa0,bf16x8 pa1,bf16x8 pa2,bf16x8 pa3){
  #pragma unroll
  for(int d0=0;d0<2;++d0){s16x4 lo[4],hi[4];
    #pragma unroll
    for(int ks=0;ks<4;++ks){
      asm volatile("ds_read_b64_tr_b16 %0,%1 offset:%c2":"=&v"(lo[ks]):"v"(vb),"i"(d0*4096+ks*1024):"memory");
      asm volatile("ds_read_b64_tr_b16 %0,%1 offset:%c2":"=&v"(hi[ks]):"v"(vb),"i"(d0*4096+ks*1024+512):"memory");}
    asm volatile("s_waitcnt lgkmcnt(0)":::"memory");SBAR();
    #define PK(k) (bf16x8){lo[k][0],lo[k][1],lo[k][2],lo[k][3],hi[k][0],hi[k][1],hi[k][2],hi[k][3]}
    o[d0]=__builtin_amdgcn_mfma_f32_32x32x16_bf16(pa0,PK(0),o[d0],0,0,0);
    o[d0]=__builtin_amdgcn_mfma_f32_32x32x16_bf16(pa1,PK(1),o[d0],0,0,0);
    o[d0]=__builtin_amdgcn_mfma_f32_32x32x16_bf16(pa2,PK(2),o[d0],0,0,0);
    o[d0]=__builtin_amdgcn_mfma_f32_32x32x16_bf16(pa3,PK(3),o[d0],0,0,0);
    #undef PK
  }
}

#ifndef ATTN_STORE16
#define ATTN_STORE16(p,v) (*(u32x4*)(p)=(v))
#endif
template<int THRL> __device__ __forceinline__ void attn_unit(int b,int h,int qb,const bf16*Q,const bf16*__restrict__ K,const bf16*__restrict__ V,bf16*O,char*shm,const __attribute__((address_space(3))) float* btab){
  int tid_l=threadIdx.x; asm volatile("":"+v"(tid_l)); const int tid=tid_l,lane=tid&63,r32=lane&31,hi=lane>>5; const int wid=__builtin_amdgcn_readfirstlane(tid>>6);
  const long rowbase=(long)b*SEQ; const int q0=qb*QB;
  const bf16*Qw=Q+(rowbase+q0+wid*QBLK)*DM+h*D;
  const bf16*Kh=K+rowbase*DM+h*D,*Vh=V+rowbase*DM+h*D;
  const unsigned lds0=(unsigned)(uintptr_t)shm;
  float*wsf=(float*)(shm+LDS_WS)+wid*64;
  const bf16*ksrc=Kh+(long)lane*DM+wid*8;
  const bf16*vsrc=Vh+(long)(16*(wid&3)+(lane>>2))*DM+(wid>>2)*32+(lane&3)*8;
  const unsigned kdst=lds0+LDS_K+wid*1024, vdst=lds0+LDS_V+wid*1024;
  #define DMA_K(t,slot) glds16(ksrc+(long)(t)*KVBLK*DM,(unsigned)__builtin_amdgcn_readfirstlane(kdst+(slot)))
  #define DMA_V(t,slot) glds16(vsrc+(long)(t)*KVBLK*DM,(unsigned)__builtin_amdgcn_readfirstlane(vdst+(slot)))
  const int vb0=(int)(lds0+LDS_V)+((lane>>4)&1)*32+(lane&3)*8+(4*hi+((lane&15)>>2))*64;
  const char*Kbase=shm+LDS_K; bf16x8 kf[8];
  const lds_cptr shm3=(lds_cptr)shm; const lds_cptr kp0=shm3+LDS_K+hi*1024+r32*16; const lds_cptr vp0=shm3+LDS_V+((lane>>4)&1)*32+(lane&3)*8+(4*hi+((lane&15)>>2))*64;
  const int NT=(q0+QB)/KVBLK;
  DMA_K(0,0);DMA_V(0,0);DMA_K(1,SLOTB);
  bf16x8 qr[4];
  #pragma unroll
  for(int d0=0;d0<4;++d0)qr[d0]=*reinterpret_cast<const bf16x8*>(&Qw[(long)r32*DM+d0*16+hi*8]);
  float mhat=0.f,l_reg=0.f;f32x16 o[2];o[0]=f32x16{};o[1]=f32x16{};const f32x16 zero16=f32x16{};
    const int qabs=q0+wid*QBLK+r32;
  #define CMASK(P0,P1,t) do{ const __attribute__((address_space(3))) float* bp_=btab+(BT_OFF-59+qabs-64*(t)-4*hi); \
    _Pragma("unroll") for(int r=0;r<16;++r){ const int x_=(r&3)+8*(r>>2); P0[r]=fadd_s(P0[r],fsub_s(bp_[59-x_],mhat)); P1[r]=fadd_s(P1[r],fsub_s(bp_[27-x_],mhat)); } }while(0)
  bool resc=false;
  #define START(P0,P1) do{ const float rm=rowmax(P0,P1); resc=false; \
    { const float dl=rm; mhat=fadd_s(mhat,dl); \
      _Pragma("unroll") for(int r=0;r<16;++r){P0[r]=fsub_s(P0[r],dl);P1[r]=fsub_s(P1[r],dl);} \
      } \
    _Pragma("unroll") for(int r=0;r<16;++r)P0[r]=__builtin_amdgcn_exp2f(P0[r]); }while(0)
  #define RESC() do{ if(resc){ asm volatile("s_waitcnt lgkmcnt(0)":::"memory"); \
      _Pragma("unroll") for(int d_=0;d_<2;++d_) _Pragma("unroll") for(int r=0;r<16;++r)o[d_][r]*=wsf[crow(r,hi)]; } }while(0)
  f32x16 pA0,pA1,pB0,pB1;
  int sl_prev=0,sl_cur=0,sl_next=SLOTB;
  #define ROT() do{sl_prev=sl_cur;sl_cur=sl_next;sl_next=(sl_next==(NSLOT-1)*SLOTB)?0:sl_next+SLOTB;}while(0)
  DMA_K(2,2*SLOTB);
  WAIT_BAR(3);
  qkt(pA0,pA1,Kbase,qr,zero16,r32,hi);asm volatile("s_nop 15\n\ts_nop 7":"+v"(pA0),"+v"(pA1));CMASK(pA0,pA1,0);
  START(pA0,pA1);
  _Pragma("unroll") for(int r=0;r<16;++r)pA1[r]=__builtin_amdgcn_exp2f(pA1[r]);
  WAIT_BAR(0);
  DMA_K(3,0);DMA_V(1,SLOTB);
  ROT();
  kload8(kf,kp0+sl_cur);
  WAIT_BAR(2);
  s16x4 vlo[8],vhi[8]; u32x4 pw0,pw1,pw2,pw3;
  #define PKW(P,B) cvtpk_s(P[B],P[B+1])
  #define PAF(k) __builtin_bit_cast(bf16x8,pw##k)
  #define VFR(i) (bf16x8){vlo[i][0],vlo[i][1],vlo[i][2],vlo[i][3],vhi[i][0],vhi[i][1],vhi[i][2],vhi[i][3]}
  #define PIN(x) asm volatile("":"+v"(x))
  #define MX3(a,b,c) __builtin_fmaxf(__builtin_fmaxf((a),(b)),(c))
  #define GAPA(MF,A0,A1,A2,A3,W0,W1,PW) do{ MF; sacc+=A0; sacc+=A1; sacc+=A2; sacc+=A3; PIN(sacc); W0; W1; PIN(PW); SBAR(); }while(0)
  #define EX(v) __builtin_amdgcn_exp2f(v)
  #define GAPB(MF,X,B) do{ MF; X[B]=EX(X[B]); X[B+1]=EX(X[B+1]); X[B+2]=EX(X[B+2]); X[B+3]=EX(X[B+3]); PIN(X); SBAR(); }while(0)
  #define VRD(i) do{ vlo[i]=vtr(vp_+(((i)>>2)*4096+((i)&3)*1024)); vhi[i]=vtr(vp_+(((i)>>2)*4096+((i)&3)*1024+512)); }while(0)
  #define KRD(G,j) do{ if(G){ kload2(kf,kp0+sl_next,j); SBAR(); } }while(0)
  #define STEP(C0,C1,P0,P1,t,GK,GV,GL) do{ SBAR(); \
    const lds_cptr vp_=vp0+sl_prev; \
    VRD(0); SBAR(); float sacc=(P0[0]+P0[1]); \
    GAPA(C0=__builtin_amdgcn_mfma_f32_32x32x16_bf16(kf[0],qr[0],zero16,0,0,0), P0[2],P0[3],P0[4],P0[5],     pw0[0]=PKW(P0,0), pw0[1]=PKW(P0,2), pw0); \
    VRD(4); SBAR(); GAPA(C1=__builtin_amdgcn_mfma_f32_32x32x16_bf16(kf[1],qr[0],zero16,0,0,0), P0[6],P0[7],P0[8],P0[9],     pw0[2]=PKW(P0,4), pw0[3]=PKW(P0,6), pw0); \
    VRD(1); SBAR(); GAPA(C0=__builtin_amdgcn_mfma_f32_32x32x16_bf16(kf[2],qr[1],C0,0,0,0),   P0[10],P0[11],P0[12],P0[13], pw1[0]=PKW(P0,8), pw1[1]=PKW(P0,10), pw1); \
    VRD(5); SBAR(); GAPA(C1=__builtin_amdgcn_mfma_f32_32x32x16_bf16(kf[3],qr[1],C1,0,0,0),   P0[14],P0[15],P1[0],P1[1],   pw1[2]=PKW(P0,12),pw1[3]=PKW(P0,14), pw1); \
    VRD(2); SBAR(); GAPA(C0=__builtin_amdgcn_mfma_f32_32x32x16_bf16(kf[4],qr[2],C0,0,0,0),   P1[2],P1[3],P1[4],P1[5],     pw2[0]=PKW(P1,0), pw2[1]=PKW(P1,2), pw2); \
    VRD(6); SBAR(); GAPA(C1=__builtin_amdgcn_mfma_f32_32x32x16_bf16(kf[5],qr[2],C1,0,0,0),   P1[6],P1[7],P1[8],P1[9],     pw2[2]=PKW(P1,4), pw2[3]=PKW(P1,6), pw2); \
    VRD(3); SBAR(); GAPA(C0=__builtin_amdgcn_mfma_f32_32x32x16_bf16(kf[6],qr[3],C0,0,0,0),   P1[10],P1[11],P1[12],P1[13], pw3[0]=PKW(P1,8), pw3[1]=PKW(P1,10), pw3); \
    VRD(7); SBAR(); GAPA(C1=__builtin_amdgcn_mfma_f32_32x32x16_bf16(kf[7],qr[3],C1,0,0,0),   P1[14],P1[15],0.f,0.f,       pw3[2]=PKW(P1,12),pw3[3]=PKW(P1,14), pw3); \
    l_reg+=sacc; \
    if(GK){DMA_K((t)+3,sl_cur);} if(GV){DMA_V((t)+1,sl_next);} \
    CMASK(C0,C1,t); \
    { float a=MX3(C0[0],C0[1],C1[0]),b=MX3(C0[2],C0[3],C1[1]); a=MX3(a,C1[2],C1[3]); \
      _Pragma("unroll") for(int r=4;r<16;r+=4){a=MX3(a,C0[r],C0[r+1]);b=MX3(b,C0[r+2],C0[r+3]);a=MX3(a,C1[r],C1[r+1]);b=MX3(b,C1[r+2],C1[r+3]);} \
      float rm=__builtin_fmaxf(a,b); { auto rr=__builtin_amdgcn_permlane32_swap(__float_as_uint(rm),__float_as_uint(rm),false,false); rm=__builtin_fmaxf(__uint_as_float(rr[0]),__uint_as_float(rr[1])); } \
      resc=false; \
      if(__builtin_expect(__any(rm>(float)THRL),0)){ const float dl=__builtin_fmaxf(rm,0.f); mhat+=dl; \
        _Pragma("unroll") for(int r=0;r<16;++r){C0[r]-=dl;C1[r]-=dl;} \
        const float f=__builtin_amdgcn_exp2f(-dl); l_reg*=f; if(hi==0)wsf[r32]=f; resc=true; } } \
    SBAR(); \
    GAPB(o[0]=__builtin_amdgcn_mfma_f32_32x32x16_bf16(PAF(0),VFR(0),o[0],0,0,0), C0,0); \
    GAPB(o[1]=__builtin_amdgcn_mfma_f32_32x32x16_bf16(PAF(0),VFR(4),o[1],0,0,0), C0,4); \
    KRD(GL,0); GAPB(o[0]=__builtin_amdgcn_mfma_f32_32x32x16_bf16(PAF(1),VFR(1),o[0],0,0,0), C0,8); \
    KRD(GL,1); GAPB(o[1]=__builtin_amdgcn_mfma_f32_32x32x16_bf16(PAF(1),VFR(5),o[1],0,0,0), C0,12); \
    KRD(GL,2); GAPB(o[0]=__builtin_amdgcn_mfma_f32_32x32x16_bf16(PAF(2),VFR(2),o[0],0,0,0), C1,0); \
    KRD(GL,3); GAPB(o[1]=__builtin_amdgcn_mfma_f32_32x32x16_bf16(PAF(2),VFR(6),o[1],0,0,0), C1,4); \
    GAPB(o[0]=__builtin_amdgcn_mfma_f32_32x32x16_bf16(PAF(3),VFR(3),o[0],0,0,0), C1,8); \
    GAPB(o[1]=__builtin_amdgcn_mfma_f32_32x32x16_bf16(PAF(3),VFR(7),o[1],0,0,0), C1,12); \
    }while(0)
  int t=1;
  for(;t+5<NT;t+=2){
    STEP(pB0,pB1,pA0,pA1,t,true,true,true);     WAIT_BAR(2); RESC(); ROT();
    STEP(pA0,pA1,pB0,pB1,t+1,true,true,true);   WAIT_BAR(2); RESC(); ROT();
  }
  #define ENDW(tt) do{ if((tt)+3<NT){WAIT_BAR(2);} else if((tt)+2<NT){WAIT_BAR(1);} else {WAIT_BAR(0);} }while(0)
  for(;t+1<NT;t+=2){
    STEP(pB0,pB1,pA0,pA1,t,(t+3<NT),(t+1<NT),(t+1<NT));       ENDW(t);   RESC(); ROT();
    STEP(pA0,pA1,pB0,pB1,t+1,(t+4<NT),(t+2<NT),(t+2<NT));     ENDW(t+1); RESC(); ROT();
  }
  STEP(pB0,pB1,pA0,pA1,NT-1,false,false,false); RESC();
  { float sacc=pB0[0]+pB0[1]; _Pragma("unroll") for(int r=2;r<16;++r)sacc+=pB0[r]; _Pragma("unroll") for(int r=0;r<16;++r)sacc+=pB1[r]; l_reg+=sacc;
    pw0=(u32x4){PKW(pB0,0),PKW(pB0,2),PKW(pB0,4),PKW(pB0,6)};pw1=(u32x4){PKW(pB0,8),PKW(pB0,10),PKW(pB0,12),PKW(pB0,14)};pw2=(u32x4){PKW(pB1,0),PKW(pB1,2),PKW(pB1,4),PKW(pB1,6)};pw3=(u32x4){PKW(pB1,8),PKW(pB1,10),PKW(pB1,12),PKW(pB1,14)};
    SBAR(); pv(o,vb0+sl_cur,PAF(0),PAF(1),PAF(2),PAF(3)); }
  #undef PKW
  #undef PAF
  #undef VFR
  #undef PIN
  #undef MX3
  #undef GAPA
  #undef GAPB
  #undef EX
  #undef VRD
  #undef KRD
  #undef STEP
  #undef ENDW
  {auto rr=__builtin_amdgcn_permlane32_swap(__float_as_uint(l_reg),__float_as_uint(l_reg),false,false);l_reg=__uint_as_float(rr[0])+__uint_as_float(rr[1]);}
  if(hi==0)wsf[32+r32]=l_reg;asm volatile("s_waitcnt lgkmcnt(0)":::"memory");
  float rli[16];
  #pragma unroll
  for(int r=0;r<16;++r)rli[r]=__builtin_amdgcn_rcpf(wsf[32+crow(r,hi)]);
  bf16*Ow=O+(rowbase+q0+wid*QBLK)*OPITCH+h*D;
  { bf16*stg=(bf16*)(shm+LDS_OST)+wid*2048;
    #pragma unroll
    for(int r=0;r<16;++r){const int orow=crow(r,hi);
      #pragma unroll
      for(int d0=0;d0<2;++d0)stg[orow*64+d0*32+r32]=__float2bfloat16(o[d0][r]*rli[r]);}
    asm volatile("s_waitcnt lgkmcnt(0)":::"memory");
    #pragma unroll
    for(int i=0;i<4;++i){const int row=i*8+(lane>>3),ch=lane&7; const u32x4 v=*(const u32x4*)(stg+row*64+ch*8); ATTN_STORE16(Ow+(long)row*OPITCH+ch*8,v);} }
  asm volatile("s_waitcnt lgkmcnt(0)\n\ts_barrier":::"memory");
  #undef DMA_K
  #undef DMA_V
  #undef CMASK
  #undef START
  #undef RESC
  #undef ROT
}
constexpr int ATTN_LDS_BYTES=LDS_BYTES;
struct AttnTensors { const bf16* Q; const bf16* K; const bf16* V; bf16* O; };
struct AttnUnit { int bh; int qb; };
struct StaticOrder {
  int vcu;
  __device__ __forceinline__ explicit StaticOrder(int grid,int block):vcu((block%8)*(grid/8)+block/8){}
  __device__ __forceinline__ bool next(int i,AttnUnit&u)const{ if(i>=2)return false; const int s=vcu&3; u.bh=vcu>>2; u.qb=(i==0)?s:7-s; return true; }
  __device__ __forceinline__ void a_ready(const AttnUnit&)const{}
  __device__ __forceinline__ void done(const AttnUnit&)const{}
};
constexpr int BT_LDS_OFF=86016, ATTN_LDS_TOTAL=BT_LDS_OFF+BT_N*4;
__device__ __forceinline__ int t5b(int n){ if(n<16)return n; int b=16; b+=(n>=22);b+=(n>=30);b+=(n>=40);b+=(n>=54);b+=(n>=73);b+=(n>=99);b+=(n>=134);b+=(n>=182);b+=(n>=246);b+=(n>=332);b+=(n>=450);b+=(n>=609);b+=(n>=825);b+=(n>=1117);b+=(n>=1513); return b; }
__device__ __forceinline__ void build_btab(__attribute__((address_space(3))) float* bt,const float*relb,int h){
  for(int i=threadIdx.x;i<BT_N;i+=NW*64){ const int dl=i-BT_OFF; float v=-INFINITY;
    if(dl>=0){ const int c=(dl<=128?1:0)+(((dl&3)==0&&dl<=512)?1:0)+(((dl&15)==0&&dl<=2048)?1:0);
      if(c>0) v=(relb[t5b(dl)*NHEAD+h]+(c==1?0.f:(c==2?0.6931471805599453f:1.0986122886681098f)))*1.4426950408889634f; }
    bt[i]=v; }
}
template<class Sched,int THRL=8> __device__ __forceinline__ void attn_phase(char*lds,const AttnTensors&T,const float*relb,const Sched&S){
  AttnUnit u; int cur_h=-1;
  __attribute__((address_space(3))) float* bt=(__attribute__((address_space(3))) float*)((__attribute__((address_space(3))) char*)lds+BT_LDS_OFF);
  for(int i=0;S.next(i,u);++i){ S.a_ready(u);
    const int h=u.bh%NHEAD;
    if(h!=cur_h){ asm volatile("s_waitcnt lgkmcnt(0)\n\ts_barrier":::"memory"); build_btab(bt,relb,h); asm volatile("s_waitcnt lgkmcnt(0)\n\ts_barrier":::"memory"); cur_h=h; }
    attn_unit<THRL>(u.bh/NHEAD,u.bh%NHEAD,u.qb,T.Q,T.K,T.V,T.O,lds,bt); S.done(u); }
}
#undef SBAR
#undef WAIT_BAR
}
#define GAS __attribute__((address_space(1)))
#define LAS __attribute__((address_space(3)))
typedef unsigned short bf16;
typedef unsigned v4u __attribute__((ext_vector_type(4)));
typedef float f32x4 __attribute__((ext_vector_type(4)));
typedef short bf16x8 __attribute__((ext_vector_type(8)));
typedef GAS unsigned gu32;
typedef GAS unsigned long long gu64;
#define RLX_AGENT __ATOMIC_RELAXED, __HIP_MEMORY_SCOPE_AGENT
#define LDS_WAIT() asm volatile("s_waitcnt lgkmcnt(0)" ::: "memory")
#define VM_WAIT() asm volatile("s_waitcnt vmcnt(0)" ::: "memory")
__device__ __forceinline__ unsigned long long rt() { return __builtin_amdgcn_s_memrealtime(); }
__device__ __forceinline__ unsigned f2bf(float f) { unsigned u = __builtin_bit_cast(unsigned, f); return (u + 0x7fffu + ((u >> 16) & 1u)) >> 16; }
__device__ __forceinline__ unsigned pk2(float lo, float hi) { return f2bf(lo) | (f2bf(hi) << 16); }
#define XB_TMO      128
#define XB_XCNT(j)  (256  + 64 * (j))
#define XB_XSUB(j)  (1280 + 64 * (j))
#define XB_XGEN(j)  (2304 + 64 * (j))
#define XB_TOP      3328
#define XB_TOPGEN   3392
#define XCD_BAR_WORDS 3456
#define XB_SPIN_CAP (1u << 18)

__device__ __forceinline__ unsigned xb_ld(unsigned* p)              { return __hip_atomic_load(p, __ATOMIC_RELAXED, __HIP_MEMORY_SCOPE_AGENT); }
__device__ __forceinline__ unsigned xb_add(unsigned* p, unsigned v) { return __hip_atomic_fetch_add(p, v, __ATOMIC_RELAXED, __HIP_MEMORY_SCOPE_AGENT); }
__device__ __forceinline__ unsigned xb_xcc_id() { return (unsigned)__builtin_amdgcn_s_getreg((3 << 11) | 20) & 0xFu; }
#define XB_SPIN(cond, bar) do { unsigned _sp = 0; while (cond) { __builtin_amdgcn_s_sleep(1); \
    if ((++_sp & 255u) == 0u) { if (xb_ld(&(bar)[XB_TMO])) break; if (_sp > XB_SPIN_CAP) { atomicAdd(&(bar)[XB_TMO], 1u); break; } } } } while (0)

struct XcdBarrier {
    unsigned* bar; unsigned x;
    volatile LAS unsigned* st;
};

__device__ __forceinline__ XcdBarrier xcd_barrier_post(unsigned* bar, volatile LAS unsigned* st) {
    XcdBarrier b; b.bar = bar; b.x = xb_xcc_id(); b.st = st;
    if (threadIdx.x == 0) (void)xb_add(&bar[XB_XCNT(b.x)], 1u);
    return b;
}
__device__ __forceinline__ void xcd_barrier_complete(unsigned* bar, unsigned x, unsigned& nloc, unsigned& nx) {
    const unsigned G = gridDim.x * gridDim.y * gridDim.z;
    unsigned sum, cnt, mine, sp = 0u;
    for (;;) {
        sum = 0u; cnt = 0u; mine = 0u;
#pragma unroll
        for (unsigned j = 0; j < 16; ++j) { const unsigned c = xb_ld(&bar[XB_XCNT(j)]); sum += c; cnt += (c > 0u) ? 1u : 0u; mine = (j == x) ? c : mine; }
        if (sum == G) break;
        __builtin_amdgcn_s_sleep(1);
        if ((++sp & 255u) == 0u) { if (xb_ld(&bar[XB_TMO])) break; if (sp > XB_SPIN_CAP) { atomicAdd(&bar[XB_TMO], 1u); break; } }
    }
    nloc = mine > 0u ? mine : 1u; nx = cnt > 0u ? cnt : 1u;
}

__device__ __forceinline__ void xcd_barrier(const XcdBarrier& b) {
    asm volatile("s_waitcnt vmcnt(0)" ::: "memory");
    __syncthreads();
    if (threadIdx.x == 0) {
        unsigned* bar = b.bar;
        __builtin_amdgcn_s_waitcnt(0);
        unsigned nloc = b.st[0], nx = b.st[1];
        if (nloc == 0u) { xcd_barrier_complete(bar, b.x, nloc, nx); b.st[0] = nloc; b.st[1] = nx; }
        const unsigned old = xb_add(&bar[XB_XSUB(b.x)], 1u);
        const unsigned gen = old / nloc;
        if (old + 1u == (gen + 1u) * nloc) {
            __builtin_amdgcn_fence(__ATOMIC_RELEASE, "agent");
            asm volatile("s_waitcnt vmcnt(0)" ::: "memory");
            const unsigned og = xb_add(&bar[XB_TOP], 1u);
            const unsigned tg = og / nx;
            if (og + 1u == (tg + 1u) * nx) xb_add(&bar[XB_TOPGEN], 1u);
            else XB_SPIN(xb_ld(&bar[XB_TOPGEN]) == tg, bar);
            __builtin_amdgcn_fence(__ATOMIC_ACQUIRE, "agent");
            xb_add(&bar[XB_XGEN(b.x)], 1u);
            asm volatile("s_waitcnt vmcnt(0)" ::: "memory");
        } else {
            XB_SPIN(xb_ld(&bar[XB_XGEN(b.x)]) == gen, bar);
            __builtin_amdgcn_fence(__ATOMIC_ACQUIRE, "agent");
            asm volatile("s_waitcnt vmcnt(0)" ::: "memory");
        }
    }
    __syncthreads();
}
namespace gdn {
#define GLAS __attribute__((address_space(3)))
typedef short bf16x8 __attribute__((ext_vector_type(8)));
typedef float f32x16 __attribute__((ext_vector_type(16)));
typedef float f32x2_t __attribute__((ext_vector_type(2))); typedef __bf16 bf16x2_t __attribute__((ext_vector_type(2)));
typedef unsigned u32x4 __attribute__((ext_vector_type(4)));
typedef unsigned u32x2 __attribute__((ext_vector_type(2)));
typedef float f32x4 __attribute__((ext_vector_type(4)));
#define GDI __device__ __forceinline__
#define GMFMA(a, b, c) __builtin_amdgcn_mfma_f32_32x32x16_bf16((a), (b), (c), 0, 0, 0)
GDI unsigned cvtpk(float lo, float hi) { f32x2_t v = {lo, hi}; bf16x2_t b = __builtin_convertvector(v, bf16x2_t); return __builtin_bit_cast(unsigned, b); }
GDI unsigned short cvt1(float x) { return (unsigned short)(cvtpk(x, 0.f) & 0xffffu); }
GDI constexpr int crow(int r, int hi) { return (r & 3) + 8 * (r >> 2) + 4 * hi; }
template <class T> GDI T* uni_ptr(T* p) { const unsigned long long u = (unsigned long long)p; const unsigned lo = __builtin_amdgcn_readfirstlane((unsigned)u), hi = __builtin_amdgcn_readfirstlane((unsigned)(u >> 32)); return (T*)(((unsigned long long)hi << 32) | lo); }
GDI float rdl(float v, int l) { return __builtin_bit_cast(float, __builtin_amdgcn_readlane(__builtin_bit_cast(int, v), l)); }
#define GDPP(x, ctrl, rmask) __builtin_bit_cast(float, __builtin_amdgcn_update_dpp(0, __builtin_bit_cast(int, (x)), (ctrl), (rmask), 0xF, false))
GDI float wsum(float v) {
    v += GDPP(v, 0xB1, 0xF); v += GDPP(v, 0x4E, 0xF); v += GDPP(v, 0x141, 0xF); v += GDPP(v, 0x140, 0xF);
    v += GDPP(v, 0x142, 0xA); v += GDPP(v, 0x143, 0xC);
    return rdl(v, 63);
}
constexpr int R_NEGW = 0, R_Q = 8192, R_INTRA = 16384, R_KT = 24576, R_U = 32768, R_SC = 49152, R_BYTES = 50176, R_TMP = 50176, R_STRIDE = 66560;
constexpr int NCH = 32, CH = 64, NIN_P = 3840, C_GQKV_ = 1536, C_B_ = 3584, C_A_ = 3592, SEQ_ = 2048;
GDI int frag_off(int R, int K) { return ((((R >> 5) * 4 + (K >> 4)) * 2 + ((K >> 2) & 1)) * 32 + (R & 31)) * 16 + ((((K >> 3) & 1) * 4) + (K & 3)) * 2; }
GDI int img_off(int row, int d) { return row * 128 + ((((d >> 3) ^ (row & 7))) << 4) + (d & 7) * 2; }
GDI bf16x8 img_frag(const GLAS unsigned char* img, int row0, int ks, int lane) {
    const int r = lane & 31, hh = lane >> 5, row = row0 + r;
    return *(const GLAS bf16x8*)(img + row * 128 + ((((2 * ks + hh) ^ (row & 7))) << 4));
}

GDI void pre_unit(int unit, const float* __restrict__ P, const float* __restrict__ convw, const float* __restrict__ alog, const float* __restrict__ dtb, unsigned char* __restrict__ rec_base, GLAS unsigned char* lw, int lane_in) {
    int lane = lane_in; asm volatile("" : "+v"(lane));
    const int bh = unit >> 5, c = unit & 31, b = bh >> 3, h = bh & 7;
    const int m0 = b * SEQ_ + c * CH;
    unsigned char* rec = uni_ptr(rec_base + (size_t)unit * R_STRIDE);
    GLAS unsigned char* q16 = lw; GLAS unsigned char* k16 = lw + 8192; GLAS float* AT = (GLAS float*)lw;
    float bt_v, gc_v, eg_v;
    {   const float* pr = P + (size_t)(m0 + lane) * NIN_P;
        const float aa = pr[C_A_ + h] + dtb[h], bb = pr[C_B_ + h];
        const float sp = (aa > 20.f) ? aa : log1pf(__expf(aa));
        const float g = -__expf(alog[h]) * sp;
        bt_v = 1.0f / (1.0f + __expf(-bb));
        float s = g;
#pragma unroll
        for (int o = 1; o < 64; o <<= 1) { const float t = __shfl_up(s, o); if (lane >= o) s += t; }
        gc_v = s; eg_v = __expf(gc_v);
        const float gcl = rdl(gc_v, 63);
        float* sc = (float*)(rec + R_SC);
        sc[lane] = eg_v; sc[64 + lane] = __expf(gcl - gc_v); if (lane == 0) sc[128] = __expf(gcl);
    }
    float W[64];
    float* ug = (float*)(rec + R_U); float* tg = (float*)(rec + R_TMP);
    {   const int ch = h * 64 + lane;
        float wq[4], wk[4], wv[4];
#pragma unroll
        for (int j = 0; j < 4; ++j) { wq[j] = convw[j * 1536 + ch]; wk[j] = convw[j * 1536 + 512 + ch]; wv[j] = convw[j * 1536 + 1024 + ch]; }
        const float* pbs = uni_ptr(P + (size_t)m0 * NIN_P + C_GQKV_ + h * 64 + 512);
        float q1 = 0.f, q2 = 0.f, q3 = 0.f, k1 = 0.f, k2 = 0.f, k3 = 0.f, v1 = 0.f, v2 = 0.f, v3 = 0.f;
        if (c > 0) { const float* p3 = pbs - 3 * NIN_P; const float* p2 = pbs - 2 * NIN_P; const float* p1 = pbs - NIN_P;
            q1 = p3[lane - 512]; k1 = p3[lane]; v1 = p3[lane + 512]; q2 = p2[lane - 512]; k2 = p2[lane]; v2 = p2[lane + 512]; q3 = p1[lane - 512]; k3 = p1[lane]; v3 = p1[lane + 512]; }
        float kwin[16];
#pragma unroll
        for (int t8 = 0; t8 < 64; t8 += 4) {
            asm volatile("" ::: "memory");
            float xq[4], xk[4], xv[4];
#pragma unroll
            for (int u = 0; u < 4; ++u) { const float* rp = pbs + (size_t)(t8 + u) * NIN_P; xq[u] = rp[lane - 512]; xk[u] = rp[lane]; xv[u] = rp[lane + 512]; }
#pragma unroll
            for (int u = 0; u < 4; ++u) { const int t = t8 + u;
                float cq = wq[0] * q1 + wq[1] * q2 + wq[2] * q3 + wq[3] * xq[u];
                float ck = wk[0] * k1 + wk[1] * k2 + wk[2] * k3 + wk[3] * xk[u];
                float cv = wv[0] * v1 + wv[1] * v2 + wv[2] * v3 + wv[3] * xv[u];
                q1 = q2; q2 = q3; q3 = xq[u]; k1 = k2; k2 = k3; k3 = xk[u]; v1 = v2; v2 = v3; v3 = xv[u];
                cq = cq / (1.0f + __expf(-cq)); ck = ck / (1.0f + __expf(-ck)); cv = cv / (1.0f + __expf(-cv));
                const float qn = wsum(cq * cq), kn = wsum(ck * ck);
                const float qv = cq * (1.0f / sqrtf(qn + 1e-6f)) * 0.125f, kv = ck * (1.0f / sqrtf(kn + 1e-6f));
                *(GLAS unsigned short*)(q16 + img_off(t, lane)) = cvt1(qv);
                *(GLAS unsigned short*)(k16 + img_off(t, lane)) = cvt1(kv);
                const float bt = rdl(bt_v, t), eg = rdl(eg_v, t);
                W[t] = bt * cv; { float* tb = uni_ptr(tg + (t >> 4) * 1024); tb[(t & 15) * 64 + lane] = bt * eg * kv; }
                kwin[t & 15] = kv;
                if ((t & 15) == 15) {
                    const int s = t >> 4, rt = lane >> 5, r = lane & 31;
                    u32x4 f0, f1;
                    f0.x = cvtpk(kwin[0], kwin[1]); f0.y = cvtpk(kwin[2], kwin[3]); f0.z = cvtpk(kwin[8], kwin[9]); f0.w = cvtpk(kwin[10], kwin[11]);
                    f1.x = cvtpk(kwin[4], kwin[5]); f1.y = cvtpk(kwin[6], kwin[7]); f1.z = cvtpk(kwin[12], kwin[13]); f1.w = cvtpk(kwin[14], kwin[15]);
                    *(u32x4*)(rec + R_KT + (((rt * 4 + s) * 2 + 0) * 32 + r) * 16) = f0;
                    *(u32x4*)(rec + R_KT + (((rt * 4 + s) * 2 + 1) * 32 + r) * 16) = f1;
                }
            }
        }
    }
    asm volatile("s_waitcnt lgkmcnt(0)" ::: "memory");
    const int r31 = lane & 31, hi = lane >> 5;
#pragma unroll
    for (int tile = 0; tile < 3; ++tile) { const int jt = (tile == 2) ? 1 : 0, it = (tile == 0) ? 0 : 1;
        f32x16 acc = {};
#pragma unroll
        for (int ks = 0; ks < 4; ++ks) acc = GMFMA(img_frag(k16, 32 * jt, ks, lane), img_frag(q16, 32 * it, ks, lane), acc);
        const int i = 32 * it + r31; const float gci = __shfl(gc_v, i);
        float vals[16];
#pragma unroll
        for (int rr = 0; rr < 16; ++rr) { const int j0 = 32 * jt + crow(rr, 0); const float gcj0 = rdl(gc_v, j0), gcj1 = rdl(gc_v, j0 + 4); const float gcj = hi ? gcj1 : gcj0; const int j = j0 + 4 * hi;
            vals[rr] = (i >= j) ? acc[rr] * __expf(gci - gcj) : 0.f; }
#pragma unroll
        for (int s = 0; s < 2; ++s) { u32x4 f; f.x = cvtpk(vals[8 * s], vals[8 * s + 1]); f.y = cvtpk(vals[8 * s + 2], vals[8 * s + 3]); f.z = cvtpk(vals[8 * s + 4], vals[8 * s + 5]); f.w = cvtpk(vals[8 * s + 6], vals[8 * s + 7]);
            *(u32x4*)(rec + R_INTRA + (((it * 4 + 2 * jt + s) * 2 + hi) * 32 + r31) * 16) = f; }
    }
#pragma unroll
    for (int rt = 0; rt < 2; ++rt)
#pragma unroll
        for (int ks = 0; ks < 4; ++ks) { const int row = 32 * rt + r31;
            const u32x2 lo = *(const GLAS u32x2*)(q16 + row * 128 + ((((2 * ks) ^ (row & 7))) << 4) + 8 * hi), hh = *(const GLAS u32x2*)(q16 + row * 128 + ((((2 * ks + 1) ^ (row & 7))) << 4) + 8 * hi);
            u32x4 f; f.x = lo.x; f.y = lo.y; f.z = hh.x; f.w = hh.y;
            *(u32x4*)(rec + R_Q + (((rt * 4 + ks) * 2 + hi) * 32 + r31) * 16) = f; }
    {   const float gc_lo = __shfl(gc_v, r31), gc_hi2 = __shfl(gc_v, 32 + r31), bt_lo = __shfl(bt_v, r31), bt_hi2 = __shfl(bt_v, 32 + r31);
        asm volatile("s_waitcnt lgkmcnt(0)" ::: "memory");
        {   f32x16 d00 = {}, d01 = {};
#pragma unroll
            for (int ks = 0; ks < 4; ++ks) { const bf16x8 f0 = img_frag(k16, 0, ks, lane), f1 = img_frag(k16, 32, ks, lane); d00 = GMFMA(f0, f0, d00); d01 = GMFMA(f0, f1, d01); }
#pragma unroll
            for (int rr = 0; rr < 16; ++rr) { const int i0 = crow(rr, 0); const float gci0 = rdl(gc_v, i0), gci1 = rdl(gc_v, i0 + 4); const float gci = hi ? gci1 : gci0; const int ia = i0 + 4 * hi;
                AT[ia * 64 + r31] = (r31 > ia) ? bt_lo * d00[rr] * __expf(gc_lo - gci) : 0.f;
                AT[ia * 64 + 32 + r31] = bt_hi2 * d01[rr] * __expf(gc_hi2 - gci); } }
        {   f32x16 d11 = {};
#pragma unroll
            for (int ks = 0; ks < 4; ++ks) { const bf16x8 f1 = img_frag(k16, 32, ks, lane); d11 = GMFMA(f1, f1, d11); }
            asm volatile("s_waitcnt lgkmcnt(0)" ::: "memory");
#pragma unroll
            for (int rr = 0; rr < 16; ++rr) { const int i0 = crow(rr, 0); const float gci0 = rdl(gc_v, 32 + i0), gci1 = rdl(gc_v, 32 + i0 + 4); const float gci = hi ? gci1 : gci0; const int ib = 32 + i0 + 4 * hi;
                AT[ib * 64 + 32 + r31] = (32 + r31 > ib) ? bt_hi2 * d11[rr] * __expf(gc_hi2 - gci) : 0.f; } }
    }
    asm volatile("s_waitcnt lgkmcnt(0)" ::: "memory");
#define GSUBST(X, ATP) _Pragma("unroll") for (int i = 0; i < 63; ++i) { unsigned ao_ = (unsigned)(i * 256); asm volatile("" : "+v"(ao_) : "v"(X[i]));     \
        _Pragma("unroll") for (int q4 = (i + 1) >> 2; q4 < 16; ++q4) { \
        const f32x4 a = *(const GLAS f32x4*)((const GLAS unsigned char*)(ATP) + ao_ + 16 * q4); \
        _Pragma("unroll") for (int e = 0; e < 4; ++e) { const int ip = 4 * q4 + e; if (ip > i) X[ip] = fmaf(-a[e], X[i], X[ip]); } } }
#pragma unroll 1
    for (int pass = 0; pass < 2; ++pass) {
        GSUBST(W, AT)
        if (pass == 0) {
#pragma unroll
            for (int i = 0; i < 64; ++i) { float* ub = uni_ptr(ug + (i >> 4) * 1024); ub[(i & 15) * 64 + lane] = W[i]; }
            asm volatile("s_waitcnt vmcnt(0)" ::: "memory");
#pragma unroll
            for (int i = 0; i < 64; ++i) { const float* tb = uni_ptr(tg + (i >> 4) * 1024); W[i] = tb[(i & 15) * 64 + lane]; }
        }
    }
#undef GSUBST
    {   asm volatile("s_waitcnt lgkmcnt(0)" ::: "memory");
#pragma unroll
        for (int i = 0; i < 64; ++i) *(GLAS unsigned short*)(lw + frag_off(i, lane)) = cvt1(-W[i]);
        asm volatile("s_waitcnt lgkmcnt(0)" ::: "memory");
#pragma unroll
        for (int x = 0; x < 8; ++x) *(u32x4*)(rec + R_NEGW + x * 1024 + lane * 16) = *(const GLAS u32x4*)(lw + x * 1024 + lane * 16);
        asm volatile("s_waitcnt lgkmcnt(0)" ::: "memory");
    }
}

GDI void scan_wg(int bh, const unsigned char* __restrict__ rec_base, float* __restrict__ GO, float* __restrict__ sg_out, GLAS unsigned char* lds, int tid_in) {
    int tid = tid_in; asm volatile("" : "+v"(tid));
    const int wave = __builtin_amdgcn_readfirstlane(tid >> 6), lane = tid & 63, r31 = lane & 31, hi = lane >> 5;
    const int b = bh >> 3, h = bh & 7;
    const unsigned char* rec0 = rec_base + (size_t)bh * NCH * R_STRIDE;
    __syncthreads();
    for (int x = tid; x < R_BYTES / 16; x += 512) *(GLAS u32x4*)(lds + x * 16) = *(const u32x4*)(rec0 + (size_t)x * 16);
    __syncthreads();
    f32x16 S0 = {}, S1 = {};
    for (int c = 0; c < NCH; ++c) {
        GLAS unsigned char* buf = lds + (c & 1) * R_BYTES;
        if (wave >= 2) {
            if (c + 1 < NCH) { const unsigned char* src = rec0 + (size_t)(c + 1) * R_STRIDE; GLAS unsigned char* dst = lds + ((c + 1) & 1) * R_BYTES;
                for (int x = tid - 128; x < R_BYTES / 16; x += 384) *(GLAS u32x4*)(dst + x * 16) = *(const u32x4*)(src + (size_t)x * 16); }
        } else {
            const int dv = 32 * wave + r31;
            const GLAS float* sc = (const GLAS float*)(buf + R_SC);
            const float gl = sc[128];
#define GFRAG(base, rt, ks) (*(const GLAS bf16x8*)(buf + (base) + ((((rt) * 4 + (ks)) * 2 + hi) * 32 + r31) * 16))
            bf16x8 sb[4];
#pragma unroll
            for (int s = 0; s < 2; ++s) { u32x4 f; f.x = cvtpk(S0[8 * s], S0[8 * s + 1]); f.y = cvtpk(S0[8 * s + 2], S0[8 * s + 3]); f.z = cvtpk(S0[8 * s + 4], S0[8 * s + 5]); f.w = cvtpk(S0[8 * s + 6], S0[8 * s + 7]); sb[s] = __builtin_bit_cast(bf16x8, f);
                u32x4 g; g.x = cvtpk(S1[8 * s], S1[8 * s + 1]); g.y = cvtpk(S1[8 * s + 2], S1[8 * s + 3]); g.z = cvtpk(S1[8 * s + 4], S1[8 * s + 5]); g.w = cvtpk(S1[8 * s + 6], S1[8 * s + 7]); sb[2 + s] = __builtin_bit_cast(bf16x8, g); }
            f32x16 vn[2], x2[2];
            const GLAS float* ul = (const GLAS float*)(buf + R_U);
#pragma unroll
            for (int ct = 0; ct < 2; ++ct) {
#pragma unroll
                for (int rr = 0; rr < 16; ++rr) vn[ct][rr] = ul[(32 * ct + crow(rr, 0) + 4 * hi) * 64 + dv];
                x2[ct] = f32x16{};
#pragma unroll
                for (int ks = 0; ks < 4; ++ks) { vn[ct] = GMFMA(GFRAG(R_NEGW, ct, ks), sb[ks], vn[ct]); x2[ct] = GMFMA(GFRAG(R_Q, ct, ks), sb[ks], x2[ct]); }
            }
            bf16x8 vb[4], vs[4];
#pragma unroll
            for (int ct = 0; ct < 2; ++ct) {
                float sv[16];
#pragma unroll
                for (int rr = 0; rr < 16; ++rr) { const int row = 32 * ct + crow(rr, 0) + 4 * hi; sv[rr] = vn[ct][rr] * sc[64 + row]; x2[ct][rr] *= sc[row]; }
#pragma unroll
                for (int s = 0; s < 2; ++s) { u32x4 f; f.x = cvtpk(vn[ct][8 * s], vn[ct][8 * s + 1]); f.y = cvtpk(vn[ct][8 * s + 2], vn[ct][8 * s + 3]); f.z = cvtpk(vn[ct][8 * s + 4], vn[ct][8 * s + 5]); f.w = cvtpk(vn[ct][8 * s + 6], vn[ct][8 * s + 7]); vb[2 * ct + s] = __builtin_bit_cast(bf16x8, f);
                    u32x4 g; g.x = cvtpk(sv[8 * s], sv[8 * s + 1]); g.y = cvtpk(sv[8 * s + 2], sv[8 * s + 3]); g.z = cvtpk(sv[8 * s + 4], sv[8 * s + 5]); g.w = cvtpk(sv[8 * s + 6], sv[8 * s + 7]); vs[2 * ct + s] = __builtin_bit_cast(bf16x8, g); }
            }
            x2[0] = GMFMA(GFRAG(R_INTRA, 0, 0), vb[0], x2[0]); x2[0] = GMFMA(GFRAG(R_INTRA, 0, 1), vb[1], x2[0]);
#pragma unroll
            for (int ks = 0; ks < 4; ++ks) x2[1] = GMFMA(GFRAG(R_INTRA, 1, ks), vb[ks], x2[1]);
#pragma unroll
            for (int rr = 0; rr < 16; ++rr) { S0[rr] *= gl; S1[rr] *= gl; }
#pragma unroll
            for (int ks = 0; ks < 4; ++ks) { S0 = GMFMA(GFRAG(R_KT, 0, ks), vs[ks], S0); S1 = GMFMA(GFRAG(R_KT, 1, ks), vs[ks], S1); }
#undef GFRAG
            float* go = GO + (size_t)(b * SEQ_ + c * CH) * 512 + h * 64 + dv;
#pragma unroll
            for (int ct = 0; ct < 2; ++ct)
#pragma unroll
                for (int rr = 0; rr < 16; ++rr) go[(size_t)(32 * ct + crow(rr, 0) + 4 * hi) * 512] = x2[ct][rr];
        }
        __syncthreads();
    }
    if (wave < 2) { float* so = sg_out + (size_t)bh * 4096 + 32 * wave + r31;
#pragma unroll
        for (int rr = 0; rr < 16; ++rr) { so[(crow(rr, 0) + 4 * hi) * 64] = S0[rr]; so[(32 + crow(rr, 0) + 4 * hi) * 64] = S1[rr]; } }
}
#undef GMFMA
#undef GDI
}

constexpr int NWAVES = 8;
constexpr int DM = 1024, NB = 8, SEQ = 2048, DB = 128, DS = 4;
constexpr int MP = NB * SEQ, MS = DB * DS, M = MP + MS;
constexpr int FF = 2816, NGU = 2 * FF, NIN = 3600, NINP = 3840;
constexpr int NH = 8, HD = 64, AW = 512, GW = 512;
constexpr int C_AQ = 0, C_AK = 512, C_AV = 1024, C_GQKV = 1536, C_Z = 3072, C_B = 3584, C_A = 3592;
constexpr float LN_EPS = 1e-5f, RMS_EPS = 1e-6f, ALPHA = 1.189207115002721f;
constexpr size_t O_YP = 0, O_YS = 16777216, O_KP = 17301504, O_VP = 25690112, O_SGP = 34078720, O_SCP = 34340864, O_KS = 34377728, O_VS = 34639872, O_SGS = 34902016, O_SCS = 39096320, O_END = 39686144;
constexpr size_t MiB = 1u << 20;
constexpr size_t WS_CTL = 0, CTL_ZERO_BYTES = 1 * MiB, WS_WGU1 = 1 * MiB, WS_WD1 = 13 * MiB, WS_WIN = 19 * MiB, WS_WOUT = 27 * MiB, WS_WGU2 = 29 * MiB, WS_WD2 = 41 * MiB;
constexpr size_t WS_XB = 48 * MiB, WS_H = 82 * MiB, WS_T = 174 * MiB, WS_X1 = 240 * MiB, WS_X1B = 306 * MiB, WS_P = 340 * MiB, WS_HEADS = 588 * MiB;
constexpr size_t WS_GQ = 622 * MiB, WS_GK = 655 * MiB, WS_GV = 688 * MiB, WS_GG = 721 * MiB, WS_GB = 722 * MiB, WS_GO = 723 * MiB, WS_X2 = 756 * MiB, WS_X2B = 822 * MiB, WS_QB = 856 * MiB, WS_KB = 872 * MiB, WS_VB = 888 * MiB, WS_REC = 904 * MiB, WS_END = 1036 * MiB;
constexpr int CW_BAR = 4096;
constexpr int RING_OFF = 0, RING_BYTES = 131072, LDSCTL_OFF = RING_BYTES, MISC_OFF = LDSCTL_OFF + 320, LDS_BYTES = 147456;

struct Args { const float* in[25]; float* out; unsigned char* ws; };

__device__ __forceinline__ float wave_sum(float v) {
#pragma unroll
    for (int o = 1; o < 64; o <<= 1) v += __shfl_xor(v, o);
    return v;
}
__device__ __forceinline__ float wave_max(float v) {
#pragma unroll
    for (int o = 1; o < 64; o <<= 1) v = fmaxf(v, __shfl_xor(v, o));
    return v;
}
__device__ __forceinline__ int t5_bucket(int n) {
    if (n < 16) return n;
    int b = 16;
    b += (n >= 22); b += (n >= 30); b += (n >= 40); b += (n >= 54); b += (n >= 73); b += (n >= 99); b += (n >= 134); b += (n >= 182);
    b += (n >= 246); b += (n >= 332); b += (n >= 450); b += (n >= 609); b += (n >= 825); b += (n >= 1117); b += (n >= 1513);
    return b;
}
__device__ __forceinline__ unsigned long long pk4(f32x4 v) { return (unsigned long long)pk2(v.x, v.y) | ((unsigned long long)pk2(v.z, v.w) << 32); }

__device__ __forceinline__ void p0_transpose_item(const float* W0, const float* W1, int K, int Nsrc, int Nd, int mode, bf16* WT, LAS float* scr, int item, int lane) {
    const int nblk = Nd / 32, kb = item / nblk, nb = item % nblk, k0 = 64 * kb, n0 = 32 * nb;
    const float* src = W0; int c0 = n0;
    if (mode == 1) { const int t = n0 / 256, w = n0 % 256; src = (w < 128) ? W0 : W1; c0 = t * 128 + (w & 127); }
    const bool okc = (c0 + (lane & 31)) < Nsrc;
#pragma unroll 8
    for (int i = 0; i < 32; ++i) { const int kk = 2 * i + (lane >> 5); scr[kk * 33 + (lane & 31)] = okc ? src[(size_t)(k0 + kk) * Nsrc + c0 + (lane & 31)] : 0.f; }
    LDS_WAIT(); asm volatile("" ::: "memory");
    const int c = lane & 7;
#pragma unroll
    for (int j = 0; j < 4; ++j) { const int n = (lane >> 3) + 8 * j; const LAS float* s = scr + (8 * c) * 33 + n;
        v4u o; o.x = pk2(s[0 * 33], s[1 * 33]); o.y = pk2(s[2 * 33], s[3 * 33]); o.z = pk2(s[4 * 33], s[5 * 33]); o.w = pk2(s[6 * 33], s[7 * 33]);
        *(GAS v4u*)(WT + (size_t)(n0 + n) * K + k0 + 8 * c) = o; }
    LDS_WAIT(); asm volatile("" ::: "memory");
}
__device__ __forceinline__ void p_transpose(const float* W0, const float* W1, int K, int Nsrc, int Nd, int mode, bf16* WT, LAS float* scr, int gw, int NGW, int lane) {
    const int nitems = (K / 64) * (Nd / 32);
    for (int it = gw; it < nitems; it += NGW) p0_transpose_item(W0, W1, K, Nsrc, Nd, mode, WT, scr, it, lane);
}
__device__ __forceinline__ void p_cvt_x(const float* xp, const float* xs, bf16* xb, int gw, int NGW, int lane) {
    for (int m = gw; m < M; m += NGW) { const float* s = (m < MP) ? xp + (size_t)m * DM : xs + (size_t)(m - MP) * DM;
#pragma unroll
        for (int j = 0; j < 4; ++j) { const f32x4 v = *(const f32x4*)(s + j * 256 + lane * 4); *(unsigned long long*)(xb + (size_t)m * DM + j * 256 + lane * 4) = pk4(v); } }
}
__device__ __forceinline__ void p_ln(const float* r0, const float* r1, const float* t, float s, const float* g, const float* b, float* o0, float* o1, bf16* ob, int gw, int NGW, int lane) {
    for (int m = gw; m < M; m += NGW) {
        const float* rr = (m < MP) ? r0 + (size_t)m * DM : r1 + (size_t)(m - MP) * DM;
        const float* tt = t + (size_t)m * DM;
        f32x4 v[4]; float sum = 0.f;
#pragma unroll
        for (int j = 0; j < 4; ++j) { const f32x4 a = *(const f32x4*)(rr + j * 256 + lane * 4), c = *(const f32x4*)(tt + j * 256 + lane * 4); v[j] = a * ALPHA + c * s; sum += (v[j].x + v[j].y) + (v[j].z + v[j].w); }
        const float mean = wave_sum(sum) * (1.f / DM); float s2 = 0.f;
#pragma unroll
        for (int j = 0; j < 4; ++j) { v[j] = v[j] - mean; s2 += (v[j].x * v[j].x + v[j].y * v[j].y) + (v[j].z * v[j].z + v[j].w * v[j].w); }
        const float rstd = 1.0f / sqrtf(wave_sum(s2) * (1.f / DM) + LN_EPS);
        float* oo = (m < MP) ? o0 + (size_t)m * DM : o1 + (size_t)(m - MP) * DM;
#pragma unroll
        for (int j = 0; j < 4; ++j) { const f32x4 gg = *(const f32x4*)(g + j * 256 + lane * 4), bb = *(const f32x4*)(b + j * 256 + lane * 4); const f32x4 y = v[j] * rstd * gg + bb;
            *(f32x4*)(oo + j * 256 + lane * 4) = y;
            if (ob) *(unsigned long long*)(ob + (size_t)m * DM + j * 256 + lane * 4) = pk4(y); }
    }
}
__device__ __forceinline__ void p_copy_out(const float* P, float* out, bf16* Qb, bf16* Kb, bf16* Vb, int gw, int NGW, int lane) {
    for (int m = gw; m < M; m += NGW) {
        const float* pr = P + (size_t)m * NINP;
        if (m < MP) {
#pragma unroll
            for (int j = 0; j < 2; ++j) { const int c = j * 256 + lane * 4; *(unsigned long long*)(Qb + (size_t)m * AW + c) = pk4(*(const f32x4*)(pr + C_AQ + c) * attn_body::C2);
                *(unsigned long long*)(Kb + (size_t)m * AW + c) = pk4(*(const f32x4*)(pr + C_AK + c)); *(unsigned long long*)(Vb + (size_t)m * AW + c) = pk4(*(const f32x4*)(pr + C_AV + c)); } }
        float* kd; float* vd;
        if (m < MP) { kd = out + O_KP + (size_t)m * AW; vd = out + O_VP + (size_t)m * AW; } else { kd = out + O_KS + (size_t)(m - MP) * AW; vd = out + O_VS + (size_t)(m - MP) * AW; }
#pragma unroll
        for (int j = 0; j < 2; ++j) { *(f32x4*)(kd + j * 256 + lane * 4) = *(const f32x4*)(pr + C_AK + j * 256 + lane * 4); *(f32x4*)(vd + j * 256 + lane * 4) = *(const f32x4*)(pr + C_AV + j * 256 + lane * 4); }
        float* sd = nullptr;
        if (m < MP) { const int b = m / SEQ, t = m % SEQ; if (t >= SEQ - 3) sd = out + O_SCP + ((size_t)b * 3 + (t - (SEQ - 3))) * 1536; }
        else { const int b = (m - MP) / DS, t = (m - MP) % DS; if (t >= 1) sd = out + O_SCS + ((size_t)b * 3 + (t - 1)) * 1536; }
        if (sd) {
#pragma unroll
            for (int j = 0; j < 6; ++j) *(f32x4*)(sd + j * 256 + lane * 4) = *(const f32x4*)(pr + C_GQKV + j * 256 + lane * 4); }
    }
}
__device__ __forceinline__ void p_attn_simple(const float* P, const float* ck, const float* cv, const float* relb, bf16* heads, LAS float* lds, int m0, int vcu, int G, int h, int lane) {
    LAS float* sq = lds + h * 64; LAS float* sp = lds + 8 * 64 + h * 392;
    for (int m = m0 + vcu; m < M; m += G) {
        const bool samp = m >= MP; int b, p;
        if (!samp) { b = m / SEQ; p = m % SEQ; } else { b = (m - MP) / DS; p = SEQ + (m - MP) % DS; }
        sq[lane] = P[(size_t)m * NINP + C_AQ + h * 64 + lane] * 0.125f;
        LDS_WAIT(); asm volatile("" ::: "memory");
        float lg[7]; float mx = -INFINITY;
#pragma unroll
        for (int i = 0; i < 7; ++i) {
            const int e = i * 64 + lane; float v = -INFINITY;
            if (e < 387) { const int g = e / 129, j = e % 129, dil = (g == 0) ? 1 : (g == 1 ? 4 : 16), delta = j * dil, pos = p - delta;
                if (pos >= 0) {
                    const float* kp;
                    if (!samp) kp = P + (size_t)(b * SEQ + pos) * NINP + C_AK + h * 64;
                    else if (pos >= SEQ) kp = P + (size_t)(MP + b * DS + (pos - SEQ)) * NINP + C_AK + h * 64;
                    else kp = ck + (((size_t)b * SEQ + pos) * NH + h) * HD;
                    float acc = 0.f;
#pragma unroll
                    for (int d = 0; d < 64; d += 4) { const f32x4 kv = *(const f32x4*)(kp + d); acc += kv.x * sq[d] + kv.y * sq[d + 1] + kv.z * sq[d + 2] + kv.w * sq[d + 3]; }
                    v = acc + relb[t5_bucket(delta) * NH + h]; } }
            lg[i] = v; mx = fmaxf(mx, v); }
        mx = wave_max(mx);
        float sum = 0.f;
#pragma unroll
        for (int i = 0; i < 7; ++i) { const int e = i * 64 + lane; const float pe = (lg[i] == -INFINITY) ? 0.f : __expf(lg[i] - mx); if (e < 387) sp[e] = pe; sum += pe; }
        sum = wave_sum(sum);
        LDS_WAIT(); asm volatile("" ::: "memory");
        float o = 0.f;
        for (int e = 0; e < 387; ++e) { const float pe = sp[e]; if (pe == 0.f) continue;
            const int g = e / 129, j = e % 129, dil = (g == 0) ? 1 : (g == 1 ? 4 : 16), pos = p - j * dil;
            const float* vp;
            if (!samp) vp = P + (size_t)(b * SEQ + pos) * NINP + C_AV + h * 64;
            else if (pos >= SEQ) vp = P + (size_t)(MP + b * DS + (pos - SEQ)) * NINP + C_AV + h * 64;
            else vp = cv + (((size_t)b * SEQ + pos) * NH + h) * HD;
            o += pe * vp[lane]; }
        heads[(size_t)m * DM + h * 64 + lane] = (bf16)f2bf(o / sum);
        LDS_WAIT(); asm volatile("" ::: "memory");
    }
}
#define SDPP(x, ctrl) __builtin_bit_cast(float, __builtin_amdgcn_update_dpp(0, __builtin_bit_cast(int, (x)), (ctrl), 0xF, 0xF, false))
__device__ __forceinline__ void p_attn_sample(const float* P, const float* ck, const float* cv, const float* relb, bf16* heads, LAS float* lgs  , int gw, int NGW, int lane_in) {
    int lane = lane_in; asm volatile("" : "+v"(lane));
    const int g = lane >> 3, c = lane & 7;
    for (int task = gw; task < MS * NH; task += NGW) {
        const int sr = task >> 3, h = task & 7, b = sr >> 2, t = sr & 3, m = MP + sr, p = SEQ + t;
        f32x4 q0 = *(const f32x4*)(P + (size_t)m * NINP + C_AQ + h * 64 + 8 * c), q1 = *(const f32x4*)(P + (size_t)m * NINP + C_AQ + h * 64 + 8 * c + 4);
        q0 = q0 * 0.125f; q1 = q1 * 0.125f;
        const float* knew = P + (size_t)(MP + b * DS) * NINP + C_AK + h * 64 + 8 * c; const float* kold = ck + ((size_t)b * SEQ * NH + h) * HD + 8 * c;
        float mx = -INFINITY;
#pragma unroll 7
        for (int it = 0; it < 49; ++it) {
            const int e = it * 8 + g; const int ee = e < 387 ? e : 386;
            const int pat = (ee >= 258) ? 2 : (ee >= 129 ? 1 : 0), j = ee - pat * 129, delta = j << (2 * pat), pos = p - delta;
            const float* kp = (pos >= SEQ) ? knew + (size_t)(pos - SEQ) * NINP : kold + (size_t)pos * (NH * HD);
            const f32x4 k0 = *(const f32x4*)kp, k1 = *(const f32x4*)(kp + 4);
            float d = (k0.x * q0.x + k0.y * q0.y) + (k0.z * q0.z + k0.w * q0.w) + (k1.x * q1.x + k1.y * q1.y) + (k1.z * q1.z + k1.w * q1.w);
            d += SDPP(d, 0xB1); d += SDPP(d, 0x4E); d += SDPP(d, 0x141);
            const float v = (e < 387) ? d + relb[t5_bucket(delta) * NH + h] : -INFINITY;
            if (c == 0) lgs[it * 8 + g] = v;
            mx = fmaxf(mx, v); }
        mx = fmaxf(mx, __shfl_xor(mx, 8)); mx = fmaxf(mx, __shfl_xor(mx, 16)); mx = fmaxf(mx, __shfl_xor(mx, 32));
        LDS_WAIT(); asm volatile("" ::: "memory");
        const float* vnew = knew + (C_AV - C_AK); const float* vold = cv + ((size_t)b * SEQ * NH + h) * HD + 8 * c;
        float sum = 0.f; float acc[8];
#pragma unroll
        for (int j = 0; j < 8; ++j) acc[j] = 0.f;
#pragma unroll 7
        for (int it = 0; it < 49; ++it) {
            const int e = it * 8 + g; const int ee = e < 387 ? e : 386;
            const int pat = (ee >= 258) ? 2 : (ee >= 129 ? 1 : 0), j = ee - pat * 129, delta = j << (2 * pat), pos = p - delta;
            const float* vp = (pos >= SEQ) ? vnew + (size_t)(pos - SEQ) * NINP : vold + (size_t)pos * (NH * HD);
            const f32x4 v0 = *(const f32x4*)vp, v1 = *(const f32x4*)(vp + 4);
            const float pe = __expf(lgs[it * 8 + g] - mx); sum += pe;
            acc[0] += pe * v0.x; acc[1] += pe * v0.y; acc[2] += pe * v0.z; acc[3] += pe * v0.w; acc[4] += pe * v1.x; acc[5] += pe * v1.y; acc[6] += pe * v1.z; acc[7] += pe * v1.w; }
        sum += __shfl_xor(sum, 8); sum += __shfl_xor(sum, 16); sum += __shfl_xor(sum, 32);
#pragma unroll
        for (int j = 0; j < 8; ++j) { acc[j] += __shfl_xor(acc[j], 8); acc[j] += __shfl_xor(acc[j], 16); acc[j] += __shfl_xor(acc[j], 32); }
        if (g == 0) { const float inv = 1.0f / sum; v4u o; o.x = pk2(acc[0] * inv, acc[1] * inv); o.y = pk2(acc[2] * inv, acc[3] * inv); o.z = pk2(acc[4] * inv, acc[5] * inv); o.w = pk2(acc[6] * inv, acc[7] * inv);
            *(v4u*)(heads + (size_t)m * DM + h * 64 + 8 * c) = o; }
        LDS_WAIT(); asm volatile("" ::: "memory");
    }
}
__device__ __forceinline__ void p_gdn_prep(const float* P, const float* sconv, const float* convw, const float* alog, const float* dtb, float* GQ, float* GK, float* GV, float* GG, float* GB, int m0, int vcu, int G, int h, int lane) {
    for (int m = m0 + vcu; m < M; m += G) {
        const bool samp = m >= MP; int b, t;
        if (!samp) { b = m / SEQ; t = m % SEQ; } else { b = (m - MP) / DS; t = (m - MP) % DS; }
        float r[3];
#pragma unroll
        for (int part = 0; part < 3; ++part) {
            const int c = part * 512 + h * 64 + lane; float acc = 0.f;
#pragma unroll
            for (int j = 0; j < 4; ++j) { const int tt = t - 3 + j; float x;
                if (tt >= 0) x = P[(size_t)(m - t + tt) * NINP + C_GQKV + c]; else x = samp ? sconv[((size_t)b * 3 + (tt + 3)) * 1536 + c] : 0.f;
                acc += x * convw[j * 1536 + c]; }
            r[part] = acc / (1.0f + __expf(-acc)); }
        const float qn = wave_sum(r[0] * r[0]), kn = wave_sum(r[1] * r[1]);
        GQ[(size_t)m * GW + h * 64 + lane] = r[0] * (1.0f / sqrtf(qn + RMS_EPS)) * 0.125f;
        GK[(size_t)m * GW + h * 64 + lane] = r[1] * (1.0f / sqrtf(kn + RMS_EPS));
        GV[(size_t)m * GW + h * 64 + lane] = r[2];
        if (lane == 0) { const float bb = P[(size_t)m * NINP + C_B + h], aa = P[(size_t)m * NINP + C_A + h] + dtb[h];
            GB[(size_t)m * NH + h] = 1.0f / (1.0f + __expf(-bb));
            const float sp = (aa > 20.f) ? aa : log1pf(__expf(aa));
            GG[(size_t)m * NH + h] = -__expf(alog[h]) * sp; }
    }
}
__device__ __forceinline__ void gdn_scan_task(int task, const float* GQ, const float* GK, const float* GV, const float* GG, const float* GB, const float* s0, const float* P, const float* nw, bf16* heads, float* out, int lane) {
    const int seq = task / NH, h = task % NH;
    float S[64]; int row0, L; float* sdst;
    if (seq < NB) { row0 = seq * SEQ; L = SEQ; sdst = out + O_SGP + ((size_t)seq * NH + h) * 4096;
#pragma unroll
        for (int d = 0; d < 64; ++d) S[d] = 0.f; }
    else { const int b = seq - NB; row0 = MP + b * DS; L = DS; sdst = out + O_SGS + ((size_t)b * NH + h) * 4096; const float* sp = s0 + ((size_t)b * NH + h) * 4096;
#pragma unroll
        for (int d = 0; d < 64; ++d) S[d] = sp[d * 64 + lane]; }
    const float nwl = nw[lane];
    size_t o = (size_t)row0 * GW + h * 64 + lane;
    float qn = GQ[o], kn = GK[o], vn = GV[o], gn = GG[(size_t)row0 * NH + h], bn = GB[(size_t)row0 * NH + h], zn = P[(size_t)row0 * NINP + C_Z + h * 64 + lane];
    for (int t = 0; t < L; ++t) {
        const float qv = qn, kv = kn, vv = vn, eg = __expf(gn), beta = bn, z = zn; const int m = row0 + t;
        if (t + 1 < L) { o += GW; qn = GQ[o]; kn = GK[o]; vn = GV[o]; gn = GG[(size_t)(m + 1) * NH + h]; bn = GB[(size_t)(m + 1) * NH + h]; zn = P[(size_t)(m + 1) * NINP + C_Z + h * 64 + lane]; }
        float k0 = 0.f, k1 = 0.f, k2 = 0.f, k3 = 0.f;
#pragma unroll
        for (int d = 0; d < 64; d += 4) {
            k0 += __builtin_bit_cast(float, __builtin_amdgcn_readlane(__builtin_bit_cast(int, kv), d)) * S[d];
            k1 += __builtin_bit_cast(float, __builtin_amdgcn_readlane(__builtin_bit_cast(int, kv), d + 1)) * S[d + 1];
            k2 += __builtin_bit_cast(float, __builtin_amdgcn_readlane(__builtin_bit_cast(int, kv), d + 2)) * S[d + 2];
            k3 += __builtin_bit_cast(float, __builtin_amdgcn_readlane(__builtin_bit_cast(int, kv), d + 3)) * S[d + 3]; }
        const float ks = (k0 + k1) + (k2 + k3);
        const float c = beta * (vv - eg * ks);
        float o0 = 0.f, o1 = 0.f, o2 = 0.f, o3 = 0.f;
#pragma unroll
        for (int d = 0; d < 64; d += 4) {
#pragma unroll
            for (int e = 0; e < 4; ++e) { const float kd = __builtin_bit_cast(float, __builtin_amdgcn_readlane(__builtin_bit_cast(int, kv), d + e)); S[d + e] = fmaf(kd, c, eg * S[d + e]); }
            o0 += __builtin_bit_cast(float, __builtin_amdgcn_readlane(__builtin_bit_cast(int, qv), d)) * S[d];
            o1 += __builtin_bit_cast(float, __builtin_amdgcn_readlane(__builtin_bit_cast(int, qv), d + 1)) * S[d + 1];
            o2 += __builtin_bit_cast(float, __builtin_amdgcn_readlane(__builtin_bit_cast(int, qv), d + 2)) * S[d + 2];
            o3 += __builtin_bit_cast(float, __builtin_amdgcn_readlane(__builtin_bit_cast(int, qv), d + 3)) * S[d + 3]; }
        const float ov = (o0 + o1) + (o2 + o3);
        const float ms = wave_sum(ov * ov) * (1.f / 64.f);
        const float y = ov * (1.0f / sqrtf(ms + RMS_EPS)) * nwl * (z / (1.0f + __expf(-z)));
        heads[(size_t)m * DM + AW + h * 64 + lane] = (bf16)f2bf(y);
    }
#pragma unroll
    for (int d = 0; d < 64; ++d) sdst[d * 64 + lane] = S[d];
}

__device__ __forceinline__ void p_gdn_out(const float* GO, const float* P, const float* nw, bf16* heads, int gw, int NGW, int lane) {
    const float nwl = nw[lane];
    for (int m = gw; m < MP; m += NGW) {
#pragma unroll
        for (int h = 0; h < NH; ++h) { const float o = GO[(size_t)m * GW + h * 64 + lane]; const float ms = wave_sum(o * o) * (1.f / 64.f); const float z = P[(size_t)m * NINP + C_Z + h * 64 + lane];
            heads[(size_t)m * DM + AW + h * 64 + lane] = (bf16)f2bf(o * (1.0f / sqrtf(ms + RMS_EPS)) * nwl * (z / (1.0f + __expf(-z)))); }
    }
}
__global__ void __launch_bounds__(NWAVES * 64, 2) mega_fwd(Args args) {
    extern __shared__ __attribute__((aligned(16))) unsigned char lds[];
    LAS unsigned char* L = (LAS unsigned char*)lds;
    volatile LAS unsigned* MISC = (volatile LAS unsigned*)(L + MISC_OFF);
    const int tid = threadIdx.x, lane = tid & 63, wave = __builtin_amdgcn_readfirstlane(tid >> 6);
    const int G = gridDim.x; const int bx = blockIdx.x; const int vcu = (G % 8 == 0) ? (bx % 8) * (G / 8) + bx / 8 : bx;
    unsigned char* ws = args.ws; float* out = args.out;
    gu32* ctl = (gu32*)(ws + WS_CTL);
    for (int u = tid; u < (LDS_BYTES - LDSCTL_OFF) / 4; u += NWAVES * 64) ((LAS unsigned*)(L + LDSCTL_OFF))[u] = 0u;
    __syncthreads();
    XcdBarrier bar = xcd_barrier_post((unsigned*)(ctl + CW_BAR), MISC + 8);
#define GRID_BAR() xcd_barrier(bar)
    const float* const* in = args.in;
    bf16 *Wgu1 = (bf16*)(ws + WS_WGU1), *Wd1 = (bf16*)(ws + WS_WD1), *Win = (bf16*)(ws + WS_WIN), *Wout = (bf16*)(ws + WS_WOUT), *Wgu2 = (bf16*)(ws + WS_WGU2), *Wd2 = (bf16*)(ws + WS_WD2);
    bf16 *XB = (bf16*)(ws + WS_XB), *H = (bf16*)(ws + WS_H), *X1B = (bf16*)(ws + WS_X1B), *HEADS = (bf16*)(ws + WS_HEADS), *X2B = (bf16*)(ws + WS_X2B);
    float *T = (float*)(ws + WS_T), *X1 = (float*)(ws + WS_X1), *P = (float*)(ws + WS_P), *GQ = (float*)(ws + WS_GQ), *GK = (float*)(ws + WS_GK), *GV = (float*)(ws + WS_GV), *GG = (float*)(ws + WS_GG), *GB = (float*)(ws + WS_GB), *X2 = (float*)(ws + WS_X2);
    const int gw = vcu * NWAVES + wave, NGW = G * NWAVES;

    {   LAS float* scr = (LAS float*)(L + RING_OFF + wave * 16384);
        p_transpose(in[9], in[10], DM, FF, NGU, 1, Wgu1, scr, gw, NGW, lane);
        p_transpose(in[11], nullptr, FF, DM, DM, 0, Wd1, scr, gw, NGW, lane);
        p_transpose(in[12], nullptr, DM, NIN, NINP, 0, Win, scr, gw, NGW, lane);
        p_transpose(in[13], nullptr, DM, DM, DM, 0, Wout, scr, gw, NGW, lane);
        p_transpose(in[20], in[21], DM, FF, NGU, 1, Wgu2, scr, gw, NGW, lane);
        p_transpose(in[22], nullptr, FF, DM, DM, 0, Wd2, scr, gw, NGW, lane);
        p_cvt_x(in[0], in[1], XB, gw, NGW, lane);
        GRID_BAR(); }
    {   pg8::Gemm g{XB, Wgu1, M, NGU, DM, 0}; pg8::StaticOrder S; S.init(M, NGU, G, bx); pg8::EpiSwiGLU E{H, FF, 0};
        pg8::gemm_phase<pg8::EpiSwiGLU, pg8::StaticOrder, true, true>(L + RING_OFF, g, S, E); GRID_BAR(); }
    {   pg8::Gemm g{H, Wd1, M, DM, FF, 0}; pg8::StaticOrder S; S.init(M, DM, G, bx); pg8::EpiF32 E{T, DM, 0};
        pg8::gemm_phase<pg8::EpiF32, pg8::StaticOrder, true, true>(L + RING_OFF, g, S, E); GRID_BAR(); }
    p_ln(in[0], in[1], T, 0.5f, in[7], in[8], X1, X1 + (size_t)MP * DM, X1B, gw, NGW, lane); GRID_BAR();
    {   pg8::Gemm g{X1B, Win, M, NINP, DM, 0}; pg8::StaticOrder S; S.init(M, NINP, G, bx); pg8::EpiF32 E{P, NINP, 0};
        pg8::gemm_phase<pg8::EpiF32, pg8::StaticOrder, true, true>(L + RING_OFF, g, S, E); GRID_BAR(); }
    bf16 *Qb = (bf16*)(ws + WS_QB), *Kb = (bf16*)(ws + WS_KB), *Vb = (bf16*)(ws + WS_VB);
    p_copy_out(P, out, Qb, Kb, Vb, gw, NGW, lane);
    p_gdn_prep(P, in[5], in[14], in[15], in[16], GQ, GK, GV, GG, GB, MP, vcu, G, wave, lane);
    unsigned char* REC = ws + WS_REC; float* GO = (float*)(ws + WS_GO);
    for (int unit = gw; unit < NB * NH * 32; unit += NGW) gdn::pre_unit(unit, P, in[14], in[15], in[16], REC, L + RING_OFF + wave * 16384, lane);
    GRID_BAR();
    {   const attn_body::AttnTensors AT{(const attn_body::bf16*)Qb, (const attn_body::bf16*)Kb, (const attn_body::bf16*)Vb, (attn_body::bf16*)HEADS};
        const attn_body::StaticOrder S(G, bx);
        attn_body::attn_phase<attn_body::StaticOrder>((char*)lds + RING_OFF, AT, in[6], S); }
    p_attn_sample(P, in[2], in[3], in[6], HEADS, (LAS float*)(L + RING_OFF) + wave * 392, gw, NGW, lane);
    for (int task = NB * NH + wave * G + bx; task < (NB + DB) * NH; task += NGW) gdn_scan_task(task, GQ, GK, GV, GG, GB, in[4], P, in[17], HEADS, out, lane);
    if (vcu < NB * NH) gdn::scan_wg(vcu, REC, GO, out + O_SGP, L + RING_OFF, tid);
    GRID_BAR();
    p_gdn_out(GO, P, in[17], HEADS, gw, NGW, lane);
    GRID_BAR();
    {   pg8::Gemm g{HEADS, Wout, M, DM, DM, 0}; pg8::StaticOrder S; S.init(M, DM, G, bx); pg8::EpiF32 E{T, DM, 0};
        pg8::gemm_phase<pg8::EpiF32, pg8::StaticOrder, true, true>(L + RING_OFF, g, S, E); GRID_BAR(); }
    p_ln(X1, X1 + (size_t)MP * DM, T, 1.0f, in[18], in[19], X2, X2 + (size_t)MP * DM, X2B, gw, NGW, lane); GRID_BAR();
    {   pg8::Gemm g{X2B, Wgu2, M, NGU, DM, 0}; pg8::StaticOrder S; S.init(M, NGU, G, bx); pg8::EpiSwiGLU E{H, FF, 0};
        pg8::gemm_phase<pg8::EpiSwiGLU, pg8::StaticOrder, true, true>(L + RING_OFF, g, S, E); GRID_BAR(); }
    {   pg8::Gemm g{H, Wd2, M, DM, FF, 0}; pg8::StaticOrder S; S.init(M, DM, G, bx); pg8::EpiF32 E{T, DM, 0};
        pg8::gemm_phase<pg8::EpiF32, pg8::StaticOrder, true, true>(L + RING_OFF, g, S, E); GRID_BAR(); }
    p_ln(X2, X2 + (size_t)MP * DM, T, 0.5f, in[23], in[24], out + O_YP, out + O_YS, nullptr, gw, NGW, lane);
}

extern "C" void kernel_launch(void* const* d_in, const int* in_sizes, int n_in, void* d_out, int out_size, void* d_ws, size_t ws_size, hipStream_t stream) {
    static int grid = 0;
    if (grid == 0) {
        if (n_in != 25 || out_size != (int)O_END || ws_size < WS_END) { fprintf(stderr, "kernel_launch: unexpected shapes (n_in %d out %d ws %zu)\n", n_in, out_size, ws_size); grid = -1; return; }
        int dev = 0, cus = 0, per_cu = 0;
        if (hipGetDevice(&dev) != hipSuccess || hipDeviceGetAttribute(&cus, hipDeviceAttributeMultiprocessorCount, dev) != hipSuccess) { grid = -1; return; }
        if (hipFuncSetAttribute((const void*)mega_fwd, hipFuncAttributeMaxDynamicSharedMemorySize, LDS_BYTES) != hipSuccess) { fprintf(stderr, "kernel_launch: hipFuncSetAttribute failed\n"); grid = -1; return; }
        if (hipOccupancyMaxActiveBlocksPerMultiprocessor(&per_cu, (const void*)mega_fwd, NWAVES * 64, LDS_BYTES) != hipSuccess || per_cu < 1) { fprintf(stderr, "kernel_launch: occupancy query reports %d\n", per_cu); }
        (void)hipGetLastError();
        grid = cus;
    }
    if (grid < 0) return;
    if (hipMemsetAsync((char*)d_ws + WS_CTL, 0, CTL_ZERO_BYTES, stream) != hipSuccess) return;
    Args a; memset(&a, 0, sizeof(a));
    for (int i = 0; i < 25; ++i) a.in[i] = (const float*)d_in[i];
    a.out = (float*)d_out; a.ws = (unsigned char*)d_ws;
    hipLaunchKernelGGL(mega_fwd, dim3(grid), dim3(NWAVES * 64), LDS_BYTES, stream, a);
}
```

```cpp
#include <hip/hip_runtime.h>
#include <cstdio>
#include <cstdint>
#include <cstring>
#include <cmath>
namespace pg8 {
#define PG8_LAS __attribute__((address_space(3)))
typedef unsigned short bf16_t;
typedef short bf16x8 __attribute__((ext_vector_type(8)));
typedef float f32x4 __attribute__((ext_vector_type(4)));
typedef unsigned u32x4 __attribute__((ext_vector_type(4)));
constexpr int BM = 256, BK = 64, HALF = 128, HTB = HALF * BK * 2  , STAGE_BYTES = 8 * HTB, NXCD = 8, WGM = 8;

__host__ __device__ __forceinline__ int lds_byte(int r, int c) { const int st = (r >> 4) * 2 + (c >> 5), rr = r & 15, cc = c & 31, ob = rr * 64 + cc * 2; return st * 1024 + (ob ^ (((ob >> 9) & 1) << 5)); }
__host__ __device__ __forceinline__ void stage_rc(int b, int& R, int& C) { const int st = b / 1024, sb = b % 1024, swz = sb ^ (((sb >> 9) & 1) << 5); R = (st >> 1) * 16 + swz / 64; C = (st & 1) * 32 + (swz % 64) / 2; }
__host__ __device__ __forceinline__ int perm32(int rho) { const int n = rho >> 4, i = rho & 15; return 8 * (i >> 2) + 4 * n + (i & 3); }

struct Unit { int pm, pn; };
struct Gemm { const bf16_t* A; const bf16_t* Bt; int M, N, K, pad; };

struct StaticOrder {
    int nM, nN, nwg, G, c;
    __host__ __device__ void init(int M, int N, int G_, int c_) { nM = M / BM; nN = N / BM; nwg = nM * nN; G = G_; c = c_; }
    __host__ __device__ bool next(int i, Unit& u) const {
        const long L = (long)i * G + c; if (L >= nwg) return false;
        int wgid = (int)L; { const int q = nwg / NXCD, r = nwg % NXCD, xcd = wgid % NXCD, off = wgid / NXCD; wgid = (xcd < r ? xcd * (q + 1) : r * (q + 1) + (xcd - r) * q) + off; }
        const int nig = WGM * nN, gid = wgid / nig, fm = gid * WGM, gsz = (nM - fm) < WGM ? (nM - fm) : WGM;
        u.pm = fm + ((wgid % nig) % gsz); u.pn = (wgid % nig) / gsz; return true;
    }
    __device__ __forceinline__ void a_ready(const Unit&) const {}
    __device__ __forceinline__ void done(const Unit&) const {}
};

__device__ __forceinline__ unsigned cvt_pk_bf16(float lo, float hi) { unsigned r; asm volatile("v_cvt_pk_bf16_f32 %0, %1, %2" : "=v"(r) : "v"(lo), "v"(hi)); return r; }
typedef float f32x2 __attribute__((ext_vector_type(2)));
struct EpiF32 {
    static constexpr bool PERM = false, AFTER_DRAIN = false;
    float* C; int ldc, pad;
    __device__ __forceinline__ void operator()(const f32x4 (&acc)[2][2][4][2], const Unit& u, int wr, int wc, int fr, int fq) const {
        const int row0 = u.pm * BM + wr * 64 + fr, col0 = u.pn * BM + wc * 32 + 4 * fq;
#pragma unroll
        for (int ai = 0; ai < 2; ++ai)
#pragma unroll
            for (int m = 0; m < 4; ++m) { float* rowp = C + (size_t)(row0 + ai * HALF + m * 16) * ldc + col0;
#pragma unroll
                for (int bj = 0; bj < 2; ++bj)
#pragma unroll
                    for (int n = 0; n < 2; ++n) *(f32x4*)(rowp + bj * HALF + n * 16) = acc[ai][bj][m][n]; }
    }
};
__device__ __forceinline__ float silu_f(float x) { return x * __builtin_amdgcn_rcpf(1.0f + __builtin_amdgcn_exp2f(-1.4426950408889634f * x)); }
struct EpiSwiGLU {
    static constexpr bool PERM = true, AFTER_DRAIN = false;
    bf16_t* H; int ldc, pad;
    __device__ __forceinline__ void operator()(const f32x4 (&acc)[2][2][4][2], const Unit& u, int wr, int wc, int fr, int fq) const {
        const int row0 = u.pm * BM + wr * 64 + fr, col0 = u.pn * HALF + wc * 32 + 8 * fq;
#pragma unroll
        for (int ai = 0; ai < 2; ++ai)
#pragma unroll
            for (int m = 0; m < 4; ++m) { bf16_t* rowp = H + (size_t)(row0 + ai * HALF + m * 16) * ldc + col0;
                const f32x4 g0 = acc[ai][0][m][0], g1 = acc[ai][0][m][1], u0 = acc[ai][1][m][0], u1 = acc[ai][1][m][1];
                u32x4 w;
                w.x = cvt_pk_bf16(silu_f(g0[0]) * u0[0], silu_f(g0[1]) * u0[1]); w.y = cvt_pk_bf16(silu_f(g0[2]) * u0[2], silu_f(g0[3]) * u0[3]);
                w.z = cvt_pk_bf16(silu_f(g1[0]) * u1[0], silu_f(g1[1]) * u1[1]); w.w = cvt_pk_bf16(silu_f(g1[2]) * u1[2], silu_f(g1[3]) * u1[3]);
                *(u32x4*)rowp = w; }
    }
};
template <class Epi, class Sched, bool ALIGN_EPI = false, bool SP2 = false>
__device__ __forceinline__ void gemm_phase(PG8_LAS unsigned char* lds, const Gemm g, const Sched& S, const Epi& E) {
    int tid_l = threadIdx.x; asm volatile("" : "+v"(tid_l));
    const int tid = tid_l, wid = __builtin_amdgcn_readfirstlane(tid >> 6), lane = tid & 63, wr = wid >> 2, wc = wid & 3, fr = lane & 15, fq = lane >> 4;
    const int K = g.K, nt = K / BK;
    unsigned voffA[2], voffB[2];
#pragma unroll
    for (int i = 0; i < 2; ++i) { int R, C; stage_rc(tid * 16 + i * 8192, R, C); const int Rb = Epi::PERM ? ((R & ~31) + perm32(R & 31)) : R;
        voffA[i] = (unsigned)(R * K + C) * 2u; voffB[i] = (unsigned)(Rb * K + C) * 2u; }
    const size_t kstep = (size_t)(BK * 2);
    const size_t hstep = (size_t)HALF * K * 2;
    const size_t tstep = 2 * hstep;
    const unsigned ldsw = (unsigned)wid * 1024u;
    const int aoff = lds_byte(wr * 64 + fr, fq * 8), boff = lds_byte(wc * 32 + fr, fq * 8);
#define PG8_SA(b, h) (((b) * 2 + (h)) * HTB)
#define PG8_SB(b, h) ((4 + (b) * 2 + (h)) * HTB)
#define PG8_STAGE(bufoff, gbase, voff) do { _Pragma("unroll") for (int _i = 0; _i < 2; ++_i) \
        __builtin_amdgcn_global_load_lds((const unsigned*)((const char*)(gbase) + (voff)[_i]), (PG8_LAS unsigned*)(lds + (bufoff) + ldsw + _i * 8192), 16, 0, 0); } while (0)
#define PG8_LDA(dst, b, h) do { _Pragma("unroll") for (int m = 0; m < 4; ++m) _Pragma("unroll") for (int k = 0; k < 2; ++k) dst[m][k] = *(const PG8_LAS bf16x8*)(lds + PG8_SA(b, h) + aoff + m * 2048 + k * 1024); } while (0)
#define PG8_LDB(dst, b, h) do { _Pragma("unroll") for (int n = 0; n < 2; ++n) _Pragma("unroll") for (int k = 0; k < 2; ++k) dst[n][k] = *(const PG8_LAS bf16x8*)(lds + PG8_SB(b, h) + boff + n * 2048 + k * 1024); } while (0)
#define PG8_MMA(ai, bj, At, Bt) do { __builtin_amdgcn_s_setprio(1); _Pragma("unroll") for (int m = 0; m < 4; ++m) _Pragma("unroll") for (int n = 0; n < 2; ++n) _Pragma("unroll") for (int k = 0; k < 2; ++k) \
        acc[ai][bj][m][n] = __builtin_amdgcn_mfma_f32_16x16x32_bf16(Bt[n][k], At[m][k], acc[ai][bj][m][n], 0, 0, 0); __builtin_amdgcn_s_setprio(0); } while (0)
#define PG8_WAIT_V(n) asm volatile("s_waitcnt vmcnt(" #n ")" ::: "memory")
#define PG8_WAIT_L(n) asm volatile("s_waitcnt lgkmcnt(" #n ")" ::: "memory")
#define PG8_BAR __builtin_amdgcn_s_barrier()
#define PG8_SCHED __builtin_amdgcn_sched_barrier(0)
    Unit cur, nxt; int ui = 0;
    if (!S.next(0, cur)) return;
    f32x4 acc[2][2][4][2];
#pragma unroll
    for (int a = 0; a < 2; ++a)
#pragma unroll
        for (int b = 0; b < 2; ++b)
#pragma unroll
            for (int m = 0; m < 4; ++m)
#pragma unroll
                for (int n = 0; n < 2; ++n) acc[a][b][m][n] = (f32x4){0.f, 0.f, 0.f, 0.f};
    bf16x8 At[4][2], B0[2][2], B1[2][2];
    const char* cA = (const char*)g.A + (size_t)cur.pm * tstep; const char* cB = (const char*)g.Bt + (size_t)cur.pn * tstep;
    S.a_ready(cur);
    if constexpr (SP2) {
        PG8_STAGE(PG8_SB(0, 0), cB, voffB); PG8_STAGE(PG8_SB(0, 1), cB + hstep, voffB); PG8_STAGE(PG8_SA(0, 0), cA, voffA); PG8_STAGE(PG8_SA(0, 1), cA + hstep, voffA);
        if (wr == 1) PG8_BAR;
        PG8_WAIT_V(2); PG8_BAR;
        PG8_STAGE(PG8_SB(1, 0), cB + kstep, voffB); PG8_STAGE(PG8_SA(1, 0), cA + kstep, voffA); PG8_STAGE(PG8_SB(1, 1), cB + hstep + kstep, voffB);
        PG8_WAIT_V(6); PG8_BAR;
    } else {
        PG8_STAGE(PG8_SB(0, 0), cB, voffB); PG8_STAGE(PG8_SA(0, 0), cA, voffA); PG8_STAGE(PG8_SB(0, 1), cB + hstep, voffB); PG8_STAGE(PG8_SA(0, 1), cA + hstep, voffA);
        if (wr == 1) PG8_BAR;
        PG8_WAIT_V(4); PG8_BAR;
        PG8_STAGE(PG8_SB(1, 0), cB + kstep, voffB); PG8_STAGE(PG8_SA(1, 0), cA + kstep, voffA); PG8_STAGE(PG8_SB(1, 1), cB + hstep + kstep, voffB);
        PG8_WAIT_V(6); PG8_BAR;
    }
    for (;;) {
        const bool has_next = S.next(ui + 1, nxt);
        const char* nA = has_next ? (const char*)g.A + (size_t)nxt.pm * tstep : cA; const char* nB = has_next ? (const char*)g.Bt + (size_t)nxt.pn * tstep : cB;
        for (int t = 0; t < nt; t += 2) {
            const bool last = (t == nt - 2);
            const char* a1 = cA + (size_t)(t + 1) * kstep;
            const char* a2 = last ? nA : cA + (size_t)(t + 2) * kstep; const char* b2 = last ? nB : cB + (size_t)(t + 2) * kstep;
            const char* a3 = a2 + kstep; const char* b3 = b2 + kstep;
            if (last && has_next) S.a_ready(nxt);
            if constexpr (SP2) {
            PG8_LDB(B0, 0, 0); PG8_LDB(B1, 0, 1); PG8_SCHED; PG8_LDA(At, 0, 0); PG8_STAGE(PG8_SA(1, 1), a1 + hstep, voffA);
            PG8_WAIT_V(8); PG8_WAIT_L(0); PG8_BAR; PG8_MMA(0, 0, At, B0); PG8_MMA(0, 1, At, B1); PG8_BAR; PG8_SCHED;
            PG8_LDA(At, 0, 1); PG8_STAGE(PG8_SB(0, 0), b2, voffB); PG8_STAGE(PG8_SB(0, 1), b2 + hstep, voffB); PG8_STAGE(PG8_SA(0, 0), a2, voffA);
            PG8_WAIT_V(8); PG8_WAIT_L(0); PG8_BAR; PG8_MMA(1, 0, At, B0); PG8_MMA(1, 1, At, B1); PG8_BAR; PG8_SCHED;
            PG8_LDB(B0, 1, 0); PG8_LDB(B1, 1, 1); PG8_SCHED; PG8_LDA(At, 1, 0); PG8_STAGE(PG8_SA(0, 1), a2 + hstep, voffA);
            PG8_WAIT_V(8); PG8_WAIT_L(0); PG8_BAR; PG8_MMA(0, 0, At, B0); PG8_MMA(0, 1, At, B1); PG8_BAR; PG8_SCHED;
            PG8_LDA(At, 1, 1); PG8_STAGE(PG8_SB(1, 0), b3, voffB); PG8_STAGE(PG8_SB(1, 1), b3 + hstep, voffB); PG8_STAGE(PG8_SA(1, 0), a3, voffA);
            PG8_WAIT_V(8); PG8_WAIT_L(0); PG8_BAR; PG8_MMA(1, 0, At, B0); PG8_MMA(1, 1, At, B1); PG8_BAR; PG8_SCHED;
            } else {
            PG8_LDB(B0, 0, 0); PG8_SCHED; PG8_LDA(At, 0, 0); PG8_STAGE(PG8_SA(1, 1), a1 + hstep, voffA);
            PG8_WAIT_L(8); PG8_BAR; PG8_WAIT_L(0); PG8_MMA(0, 0, At, B0); PG8_BAR; PG8_SCHED;
            PG8_LDB(B1, 0, 1); PG8_STAGE(PG8_SB(0, 0), b2, voffB);
            PG8_BAR; PG8_WAIT_L(0); PG8_MMA(0, 1, At, B1); PG8_BAR;
            PG8_LDA(At, 0, 1); PG8_STAGE(PG8_SA(0, 0), a2, voffA);
            PG8_BAR; PG8_WAIT_L(0); PG8_MMA(1, 0, At, B0); PG8_BAR; PG8_SCHED;
            PG8_STAGE(PG8_SB(0, 1), b2 + hstep, voffB);
            PG8_WAIT_V(6); PG8_BAR; PG8_MMA(1, 1, At, B1); PG8_BAR;
            PG8_LDB(B0, 1, 0); PG8_SCHED; PG8_LDA(At, 1, 0); PG8_STAGE(PG8_SA(0, 1), a2 + hstep, voffA);
            PG8_WAIT_L(8); PG8_BAR; PG8_WAIT_L(0); PG8_MMA(0, 0, At, B0); PG8_BAR; PG8_SCHED;
            PG8_LDB(B1, 1, 1); PG8_STAGE(PG8_SB(1, 0), b3, voffB);
            PG8_BAR; PG8_WAIT_L(0); PG8_MMA(0, 1, At, B1); PG8_BAR;
            PG8_LDA(At, 1, 1); PG8_STAGE(PG8_SA(1, 0), a3, voffA);
            PG8_BAR; PG8_WAIT_L(0); PG8_MMA(1, 0, At, B0); PG8_BAR; PG8_SCHED;
            PG8_STAGE(PG8_SB(1, 1), b3 + hstep, voffB);
            PG8_WAIT_V(6); PG8_BAR; PG8_MMA(1, 1, At, B1); PG8_BAR;
            }
        }
        if constexpr (ALIGN_EPI) { if (wr == 0) PG8_BAR; }
        if constexpr (!Epi::AFTER_DRAIN) { E(acc, cur, wr, wc, fr, fq); S.done(cur); }
        if (!has_next) break;
#pragma unroll
        for (int a = 0; a < 2; ++a)
#pragma unroll
            for (int b = 0; b < 2; ++b)
#pragma unroll
                for (int m = 0; m < 4; ++m)
#pragma unroll
                    for (int n = 0; n < 2; ++n) acc[a][b][m][n] = (f32x4){0.f, 0.f, 0.f, 0.f};
        cur = nxt; cA = nA; cB = nB; ++ui;
        if constexpr (ALIGN_EPI) { if (wr == 1) PG8_BAR; }
    }
    PG8_WAIT_V(0);
    if constexpr (!ALIGN_EPI) { if (wr == 0) PG8_BAR; }
    PG8_BAR;
    if constexpr (Epi::AFTER_DRAIN) { E.fused(acc, cur, wr, wc, fr, fq, lds, wid, lane); S.done(cur); }
#undef PG8_SA
#undef PG8_SB
#undef PG8_STAGE
#undef PG8_LDA
#undef PG8_LDB
#undef PG8_MMA
#undef PG8_WAIT_V
#undef PG8_WAIT_L
#undef PG8_BAR
#undef PG8_SCHED
}
}
#include <hip/hip_bf16.h>
#include <cmath>
namespace attn_body {
using bf16=__hip_bfloat16;
using bf16x8=__attribute__((ext_vector_type(8)))short;
using s16x4=__attribute__((ext_vector_type(4)))short;
using f32x16=__attribute__((ext_vector_type(16)))float;
using u32x4=__attribute__((ext_vector_type(4)))unsigned;
constexpr int BATCH=8,NHEAD=8,SEQ=2048,D=64,DM=NHEAD*D,OPITCH=1024,BT_OFF=256,BT_N=2304;
constexpr int NW=8,QBLK=32,QB=QBLK*NW,KVBLK=64,NQB=SEQ/QB;
constexpr int ATTN_PITCH=DM, ATTN_UNIT_ROWS=QB;
__device__ __forceinline__ int crow(int r,int hi){return (r&3)+8*(r>>2)+4*hi;}
#define SBAR() __builtin_amdgcn_sched_barrier(0)
__device__ __forceinline__ void cmask(f32x16&p0,f32x16&p1,int jb,int qrel,int hi){
  const float NEG=-INFINITY; int kb=64*jb+4*hi;
  #pragma unroll
  for(int r=0;r<16;++r){int kv=kb+(r&3)+8*(r>>2); if(kv>qrel)p0[r]=NEG; if(kv+32>qrel)p1[r]=NEG;}
}

constexpr int NSLOT=3, SLOTB=8192;
constexpr int LDS_K=0, LDS_V=NSLOT*SLOTB, LDS_WS=2*NSLOT*SLOTB, LDS_OST=LDS_WS+NW*64*4, LDS_BYTES=LDS_OST+NW*4096;
constexpr float C2=0.125f*1.4426950408889634f;
__device__ __forceinline__ void glds16(const void*gsrc,unsigned lds_dst){unsigned keep;
  asm volatile("s_mov_b32 %0, m0\n\ts_mov_b32 m0, %2\n\ts_nop 0\n\tglobal_load_lds_dwordx4 %1, off\n\ts_mov_b32 m0, %0":"=&s"(keep):"v"(gsrc),"s"(lds_dst):"memory");}
__device__ __forceinline__ float max3f(float a,float b,float c){float r;asm("v_max3_f32 %0, %1, %2, %3":"=v"(r):"v"(a),"v"(b),"v"(c));return r;}
__device__ __forceinline__ float max2f(float a,float b){float r;asm("v_max_f32_e32 %0, %1, %2":"=v"(r):"v"(a),"v"(b));return r;}
__device__ __forceinline__ float fadd_s(float a,float b){float r;asm("v_add_f32_e32 %0, %1, %2":"=v"(r):"v"(a),"v"(b));return r;}
__device__ __forceinline__ float fsub_s(float a,float b){float r;asm("v_sub_f32_e32 %0, %1, %2":"=v"(r):"v"(a),"v"(b));return r;}
typedef float f32x2_t __attribute__((ext_vector_type(2))); typedef __bf16 bf16x2_t __attribute__((ext_vector_type(2)));
__device__ __forceinline__ unsigned cvtpk_s(float lo,float hi){f32x2_t v={lo,hi};bf16x2_t b=__builtin_convertvector(v,bf16x2_t);return __builtin_bit_cast(unsigned,b);}
#define WAIT_BAR(N) asm volatile("s_waitcnt vmcnt(" #N ") lgkmcnt(0)\n\ts_barrier":::"memory")

__device__ __forceinline__ void qkt(f32x16&p0,f32x16&p1,const char*Kslot,const bf16x8*qr,const f32x16&negm,int r32,int hi){
  const char*kb=Kslot+hi*1024+r32*16;
  #pragma unroll
  for(int d0=0;d0<4;++d0){
    const bf16x8 b0=*reinterpret_cast<const bf16x8*>(kb+d0*2048);
    const bf16x8 b1=*reinterpret_cast<const bf16x8*>(kb+d0*2048+512);
    if(d0==0){p0=__builtin_amdgcn_mfma_f32_32x32x16_bf16(b0,qr[0],negm,0,0,0);p1=__builtin_amdgcn_mfma_f32_32x32x16_bf16(b1,qr[0],negm,0,0,0);}
    else{p0=__builtin_amdgcn_mfma_f32_32x32x16_bf16(b0,qr[d0],p0,0,0,0);p1=__builtin_amdgcn_mfma_f32_32x32x16_bf16(b1,qr[d0],p1,0,0,0);}}
}
typedef __attribute__((address_space(3))) const char* lds_cptr;
typedef short v4i16_t __attribute__((ext_vector_type(4)));
__device__ __forceinline__ void kload8(bf16x8*kf,lds_cptr kp){
  kf[0]=*(const __attribute__((address_space(3))) bf16x8*)(kp);      kf[1]=*(const __attribute__((address_space(3))) bf16x8*)(kp+512);
  kf[2]=*(const __attribute__((address_space(3))) bf16x8*)(kp+2048); kf[3]=*(const __attribute__((address_space(3))) bf16x8*)(kp+2560);
  kf[4]=*(const __attribute__((address_space(3))) bf16x8*)(kp+4096); kf[5]=*(const __attribute__((address_space(3))) bf16x8*)(kp+4608);
  kf[6]=*(const __attribute__((address_space(3))) bf16x8*)(kp+6144); kf[7]=*(const __attribute__((address_space(3))) bf16x8*)(kp+6656);
}
__device__ __forceinline__ void kload2(bf16x8*kf,lds_cptr kp,int j){ kf[2*j]=*(const __attribute__((address_space(3))) bf16x8*)(kp+j*2048); kf[2*j+1]=*(const __attribute__((address_space(3))) bf16x8*)(kp+j*2048+512); }
__device__ __forceinline__ s16x4 vtr(lds_cptr p){ return __builtin_bit_cast(s16x4,__builtin_amdgcn_ds_read_tr16_b64_v4i16((__attribute__((address_space(3))) v4i16_t*)p)); }
__device__ __forceinline__ float rowmax(const f32x16&p0,const f32x16&p1){
  float a=max3f(p0[0],p0[1],p1[0]),b=max3f(p0[2],p0[3],p1[1]);a=max3f(a,p1[2],p1[3]);
  #pragma unroll
  for(int r=4;r<16;r+=4){a=max3f(a,p0[r],p0[r+1]);b=max3f(b,p0[r+2],p0[r+3]);a=max3f(a,p1[r],p1[r+1]);b=max3f(b,p1[r+2],p1[r+3]);}
  const float m=max2f(a,b);
  auto rr=__builtin_amdgcn_permlane32_swap(__float_as_uint(m),__float_as_uint(m),false,false);
  return max2f(__uint_as_float(rr[0]),__uint_as_float(rr[1]));
}
__device__ __forceinline__ void pv(f32x16*o,int vb,bf16x8 pa0,bf16x8 pa1,bf16x8 pa2,bf16x8 pa3){
  #pragma unroll
  for(int d0=0;d0<2;++d0){s16x4 lo[4],hi[4];
    #pragma unroll
    for(int ks=0;ks<4;++ks){
      asm volatile("ds_read_b64_tr_b16 %0,%1 offset:%c2":"=&v"(lo[ks]):"v"(vb),"i"(d0*4096+ks*1024):"memory");
      asm volatile("ds_read_b64_tr_b16 %0,%1 offset:%c2":"=&v"(hi[ks]):"v"(vb),"i"(d0*4096+ks*1024+512):"memory");}
    asm volatile("s_waitcnt lgkmcnt(0)":::"memory");SBAR();
    #define PK(k) (bf16x8){lo[k][0],lo[k][1],lo[k][2],lo[k][3],hi[k][0],hi[k][1],hi[k][2],hi[k][3]}
    o[d0]=__builtin_amdgcn_mfma_f32_32x32x16_bf16(pa0,PK(0),o[d0],0,0,0);
    o[d0]=__builtin_amdgcn_mfma_f32_32x32x16_bf16(pa1,PK(1),o[d0],0,0,0);
    o[d0]=__builtin_amdgcn_mfma_f32_32x32x16_bf16(pa2,PK(2),o[d0],0,0,0);
    o[d0]=__builtin_amdgcn_mfma_f32_32x32x16_bf16(pa3,PK(3),o[d0],0,0,0);
    #undef PK
  }
}

#ifndef ATTN_STORE16
#define ATTN_STORE16(p,v) (*(u32x4*)(p)=(v))
#endif
template<int THRL> __device__ __forceinline__ void attn_unit(int b,int h,int qb,const bf16*Q,const bf16*__restrict__ K,const bf16*__restrict__ V,bf16*O,char*shm,const __attribute__((address_space(3))) float* btab){
  int tid_l=threadIdx.x; asm volatile("":"+v"(tid_l)); const int tid=tid_l,lane=tid&63,r32=lane&31,hi=lane>>5; const int wid=__builtin_amdgcn_readfirstlane(tid>>6);
  const long rowbase=(long)b*SEQ; const int q0=qb*QB;
  const bf16*Qw=Q+(rowbase+q0+wid*QBLK)*DM+h*D;
  const bf16*Kh=K+rowbase*DM+h*D,*Vh=V+rowbase*DM+h*D;
  const unsigned lds0=(unsigned)(uintptr_t)shm;
  float*wsf=(float*)(shm+LDS_WS)+wid*64;
  const bf16*ksrc=Kh+(long)lane*DM+wid*8;
  const bf16*vsrc=Vh+(long)(16*(wid&3)+(lane>>2))*DM+(wid>>2)*32+(lane&3)*8;
  const unsigned kdst=lds0+LDS_K+wid*1024, vdst=lds0+LDS_V+wid*1024;
  #define DMA_K(t,slot) glds16(ksrc+(long)(t)*KVBLK*DM,(unsigned)__builtin_amdgcn_readfirstlane(kdst+(slot)))
  #define DMA_V(t,slot) glds16(vsrc+(long)(t)*KVBLK*DM,(unsigned)__builtin_amdgcn_readfirstlane(vdst+(slot)))
  const int vb0=(int)(lds0+LDS_V)+((lane>>4)&1)*32+(lane&3)*8+(4*hi+((lane&15)>>2))*64;
  const char*Kbase=shm+LDS_K; bf16x8 kf[8];
  const lds_cptr shm3=(lds_cptr)shm; const lds_cptr kp0=shm3+LDS_K+hi*1024+r32*16; const lds_cptr vp0=shm3+LDS_V+((lane>>4)&1)*32+(lane&3)*8+(4*hi+((lane&15)>>2))*64;
  const int NT=(q0+QB)/KVBLK;
  DMA_K(0,0);DMA_V(0,0);DMA_K(1,SLOTB);
  bf16x8 qr[4];
  #pragma unroll
  for(int d0=0;d0<4;++d0)qr[d0]=*reinterpret_cast<const bf16x8*>(&Qw[(long)r32*DM+d0*16+hi*8]);
  float mhat=0.f,l_reg=0.f;f32x16 o[2];o[0]=f32x16{};o[1]=f32x16{};const f32x16 zero16=f32x16{};
    const int qabs=q0+wid*QBLK+r32;
  #define CMASK(P0,P1,t) do{ const __attribute__((address_space(3))) float* bp_=btab+(BT_OFF-59+qabs-64*(t)-4*hi); \
    _Pragma("unroll") for(int r=0;r<16;++r){ const int x_=(r&3)+8*(r>>2); P0[r]=fadd_s(P0[r],fsub_s(bp_[59-x_],mhat)); P1[r]=fadd_s(P1[r],fsub_s(bp_[27-x_],mhat)); } }while(0)
  bool resc=false;
  #define START(P0,P1) do{ const float rm=rowmax(P0,P1); resc=false; \
    { const float dl=rm; mhat=fadd_s(mhat,dl); \
      _Pragma("unroll") for(int r=0;r<16;++r){P0[r]=fsub_s(P0[r],dl);P1[r]=fsub_s(P1[r],dl);} \
      } \
    _Pragma("unroll") for(int r=0;r<16;++r)P0[r]=__builtin_amdgcn_exp2f(P0[r]); }while(0)
  #define RESC() do{ if(resc){ asm volatile("s_waitcnt lgkmcnt(0)":::"memory"); \
      _Pragma("unroll") for(int d_=0;d_<2;++d_) _Pragma("unroll") for(int r=0;r<16;++r)o[d_][r]*=wsf[crow(r,hi)]; } }while(0)
  f32x16 pA0,pA1,pB0,pB1;
  int sl_prev=0,sl_cur=0,sl_next=SLOTB;
  #define ROT() do{sl_prev=sl_cur;sl_cur=sl_next;sl_next=(sl_next==(NSLOT-1)*SLOTB)?0:sl_next+SLOTB;}while(0)
  DMA_K(2,2*SLOTB);
  WAIT_BAR(3);
  qkt(pA0,pA1,Kbase,qr,zero16,r32,hi);asm volatile("s_nop 15\n\ts_nop 7":"+v"(pA0),"+v"(pA1));CMASK(pA0,pA1,0);
  START(pA0,pA1);
  _Pragma("unroll") for(int r=0;r<16;++r)pA1[r]=__builtin_amdgcn_exp2f(pA1[r]);
  WAIT_BAR(0);
  DMA_K(3,0);DMA_V(1,SLOTB);
  ROT();
  kload8(kf,kp0+sl_cur);
  WAIT_BAR(2);
  s16x4 vlo[8],vhi[8]; u32x4 pw0,pw1,pw2,pw3;
  #define PKW(P,B) cvtpk_s(P[B],P[B+1])
  #define PAF(k) __builtin_bit_cast(bf16x8,pw##k)
  #define VFR(i) (bf16x8){vlo[i][0],vlo[i][1],vlo[i][2],vlo[i][3],vhi[i][0],vhi[i][1],vhi[i][2],vhi[i][3]}
  #define PIN(x) asm volatile("":"+v"(x))
  #define MX3(a,b,c) __builtin_fmaxf(__builtin_fmaxf((a),(b)),(c))
  #define GAPA(MF,A0,A1,A2,A3,W0,W1,PW) do{ MF; sacc+=A0; sacc+=A1; sacc+=A2; sacc+=A3; PIN(sacc); W0; W1; PIN(PW); SBAR(); }while(0)
  #define EX(v) __builtin_amdgcn_exp2f(v)
  #define GAPB(MF,X,B) do{ MF; X[B]=EX(X[B]); X[B+1]=EX(X[B+1]); X[B+2]=EX(X[B+2]); X[B+3]=EX(X[B+3]); PIN(X); SBAR(); }while(0)
  #define VRD(i) do{ vlo[i]=vtr(vp_+(((i)>>2)*4096+((i)&3)*1024)); vhi[i]=vtr(vp_+(((i)>>2)*4096+((i)&3)*1024+512)); }while(0)
  #define KRD(G,j) do{ if(G){ kload2(kf,kp0+sl_next,j); SBAR(); } }while(0)
  #define STEP(C0,C1,P0,P1,t,GK,GV,GL) do{ SBAR(); \
    const lds_cptr vp_=vp0+sl_prev; \
    VRD(0); SBAR(); float sacc=(P0[0]+P0[1]); \
    GAPA(C0=__builtin_amdgcn_mfma_f32_32x32x16_bf16(kf[0],qr[0],zero16,0,0,0), P0[2],P0[3],P0[4],P0[5],     pw0[0]=PKW(P0,0), pw0[1]=PKW(P0,2), pw0); \
    VRD(4); SBAR(); GAPA(C1=__builtin_amdgcn_mfma_f32_32x32x16_bf16(kf[1],qr[0],zero16,0,0,0), P0[6],P0[7],P0[8],P0[9],     pw0[2]=PKW(P0,4), pw0[3]=PKW(P0,6), pw0); \
    VRD(1); SBAR(); GAPA(C0=__builtin_amdgcn_mfma_f32_32x32x16_bf16(kf[2],qr[1],C0,0,0,0),   P0[10],P0[11],P0[12],P0[13], pw1[0]=PKW(P0,8), pw1[1]=PKW(P0,10), pw1); \
    VRD(5); SBAR(); GAPA(C1=__builtin_amdgcn_mfma_f32_32x32x16_bf16(kf[3],qr[1],C1,0,0,0),   P0[14],P0[15],P1[0],P1[1],   pw1[2]=PKW(P0,12),pw1[3]=PKW(P0,14), pw1); \
    VRD(2); SBAR(); GAPA(C0=__builtin_amdgcn_mfma_f32_32x32x16_bf16(kf[4],qr[2],C0,0,0,0),   P1[2],P1[3],P1[4],P1[5],     pw2[0]=PKW(P1,0), pw2[1]=PKW(P1,2), pw2); \
    VRD(6); SBAR(); GAPA(C1=__builtin_amdgcn_mfma_f32_32x32x16_bf16(kf[5],qr[2],C1,0,0,0),   P1[6],P1[7],P1[8],P1[9],     pw2[2]=PKW(P1,4), pw2[3]=PKW(P1,6), pw2); \
    VRD(3); SBAR(); GAPA(C0=__builtin_amdgcn_mfma_f32_32x32x16_bf16(kf[6],qr[3],C0,0,0,0),   P1[10],P1[11],P1[12],P1[13], pw3[0]=PKW(P1,8), pw3[1]=PKW(P1,10), pw3); \
    VRD(7); SBAR(); GAPA(C1=__builtin_amdgcn_mfma_f32_32x32x16_bf16(kf[7],qr[3],C1,0,0,0),   P1[14],P1[15],0.f,0.f,       pw3[2]=PKW(P1,12),pw3[3]=PKW(P1,14), pw3); \
    l_reg+=sacc; \
    if(GK){DMA_K((t)+3,sl_cur);} if(GV){DMA_V((t)+1,sl_next);} \
    CMASK(C0,C1,t); \
    { float a=MX3(C0[0],C0[1],C1[0]),b=MX3(C0[2],C0[3],C1[1]); a=MX3(a,C1[2],C1[3]); \
      _Pragma("unroll") for(int r=4;r<16;r+=4){a=MX3(a,C0[r],C0[r+1]);b=MX3(b,C0[r+2],C0[r+3]);a=MX3(a,C1[r],C1[r+1]);b=MX3(b,C1[r+2],C1[r+3]);} \
      float rm=__builtin_fmaxf(a,b); { auto rr=__builtin_amdgcn_permlane32_swap(__float_as_uint(rm),__float_as_uint(rm),false,false); rm=__builtin_fmaxf(__uint_as_float(rr[0]),__uint_as_float(rr[1])); } \
      resc=false; \
      if(__builtin_expect(__any(rm>(float)THRL),0)){ const float dl=__builtin_fmaxf(rm,0.f); mhat+=dl; \
        _Pragma("unroll") for(int r=0;r<16;++r){C0[r]-=dl;C1[r]-=dl;} \
        const float f=__builtin_amdgcn_exp2f(-dl); l_reg*=f; if(hi==0)wsf[r32]=f; resc=true; } } \
    SBAR(); \
    GAPB(o[0]=__builtin_amdgcn_mfma_f32_32x32x16_bf16(PAF(0),VFR(0),o[0],0,0,0), C0,0); \
    GAPB(o[1]=__builtin_amdgcn_mfma_f32_32x32x16_bf16(PAF(0),VFR(4),o[1],0,0,0), C0,4); \
    KRD(GL,0); GAPB(o[0]=__builtin_amdgcn_mfma_f32_32x32x16_bf16(PAF(1),VFR(1),o[0],0,0,0), C0,8); \
    KRD(GL,1); GAPB(o[1]=__builtin_amdgcn_mfma_f32_32x32x16_bf16(PAF(1),VFR(5),o[1],0,0,0), C0,12); \
    KRD(GL,2); GAPB(o[0]=__builtin_amdgcn_mfma_f32_32x32x16_bf16(PAF(2),VFR(2),o[0],0,0,0), C1,0); \
    KRD(GL,3); GAPB(o[1]=__builtin_amdgcn_mfma_f32_32x32x16_bf16(PAF(2),VFR(6),o[1],0,0,0), C1,4); \
    GAPB(o[0]=__builtin_amdgcn_mfma_f32_32x32x16_bf16(PAF(3),VFR(3),o[0],0,0,0), C1,8); \
    GAPB(o[1]=__builtin_amdgcn_mfma_f32_32x32x16_bf16(PAF(3),VFR(7),o[1],0,0,0), C1,12); \
    }while(0)
  int t=1;
  for(;t+5<NT;t+=2){
    STEP(pB0,pB1,pA0,pA1,t,true,true,true);     WAIT_BAR(2); RESC(); ROT();
    STEP(pA0,pA1,pB0,pB1,t+1,true,true,true);   WAIT_BAR(2); RESC(); ROT();
  }
  #define ENDW(tt) do{ if((tt)+3<NT){WAIT_BAR(2);} else if((tt)+2<NT){WAIT_BAR(1);} else {WAIT_BAR(0);} }while(0)
  for(;t+1<NT;t+=2){
    STEP(pB0,pB1,pA0,pA1,t,(t+3<NT),(t+1<NT),(t+1<NT));       ENDW(t);   RESC(); ROT();
    STEP(pA0,pA1,pB0,pB1,t+1,(t+4<NT),(t+2<NT),(t+2<NT));     ENDW(t+1); RESC(); ROT();
  }
  STEP(pB0,pB1,pA0,pA1,NT-1,false,false,false); RESC();
  { float sacc=pB0[0]+pB0[1]; _Pragma("unroll") for(int r=2;r<16;++r)sacc+=pB0[r]; _Pragma("unroll") for(int r=0;r<16;++r)sacc+=pB1[r]; l_reg+=sacc;
    pw0=(u32x4){PKW(pB0,0),PKW(pB0,2),PKW(pB0,4),PKW(pB0,6)};pw1=(u32x4){PKW(pB0,8),PKW(pB0,10),PKW(pB0,12),PKW(pB0,14)};pw2=(u32x4){PKW(pB1,0),PKW(pB1,2),PKW(pB1,4),PKW(pB1,6)};pw3=(u32x4){PKW(pB1,8),PKW(pB1,10),PKW(pB1,12),PKW(pB1,14)};
    SBAR(); pv(o,vb0+sl_cur,PAF(0),PAF(1),PAF(2),PAF(3)); }
  #undef PKW
  #undef PAF
  #undef VFR
  #undef PIN
  #undef MX3
  #undef GAPA
  #undef GAPB
  #undef EX
  #undef VRD
  #undef KRD
  #undef STEP
  #undef ENDW
  {auto rr=__builtin_amdgcn_permlane32_swap(__float_as_uint(l_reg),__float_as_uint(l_reg),false,false);l_reg=__uint_as_float(rr[0])+__uint_as_float(rr[1]);}
  if(hi==0)wsf[32+r32]=l_reg;asm volatile("s_waitcnt lgkmcnt(0)":::"memory");
  float rli[16];
  #pragma unroll
  for(int r=0;r<16;++r)rli[r]=__builtin_amdgcn_rcpf(wsf[32+crow(r,hi)]);
  bf16*Ow=O+(rowbase+q0+wid*QBLK)*OPITCH+h*D;
  { bf16*stg=(bf16*)(shm+LDS_OST)+wid*2048;
    #pragma unroll
    for(int r=0;r<16;++r){const int orow=crow(r,hi);
      #pragma unroll
      for(int d0=0;d0<2;++d0)stg[orow*64+d0*32+r32]=__float2bfloat16(o[d0][r]*rli[r]);}
    asm volatile("s_waitcnt lgkmcnt(0)":::"memory");
    #pragma unroll
    for(int i=0;i<4;++i){const int row=i*8+(lane>>3),ch=lane&7; const u32x4 v=*(const u32x4*)(stg+row*64+ch*8); ATTN_STORE16(Ow+(long)row*OPITCH+ch*8,v);} }
  asm volatile("s_waitcnt lgkmcnt(0)\n\ts_barrier":::"memory");
  #undef DMA_K
  #undef DMA_V
  #undef CMASK
  #undef START
  #undef RESC
  #undef ROT
}
constexpr int ATTN_LDS_BYTES=LDS_BYTES;
struct AttnTensors { const bf16* Q; const bf16* K; const bf16* V; bf16* O; };
struct AttnUnit { int bh; int qb; };
struct StaticOrder {
  int vcu;
  __device__ __forceinline__ explicit StaticOrder(int grid,int block):vcu((block%8)*(grid/8)+block/8){}
  __device__ __forceinline__ bool next(int i,AttnUnit&u)const{ if(i>=2)return false; const int s=vcu&3; u.bh=vcu>>2; u.qb=(i==0)?s:7-s; return true; }
  __device__ __forceinline__ void a_ready(const AttnUnit&)const{}
  __device__ __forceinline__ void done(const AttnUnit&)const{}
};
constexpr int BT_LDS_OFF=86016, ATTN_LDS_TOTAL=BT_LDS_OFF+BT_N*4;
__device__ __forceinline__ int t5b(int n){ if(n<16)return n; int b=16; b+=(n>=22);b+=(n>=30);b+=(n>=40);b+=(n>=54);b+=(n>=73);b+=(n>=99);b+=(n>=134);b+=(n>=182);b+=(n>=246);b+=(n>=332);b+=(n>=450);b+=(n>=609);b+=(n>=825);b+=(n>=1117);b+=(n>=1513); return b; }
__device__ __forceinline__ void build_btab(__attribute__((address_space(3))) float* bt,const float*relb,int h){
  for(int i=threadIdx.x;i<BT_N;i+=NW*64){ const int dl=i-BT_OFF; float v=-INFINITY;
    if(dl>=0){ const int c=(dl<=128?1:0)+(((dl&3)==0&&dl<=512)?1:0)+(((dl&15)==0&&dl<=2048)?1:0);
      if(c>0) v=(relb[t5b(dl)*NHEAD+h]+(c==1?0.f:(c==2?0.6931471805599453f:1.0986122886681098f)))*1.4426950408889634f; }
    bt[i]=v; }
}
template<class Sched,int THRL=8> __device__ __forceinline__ void attn_phase(char*lds,const AttnTensors&T,const float*relb,const Sched&S){
  AttnUnit u; int cur_h=-1;
  __attribute__((address_space(3))) float* bt=(__attribute__((address_space(3))) float*)((__attribute__((address_space(3))) char*)lds+BT_LDS_OFF);
  for(int i=0;S.next(i,u);++i){ S.a_ready(u);
    const int h=u.bh%NHEAD;
    if(h!=cur_h){ asm volatile("s_waitcnt lgkmcnt(0)\n\ts_barrier":::"memory"); build_btab(bt,relb,h); asm volatile("s_waitcnt lgkmcnt(0)\n\ts_barrier":::"memory"); cur_h=h; }
    attn_unit<THRL>(u.bh/NHEAD,u.bh%NHEAD,u.qb,T.Q,T.K,T.V,T.O,lds,bt); S.done(u); }
}
#undef SBAR
#undef WAIT_BAR
}
#define GAS __attribute__((address_space(1)))
#define LAS __attribute__((address_space(3)))
typedef unsigned short bf16;
typedef unsigned v4u __attribute__((ext_vector_type(4)));
typedef float f32x4 __attribute__((ext_vector_type(4)));
typedef short bf16x8 __attribute__((ext_vector_type(8)));
typedef GAS unsigned gu32;
typedef GAS unsigned long long gu64;
#define RLX_AGENT __ATOMIC_RELAXED, __HIP_MEMORY_SCOPE_AGENT
#define LDS_WAIT() asm volatile("s_waitcnt lgkmcnt(0)" ::: "memory")
#define VM_WAIT() asm volatile("s_waitcnt vmcnt(0)" ::: "memory")
__device__ __forceinline__ unsigned long long rt() { return __builtin_amdgcn_s_memrealtime(); }
__device__ __forceinline__ unsigned f2bf(float f) { unsigned u = __builtin_bit_cast(unsigned, f); return (u + 0x7fffu + ((u >> 16) & 1u)) >> 16; }
__device__ __forceinline__ unsigned pk2(float lo, float hi) { return f2bf(lo) | (f2bf(hi) << 16); }
#define XB_TMO      128
#define XB_XCNT(j)  (256  + 64 * (j))
#define XB_XSUB(j)  (1280 + 64 * (j))
#define XB_XGEN(j)  (2304 + 64 * (j))
#define XB_TOP      3328
#define XB_TOPGEN   3392
#define XCD_BAR_WORDS 3456
#define XB_SPIN_CAP (1u << 18)

__device__ __forceinline__ unsigned xb_ld(unsigned* p)              { return __hip_atomic_load(p, __ATOMIC_RELAXED, __HIP_MEMORY_SCOPE_AGENT); }
__device__ __forceinline__ unsigned xb_add(unsigned* p, unsigned v) { return __hip_atomic_fetch_add(p, v, __ATOMIC_RELAXED, __HIP_MEMORY_SCOPE_AGENT); }
__device__ __forceinline__ unsigned xb_xcc_id() { return (unsigned)__builtin_amdgcn_s_getreg((3 << 11) | 20) & 0xFu; }
#define XB_SPIN(cond, bar) do { unsigned _sp = 0; while (cond) { __builtin_amdgcn_s_sleep(1); \
    if ((++_sp & 255u) == 0u) { if (xb_ld(&(bar)[XB_TMO])) break; if (_sp > XB_SPIN_CAP) { atomicAdd(&(bar)[XB_TMO], 1u); break; } } } } while (0)

struct XcdBarrier {
    unsigned* bar; unsigned x;
    volatile LAS unsigned* st;
};

__device__ __forceinline__ XcdBarrier xcd_barrier_post(unsigned* bar, volatile LAS unsigned* st) {
    XcdBarrier b; b.bar = bar; b.x = xb_xcc_id(); b.st = st;
    if (threadIdx.x == 0) (void)xb_add(&bar[XB_XCNT(b.x)], 1u);
    return b;
}
__device__ __forceinline__ void xcd_barrier_complete(unsigned* bar, unsigned x, unsigned& nloc, unsigned& nx) {
    const unsigned G = gridDim.x * gridDim.y * gridDim.z;
    unsigned sum, cnt, mine, sp = 0u;
    for (;;) {
        sum = 0u; cnt = 0u; mine = 0u;
#pragma unroll
        for (unsigned j = 0; j < 16; ++j) { const unsigned c = xb_ld(&bar[XB_XCNT(j)]); sum += c; cnt += (c > 0u) ? 1u : 0u; mine = (j == x) ? c : mine; }
        if (sum == G) break;
        __builtin_amdgcn_s_sleep(1);
        if ((++sp & 255u) == 0u) { if (xb_ld(&bar[XB_TMO])) break; if (sp > XB_SPIN_CAP) { atomicAdd(&bar[XB_TMO], 1u); break; } }
    }
    nloc = mine > 0u ? mine : 1u; nx = cnt > 0u ? cnt : 1u;
}

__device__ __forceinline__ void xcd_barrier(const XcdBarrier& b) {
    asm volatile("s_waitcnt vmcnt(0)" ::: "memory");
    __syncthreads();
    if (threadIdx.x == 0) {
        unsigned* bar = b.bar;
        __builtin_amdgcn_s_waitcnt(0);
        unsigned nloc = b.st[0], nx = b.st[1];
        if (nloc == 0u) { xcd_barrier_complete(bar, b.x, nloc, nx); b.st[0] = nloc; b.st[1] = nx; }
        const unsigned old = xb_add(&bar[XB_XSUB(b.x)], 1u);
        const unsigned gen = old / nloc;
        if (old + 1u == (gen + 1u) * nloc) {
            __builtin_amdgcn_fence(__ATOMIC_RELEASE, "agent");
            asm volatile("s_waitcnt vmcnt(0)" ::: "memory");
            const unsigned og = xb_add(&bar[XB_TOP], 1u);
            const unsigned tg = og / nx;
            if (og + 1u == (tg + 1u) * nx) xb_add(&bar[XB_TOPGEN], 1u);
            else XB_SPIN(xb_ld(&bar[XB_TOPGEN]) == tg, bar);
            __builtin_amdgcn_fence(__ATOMIC_ACQUIRE, "agent");
            xb_add(&bar[XB_XGEN(b.x)], 1u);
            asm volatile("s_waitcnt vmcnt(0)" ::: "memory");
        } else {
            XB_SPIN(xb_ld(&bar[XB_XGEN(b.x)]) == gen, bar);
            __builtin_amdgcn_fence(__ATOMIC_ACQUIRE, "agent");
            asm volatile("s_waitcnt vmcnt(0)" ::: "memory");
        }
    }
    __syncthreads();
}
namespace gdn {
#define GLAS __attribute__((address_space(3)))
typedef short bf16x8 __attribute__((ext_vector_type(8)));
typedef float f32x16 __attribute__((ext_vector_type(16)));
typedef float f32x2_t __attribute__((ext_vector_type(2))); typedef __bf16 bf16x2_t __attribute__((ext_vector_type(2)));
typedef unsigned u32x4 __attribute__((ext_vector_type(4)));
typedef unsigned u32x2 __attribute__((ext_vector_type(2)));
typedef float f32x4 __attribute__((ext_vector_type(4)));
#define GDI __device__ __forceinline__
#define GMFMA(a, b, c) __builtin_amdgcn_mfma_f32_32x32x16_bf16((a), (b), (c), 0, 0, 0)
GDI unsigned cvtpk(float lo, float hi) { f32x2_t v = {lo, hi}; bf16x2_t b = __builtin_convertvector(v, bf16x2_t); return __builtin_bit_cast(unsigned, b); }
GDI unsigned short cvt1(float x) { return (unsigned short)(cvtpk(x, 0.f) & 0xffffu); }
GDI constexpr int crow(int r, int hi) { return (r & 3) + 8 * (r >> 2) + 4 * hi; }
template <class T> GDI T* uni_ptr(T* p) { const unsigned long long u = (unsigned long long)p; const unsigned lo = __builtin_amdgcn_readfirstlane((unsigned)u), hi = __builtin_amdgcn_readfirstlane((unsigned)(u >> 32)); return (T*)(((unsigned long long)hi << 32) | lo); }
GDI float rdl(float v, int l) { return __builtin_bit_cast(float, __builtin_amdgcn_readlane(__builtin_bit_cast(int, v), l)); }
#define GDPP(x, ctrl, rmask) __builtin_bit_cast(float, __builtin_amdgcn_update_dpp(0, __builtin_bit_cast(int, (x)), (ctrl), (rmask), 0xF, false))
GDI float wsum(float v) {
    v += GDPP(v, 0xB1, 0xF); v += GDPP(v, 0x4E, 0xF); v += GDPP(v, 0x141, 0xF); v += GDPP(v, 0x140, 0xF);
    v += GDPP(v, 0x142, 0xA); v += GDPP(v, 0x143, 0xC);
    return rdl(v, 63);
}
constexpr int R_NEGW = 0, R_Q = 8192, R_INTRA = 16384, R_KT = 24576, R_U = 32768, R_SC = 49152, R_BYTES = 50176, R_TMP = 50176, R_STRIDE = 66560;
constexpr int NCH = 32, CH = 64, NIN_P = 3840, C_GQKV_ = 1536, C_B_ = 3584, C_A_ = 3592, SEQ_ = 2048;
GDI int frag_off(int R, int K) { return ((((R >> 5) * 4 + (K >> 4)) * 2 + ((K >> 2) & 1)) * 32 + (R & 31)) * 16 + ((((K >> 3) & 1) * 4) + (K & 3)) * 2; }
GDI int img_off(int row, int d) { return row * 128 + ((((d >> 3) ^ (row & 7))) << 4) + (d & 7) * 2; }
GDI bf16x8 img_frag(const GLAS unsigned char* img, int row0, int ks, int lane) {
    const int r = lane & 31, hh = lane >> 5, row = row0 + r;
    return *(const GLAS bf16x8*)(img + row * 128 + ((((2 * ks + hh) ^ (row & 7))) << 4));
}

GDI void pre_unit(int unit, const float* __restrict__ P, const float* __restrict__ convw, const float* __restrict__ alog, const float* __restrict__ dtb, unsigned char* __restrict__ rec_base, GLAS unsigned char* lw, int lane_in) {
    int lane = lane_in; asm volatile("" : "+v"(lane));
    const int bh = unit >> 5, c = unit & 31, b = bh >> 3, h = bh & 7;
    const int m0 = b * SEQ_ + c * CH;
    unsigned char* rec = uni_ptr(rec_base + (size_t)unit * R_STRIDE);
    GLAS unsigned char* q16 = lw; GLAS unsigned char* k16 = lw + 8192; GLAS float* AT = (GLAS float*)lw;
    float bt_v, gc_v, eg_v;
    {   const float* pr = P + (size_t)(m0 + lane) * NIN_P;
        const float aa = pr[C_A_ + h] + dtb[h], bb = pr[C_B_ + h];
        const float sp = (aa > 20.f) ? aa : log1pf(__expf(aa));
        const float g = -__expf(alog[h]) * sp;
        bt_v = 1.0f / (1.0f + __expf(-bb));
        float s = g;
#pragma unroll
        for (int o = 1; o < 64; o <<= 1) { const float t = __shfl_up(s, o); if (lane >= o) s += t; }
        gc_v = s; eg_v = __expf(gc_v);
        const float gcl = rdl(gc_v, 63);
        float* sc = (float*)(rec + R_SC);
        sc[lane] = eg_v; sc[64 + lane] = __expf(gcl - gc_v); if (lane == 0) sc[128] = __expf(gcl);
    }
    float W[64];
    float* ug = (float*)(rec + R_U); float* tg = (float*)(rec + R_TMP);
    {   const int ch = h * 64 + lane;
        float wq[4], wk[4], wv[4];
#pragma unroll
        for (int j = 0; j < 4; ++j) { wq[j] = convw[j * 1536 + ch]; wk[j] = convw[j * 1536 + 512 + ch]; wv[j] = convw[j * 1536 + 1024 + ch]; }
        const float* pbs = uni_ptr(P + (size_t)m0 * NIN_P + C_GQKV_ + h * 64 + 512);
        float q1 = 0.f, q2 = 0.f, q3 = 0.f, k1 = 0.f, k2 = 0.f, k3 = 0.f, v1 = 0.f, v2 = 0.f, v3 = 0.f;
        if (c > 0) { const float* p3 = pbs - 3 * NIN_P; const float* p2 = pbs - 2 * NIN_P; const float* p1 = pbs - NIN_P;
            q1 = p3[lane - 512]; k1 = p3[lane]; v1 = p3[lane + 512]; q2 = p2[lane - 512]; k2 = p2[lane]; v2 = p2[lane + 512]; q3 = p1[lane - 512]; k3 = p1[lane]; v3 = p1[lane + 512]; }
        float kwin[16];
#pragma unroll
        for (int t8 = 0; t8 < 64; t8 += 4) {
            asm volatile("" ::: "memory");
            float xq[4], xk[4], xv[4];
#pragma unroll
            for (int u = 0; u < 4; ++u) { const float* rp = pbs + (size_t)(t8 + u) * NIN_P; xq[u] = rp[lane - 512]; xk[u] = rp[lane]; xv[u] = rp[lane + 512]; }
#pragma unroll
            for (int u = 0; u < 4; ++u) { const int t = t8 + u;
                float cq = wq[0] * q1 + wq[1] * q2 + wq[2] * q3 + wq[3] * xq[u];
                float ck = wk[0] * k1 + wk[1] * k2 + wk[2] * k3 + wk[3] * xk[u];
                float cv = wv[0] * v1 + wv[1] * v2 + wv[2] * v3 + wv[3] * xv[u];
                q1 = q2; q2 = q3; q3 = xq[u]; k1 = k2; k2 = k3; k3 = xk[u]; v1 = v2; v2 = v3; v3 = xv[u];
                cq = cq / (1.0f + __expf(-cq)); ck = ck / (1.0f + __expf(-ck)); cv = cv / (1.0f + __expf(-cv));
                const float qn = wsum(cq * cq), kn = wsum(ck * ck);
                const float qv = cq * (1.0f / sqrtf(qn + 1e-6f)) * 0.125f, kv = ck * (1.0f / sqrtf(kn + 1e-6f));
                *(GLAS unsigned short*)(q16 + img_off(t, lane)) = cvt1(qv);
                *(GLAS unsigned short*)(k16 + img_off(t, lane)) = cvt1(kv);
                const float bt = rdl(bt_v, t), eg = rdl(eg_v, t);
                W[t] = bt * cv; { float* tb = uni_ptr(tg + (t >> 4) * 1024); tb[(t & 15) * 64 + lane] = bt * eg * kv; }
                kwin[t & 15] = kv;
                if ((t & 15) == 15) {
                    const int s = t >> 4, rt = lane >> 5, r = lane & 31;
                    u32x4 f0, f1;
                    f0.x = cvtpk(kwin[0], kwin[1]); f0.y = cvtpk(kwin[2], kwin[3]); f0.z = cvtpk(kwin[8], kwin[9]); f0.w = cvtpk(kwin[10], kwin[11]);
                    f1.x = cvtpk(kwin[4], kwin[5]); f1.y = cvtpk(kwin[6], kwin[7]); f1.z = cvtpk(kwin[12], kwin[13]); f1.w = cvtpk(kwin[14], kwin[15]);
                    *(u32x4*)(rec + R_KT + (((rt * 4 + s) * 2 + 0) * 32 + r) * 16) = f0;
                    *(u32x4*)(rec + R_KT + (((rt * 4 + s) * 2 + 1) * 32 + r) * 16) = f1;
                }
            }
        }
    }
    asm volatile("s_waitcnt lgkmcnt(0)" ::: "memory");
    const int r31 = lane & 31, hi = lane >> 5;
#pragma unroll
    for (int tile = 0; tile < 3; ++tile) { const int jt = (tile == 2) ? 1 : 0, it = (tile == 0) ? 0 : 1;
        f32x16 acc = {};
#pragma unroll
        for (int ks = 0; ks < 4; ++ks) acc = GMFMA(img_frag(k16, 32 * jt, ks, lane), img_frag(q16, 32 * it, ks, lane), acc);
        const int i = 32 * it + r31; const float gci = __shfl(gc_v, i);
        float vals[16];
#pragma unroll
        for (int rr = 0; rr < 16; ++rr) { const int j0 = 32 * jt + crow(rr, 0); const float gcj0 = rdl(gc_v, j0), gcj1 = rdl(gc_v, j0 + 4); const float gcj = hi ? gcj1 : gcj0; const int j = j0 + 4 * hi;
            vals[rr] = (i >= j) ? acc[rr] * __expf(gci - gcj) : 0.f; }
#pragma unroll
        for (int s = 0; s < 2; ++s) { u32x4 f; f.x = cvtpk(vals[8 * s], vals[8 * s + 1]); f.y = cvtpk(vals[8 * s + 2], vals[8 * s + 3]); f.z = cvtpk(vals[8 * s + 4], vals[8 * s + 5]); f.w = cvtpk(vals[8 * s + 6], vals[8 * s + 7]);
            *(u32x4*)(rec + R_INTRA + (((it * 4 + 2 * jt + s) * 2 + hi) * 32 + r31) * 16) = f; }
    }
#pragma unroll
    for (int rt = 0; rt < 2; ++rt)
#pragma unroll
        for (int ks = 0; ks < 4; ++ks) { const int row = 32 * rt + r31;
            const u32x2 lo = *(const GLAS u32x2*)(q16 + row * 128 + ((((2 * ks) ^ (row & 7))) << 4) + 8 * hi), hh = *(const GLAS u32x2*)(q16 + row * 128 + ((((2 * ks + 1) ^ (row & 7))) << 4) + 8 * hi);
            u32x4 f; f.x = lo.x; f.y = lo.y; f.z = hh.x; f.w = hh.y;
            *(u32x4*)(rec + R_Q + (((rt * 4 + ks) * 2 + hi) * 32 + r31) * 16) = f; }
    {   const float gc_lo = __shfl(gc_v, r31), gc_hi2 = __shfl(gc_v, 32 + r31), bt_lo = __shfl(bt_v, r31), bt_hi2 = __shfl(bt_v, 32 + r31);
        asm volatile("s_waitcnt lgkmcnt(0)" ::: "memory");
        {   f32x16 d00 = {}, d01 = {};
#pragma unroll
            for (int ks = 0; ks < 4; ++ks) { const bf16x8 f0 = img_frag(k16, 0, ks, lane), f1 = img_frag(k16, 32, ks, lane); d00 = GMFMA(f0, f0, d00); d01 = GMFMA(f0, f1, d01); }
#pragma unroll
            for (int rr = 0; rr < 16; ++rr) { const int i0 = crow(rr, 0); const float gci0 = rdl(gc_v, i0), gci1 = rdl(gc_v, i0 + 4); const float gci = hi ? gci1 : gci0; const int ia = i0 + 4 * hi;
                AT[ia * 64 + r31] = (r31 > ia) ? bt_lo * d00[rr] * __expf(gc_lo - gci) : 0.f;
                AT[ia * 64 + 32 + r31] = bt_hi2 * d01[rr] * __expf(gc_hi2 - gci); } }
        {   f32x16 d11 = {};
#pragma unroll
            for (int ks = 0; ks < 4; ++ks) { const bf16x8 f1 = img_frag(k16, 32, ks, lane); d11 = GMFMA(f1, f1, d11); }
            asm volatile("s_waitcnt lgkmcnt(0)" ::: "memory");
#pragma unroll
            for (int rr = 0; rr < 16; ++rr) { const int i0 = crow(rr, 0); const float gci0 = rdl(gc_v, 32 + i0), gci1 = rdl(gc_v, 32 + i0 + 4); const float gci = hi ? gci1 : gci0; const int ib = 32 + i0 + 4 * hi;
                AT[ib * 64 + 32 + r31] = (32 + r31 > ib) ? bt_hi2 * d11[rr] * __expf(gc_hi2 - gci) : 0.f; } }
    }
    asm volatile("s_waitcnt lgkmcnt(0)" ::: "memory");
#define GSUBST(X, ATP) _Pragma("unroll") for (int i = 0; i < 63; ++i) { unsigned ao_ = (unsigned)(i * 256); asm volatile("" : "+v"(ao_) : "v"(X[i]));     \
        _Pragma("unroll") for (int q4 = (i + 1) >> 2; q4 < 16; ++q4) { \
        const f32x4 a = *(const GLAS f32x4*)((const GLAS unsigned char*)(ATP) + ao_ + 16 * q4); \
        _Pragma("unroll") for (int e = 0; e < 4; ++e) { const int ip = 4 * q4 + e; if (ip > i) X[ip] = fmaf(-a[e], X[i], X[ip]); } } }
#pragma unroll 1
    for (int pass = 0; pass < 2; ++pass) {
        GSUBST(W, AT)
        if (pass == 0) {
#pragma unroll
            for (int i = 0; i < 64; ++i) { float* ub = uni_ptr(ug + (i >> 4) * 1024); ub[(i & 15) * 64 + lane] = W[i]; }
            asm volatile("s_waitcnt vmcnt(0)" ::: "memory");
#pragma unroll
            for (int i = 0; i < 64; ++i) { const float* tb = uni_ptr(tg + (i >> 4) * 1024); W[i] = tb[(i & 15) * 64 + lane]; }
        }
    }
#undef GSUBST
    {   asm volatile("s_waitcnt lgkmcnt(0)" ::: "memory");
#pragma unroll
        for (int i = 0; i < 64; ++i) *(GLAS unsigned short*)(lw + frag_off(i, lane)) = cvt1(-W[i]);
        asm volatile("s_waitcnt lgkmcnt(0)" ::: "memory");
#pragma unroll
        for (int x = 0; x < 8; ++x) *(u32x4*)(rec + R_NEGW + x * 1024 + lane * 16) = *(const GLAS u32x4*)(lw + x * 1024 + lane * 16);
        asm volatile("s_waitcnt lgkmcnt(0)" ::: "memory");
    }
}

GDI void scan_wg(int bh, const unsigned char* __restrict__ rec_base, float* __restrict__ GO, float* __restrict__ sg_out, GLAS unsigned char* lds, int tid_in) {
    int tid = tid_in; asm volatile("" : "+v"(tid));
    const int wave = __builtin_amdgcn_readfirstlane(tid >> 6), lane = tid & 63, r31 = lane & 31, hi = lane >> 5;
    const int b = bh >> 3, h = bh & 7;
    const unsigned char* rec0 = rec_base + (size_t)bh * NCH * R_STRIDE;
    __syncthreads();
    for (int x = tid; x < R_BYTES / 16; x += 512) *(GLAS u32x4*)(lds + x * 16) = *(const u32x4*)(rec0 + (size_t)x * 16);
    __syncthreads();
    f32x16 S0 = {}, S1 = {};
    for (int c = 0; c < NCH; ++c) {
        GLAS unsigned char* buf = lds + (c & 1) * R_BYTES;
        if (wave >= 2) {
            if (c + 1 < NCH) { const unsigned char* src = rec0 + (size_t)(c + 1) * R_STRIDE; GLAS unsigned char* dst = lds + ((c + 1) & 1) * R_BYTES;
                for (int x = tid - 128; x < R_BYTES / 16; x += 384) *(GLAS u32x4*)(dst + x * 16) = *(const u32x4*)(src + (size_t)x * 16); }
        } else {
            const int dv = 32 * wave + r31;
            const GLAS float* sc = (const GLAS float*)(buf + R_SC);
            const float gl = sc[128];
#define GFRAG(base, rt, ks) (*(const GLAS bf16x8*)(buf + (base) + ((((rt) * 4 + (ks)) * 2 + hi) * 32 + r31) * 16))
            bf16x8 sb[4];
#pragma unroll
            for (int s = 0; s < 2; ++s) { u32x4 f; f.x = cvtpk(S0[8 * s], S0[8 * s + 1]); f.y = cvtpk(S0[8 * s + 2], S0[8 * s + 3]); f.z = cvtpk(S0[8 * s + 4], S0[8 * s + 5]); f.w = cvtpk(S0[8 * s + 6], S0[8 * s + 7]); sb[s] = __builtin_bit_cast(bf16x8, f);
                u32x4 g; g.x = cvtpk(S1[8 * s], S1[8 * s + 1]); g.y = cvtpk(S1[8 * s + 2], S1[8 * s + 3]); g.z = cvtpk(S1[8 * s + 4], S1[8 * s + 5]); g.w = cvtpk(S1[8 * s + 6], S1[8 * s + 7]); sb[2 + s] = __builtin_bit_cast(bf16x8, g); }
            f32x16 vn[2], x2[2];
            const GLAS float* ul = (const GLAS float*)(buf + R_U);
#pragma unroll
            for (int ct = 0; ct < 2; ++ct) {
#pragma unroll
                for (int rr = 0; rr < 16; ++rr) vn[ct][rr] = ul[(32 * ct + crow(rr, 0) + 4 * hi) * 64 + dv];
                x2[ct] = f32x16{};
#pragma unroll
                for (int ks = 0; ks < 4; ++ks) { vn[ct] = GMFMA(GFRAG(R_NEGW, ct, ks), sb[ks], vn[ct]); x2[ct] = GMFMA(GFRAG(R_Q, ct, ks), sb[ks], x2[ct]); }
            }
            bf16x8 vb[4], vs[4];
#pragma unroll
            for (int ct = 0; ct < 2; ++ct) {
                float sv[16];
#pragma unroll
                for (int rr = 0; rr < 16; ++rr) { const int row = 32 * ct + crow(rr, 0) + 4 * hi; sv[rr] = vn[ct][rr] * sc[64 + row]; x2[ct][rr] *= sc[row]; }
#pragma unroll
                for (int s = 0; s < 2; ++s) { u32x4 f; f.x = cvtpk(vn[ct][8 * s], vn[ct][8 * s + 1]); f.y = cvtpk(vn[ct][8 * s + 2], vn[ct][8 * s + 3]); f.z = cvtpk(vn[ct][8 * s + 4], vn[ct][8 * s + 5]); f.w = cvtpk(vn[ct][8 * s + 6], vn[ct][8 * s + 7]); vb[2 * ct + s] = __builtin_bit_cast(bf16x8, f);
                    u32x4 g; g.x = cvtpk(sv[8 * s], sv[8 * s + 1]); g.y = cvtpk(sv[8 * s + 2], sv[8 * s + 3]); g.z = cvtpk(sv[8 * s + 4], sv[8 * s + 5]); g.w = cvtpk(sv[8 * s + 6], sv[8 * s + 7]); vs[2 * ct + s] = __builtin_bit_cast(bf16x8, g); }
            }
            x2[0] = GMFMA(GFRAG(R_INTRA, 0, 0), vb[0], x2[0]); x2[0] = GMFMA(GFRAG(R_INTRA, 0, 1), vb[1], x2[0]);
#pragma unroll
            for (int ks = 0; ks < 4; ++ks) x2[1] = GMFMA(GFRAG(R_INTRA, 1, ks), vb[ks], x2[1]);
#pragma unroll
            for (int rr = 0; rr < 16; ++rr) { S0[rr] *= gl; S1[rr] *= gl; }
#pragma unroll
            for (int ks = 0; ks < 4; ++ks) { S0 = GMFMA(GFRAG(R_KT, 0, ks), vs[ks], S0); S1 = GMFMA(GFRAG(R_KT, 1, ks), vs[ks], S1); }
#undef GFRAG
            float* go = GO + (size_t)(b * SEQ_ + c * CH) * 512 + h * 64 + dv;
#pragma unroll
            for (int ct = 0; ct < 2; ++ct)
#pragma unroll
                for (int rr = 0; rr < 16; ++rr) go[(size_t)(32 * ct + crow(rr, 0) + 4 * hi) * 512] = x2[ct][rr];
        }
        __syncthreads();
    }
    if (wave < 2) { float* so = sg_out + (size_t)bh * 4096 + 32 * wave + r31;
#pragma unroll
        for (int rr = 0; rr < 16; ++rr) { so[(crow(rr, 0) + 4 * hi) * 64] = S0[rr]; so[(32 + crow(rr, 0) + 4 * hi) * 64] = S1[rr]; } }
}
#undef GMFMA
#undef GDI
}

constexpr int NWAVES = 8;
constexpr int DM = 1024, NB = 8, SEQ = 2048, DB = 128, DS = 4;
constexpr int MP = NB * SEQ, MS = DB * DS, M = MP + MS;
constexpr int FF = 2816, NGU = 2 * FF, NIN = 3600, NINP = 3840;
constexpr int NH = 8, HD = 64, AW = 512, GW = 512;
constexpr int C_AQ = 0, C_AK = 512, C_AV = 1024, C_GQKV = 1536, C_Z = 3072, C_B = 3584, C_A = 3592;
constexpr float LN_EPS = 1e-5f, RMS_EPS = 1e-6f, ALPHA = 1.189207115002721f;
constexpr size_t O_YP = 0, O_YS = 16777216, O_KP = 17301504, O_VP = 25690112, O_SGP = 34078720, O_SCP = 34340864, O_KS = 34377728, O_VS = 34639872, O_SGS = 34902016, O_SCS = 39096320, O_END = 39686144;
constexpr size_t MiB = 1u << 20;
constexpr size_t WS_CTL = 0, CTL_ZERO_BYTES = 1 * MiB, WS_WGU1 = 1 * MiB, WS_WD1 = 13 * MiB, WS_WIN = 19 * MiB, WS_WOUT = 27 * MiB, WS_WGU2 = 29 * MiB, WS_WD2 = 41 * MiB;
constexpr size_t WS_XB = 48 * MiB, WS_H = 82 * MiB, WS_T = 174 * MiB, WS_X1 = 240 * MiB, WS_X1B = 306 * MiB, WS_P = 340 * MiB, WS_HEADS = 588 * MiB;
constexpr size_t WS_GQ = 622 * MiB, WS_GK = 655 * MiB, WS_GV = 688 * MiB, WS_GG = 721 * MiB, WS_GB = 722 * MiB, WS_GO = 723 * MiB, WS_X2 = 756 * MiB, WS_X2B = 822 * MiB, WS_QB = 856 * MiB, WS_KB = 872 * MiB, WS_VB = 888 * MiB, WS_REC = 904 * MiB, WS_END = 1036 * MiB;
constexpr int CW_BAR = 4096;
constexpr int RING_OFF = 0, RING_BYTES = 131072, LDSCTL_OFF = RING_BYTES, MISC_OFF = LDSCTL_OFF + 320, LDS_BYTES = 147456;

struct Args { const float* in[25]; float* out; unsigned char* ws; };

__device__ __forceinline__ float wave_sum(float v) {
#pragma unroll
    for (int o = 1; o < 64; o <<= 1) v += __shfl_xor(v, o);
    return v;
}
__device__ __forceinline__ float wave_max(float v) {
#pragma unroll
    for (int o = 1; o < 64; o <<= 1) v = fmaxf(v, __shfl_xor(v, o));
    return v;
}
__device__ __forceinline__ int t5_bucket(int n) {
    if (n < 16) return n;
    int b = 16;
    b += (n >= 22); b += (n >= 30); b += (n >= 40); b += (n >= 54); b += (n >= 73); b += (n >= 99); b += (n >= 134); b += (n >= 182);
    b += (n >= 246); b += (n >= 332); b += (n >= 450); b += (n >= 609); b += (n >= 825); b += (n >= 1117); b += (n >= 1513);
    return b;
}
__device__ __forceinline__ unsigned long long pk4(f32x4 v) { return (unsigned long long)pk2(v.x, v.y) | ((unsigned long long)pk2(v.z, v.w) << 32); }

__device__ __forceinline__ void p0_transpose_item(const float* W0, const float* W1, int K, int Nsrc, int Nd, int mode, bf16* WT, LAS float* scr, int item, int lane) {
    const int nblk = Nd / 32, kb = item / nblk, nb = item % nblk, k0 = 64 * kb, n0 = 32 * nb;
    const float* src = W0; int c0 = n0;
    if (mode == 1) { const int t = n0 / 256, w = n0 % 256; src = (w < 128) ? W0 : W1; c0 = t * 128 + (w & 127); }
    const bool okc = (c0 + (lane & 31)) < Nsrc;
#pragma unroll 8
    for (int i = 0; i < 32; ++i) { const int kk = 2 * i + (lane >> 5); scr[kk * 33 + (lane & 31)] = okc ? src[(size_t)(k0 + kk) * Nsrc + c0 + (lane & 31)] : 0.f; }
    LDS_WAIT(); asm volatile("" ::: "memory");
    const int c = lane & 7;
#pragma unroll
    for (int j = 0; j < 4; ++j) { const int n = (lane >> 3) + 8 * j; const LAS float* s = scr + (8 * c) * 33 + n;
        v4u o; o.x = pk2(s[0 * 33], s[1 * 33]); o.y = pk2(s[2 * 33], s[3 * 33]); o.z = pk2(s[4 * 33], s[5 * 33]); o.w = pk2(s[6 * 33], s[7 * 33]);
        *(GAS v4u*)(WT + (size_t)(n0 + n) * K + k0 + 8 * c) = o; }
    LDS_WAIT(); asm volatile("" ::: "memory");
}
__device__ __forceinline__ void p_transpose(const float* W0, const float* W1, int K, int Nsrc, int Nd, int mode, bf16* WT, LAS float* scr, int gw, int NGW, int lane) {
    const int nitems = (K / 64) * (Nd / 32);
    for (int it = gw; it < nitems; it += NGW) p0_transpose_item(W0, W1, K, Nsrc, Nd, mode, WT, scr, it, lane);
}
__device__ __forceinline__ void p_cvt_x(const float* xp, const float* xs, bf16* xb, int gw, int NGW, int lane) {
    for (int m = gw; m < M; m += NGW) { const float* s = (m < MP) ? xp + (size_t)m * DM : xs + (size_t)(m - MP) * DM;
#pragma unroll
        for (int j = 0; j < 4; ++j) { const f32x4 v = *(const f32x4*)(s + j * 256 + lane * 4); *(unsigned long long*)(xb + (size_t)m * DM + j * 256 + lane * 4) = pk4(v); } }
}
__device__ __forceinline__ void p_ln(const float* r0, const float* r1, const float* t, float s, const float* g, const float* b, float* o0, float* o1, bf16* ob, int gw, int NGW, int lane) {
    for (int m = gw; m < M; m += NGW) {
        const float* rr = (m < MP) ? r0 + (size_t)m * DM : r1 + (size_t)(m - MP) * DM;
        const float* tt = t + (size_t)m * DM;
        f32x4 v[4]; float sum = 0.f;
#pragma unroll
        for (int j = 0; j < 4; ++j) { const f32x4 a = *(const f32x4*)(rr + j * 256 + lane * 4), c = *(const f32x4*)(tt + j * 256 + lane * 4); v[j] = a * ALPHA + c * s; sum += (v[j].x + v[j].y) + (v[j].z + v[j].w); }
        const float mean = wave_sum(sum) * (1.f / DM); float s2 = 0.f;
#pragma unroll
        for (int j = 0; j < 4; ++j) { v[j] = v[j] - mean; s2 += (v[j].x * v[j].x + v[j].y * v[j].y) + (v[j].z * v[j].z + v[j].w * v[j].w); }
        const float rstd = 1.0f / sqrtf(wave_sum(s2) * (1.f / DM) + LN_EPS);
        float* oo = (m < MP) ? o0 + (size_t)m * DM : o1 + (size_t)(m - MP) * DM;
#pragma unroll
        for (int j = 0; j < 4; ++j) { const f32x4 gg = *(const f32x4*)(g + j * 256 + lane * 4), bb = *(const f32x4*)(b + j * 256 + lane * 4); const f32x4 y = v[j] * rstd * gg + bb;
            *(f32x4*)(oo + j * 256 + lane * 4) = y;
            if (ob) *(unsigned long long*)(ob + (size_t)m * DM + j * 256 + lane * 4) = pk4(y); }
    }
}
__device__ __forceinline__ void p_copy_out(const float* P, float* out, bf16* Qb, bf16* Kb, bf16* Vb, int gw, int NGW, int lane) {
    for (int m = gw; m < M; m += NGW) {
        const float* pr = P + (size_t)m * NINP;
        if (m < MP) {
#pragma unroll
            for (int j = 0; j < 2; ++j) { const int c = j * 256 + lane * 4; *(unsigned long long*)(Qb + (size_t)m * AW + c) = pk4(*(const f32x4*)(pr + C_AQ + c) * attn_body::C2);
                *(unsigned long long*)(Kb + (size_t)m * AW + c) = pk4(*(const f32x4*)(pr + C_AK + c)); *(unsigned long long*)(Vb + (size_t)m * AW + c) = pk4(*(const f32x4*)(pr + C_AV + c)); } }
        float* kd; float* vd;
        if (m < MP) { kd = out + O_KP + (size_t)m * AW; vd = out + O_VP + (size_t)m * AW; } else { kd = out + O_KS + (size_t)(m - MP) * AW; vd = out + O_VS + (size_t)(m - MP) * AW; }
#pragma unroll
        for (int j = 0; j < 2; ++j) { *(f32x4*)(kd + j * 256 + lane * 4) = *(const f32x4*)(pr + C_AK + j * 256 + lane * 4); *(f32x4*)(vd + j * 256 + lane * 4) = *(const f32x4*)(pr + C_AV + j * 256 + lane * 4); }
        float* sd = nullptr;
        if (m < MP) { const int b = m / SEQ, t = m % SEQ; if (t >= SEQ - 3) sd = out + O_SCP + ((size_t)b * 3 + (t - (SEQ - 3))) * 1536; }
        else { const int b = (m - MP) / DS, t = (m - MP) % DS; if (t >= 1) sd = out + O_SCS + ((size_t)b * 3 + (t - 1)) * 1536; }
        if (sd) {
#pragma unroll
            for (int j = 0; j < 6; ++j) *(f32x4*)(sd + j * 256 + lane * 4) = *(const f32x4*)(pr + C_GQKV + j * 256 + lane * 4); }
    }
}
__device__ __forceinline__ void p_attn_simple(const float* P, const float* ck, const float* cv, const float* relb, bf16* heads, LAS float* lds, int m0, int vcu, int G, int h, int lane) {
    LAS float* sq = lds + h * 64; LAS float* sp = lds + 8 * 64 + h * 392;
    for (int m = m0 + vcu; m < M; m += G) {
        const bool samp = m >= MP; int b, p;
        if (!samp) { b = m / SEQ; p = m % SEQ; } else { b = (m - MP) / DS; p = SEQ + (m - MP) % DS; }
        sq[lane] = P[(size_t)m * NINP + C_AQ + h * 64 + lane] * 0.125f;
        LDS_WAIT(); asm volatile("" ::: "memory");
        float lg[7]; float mx = -INFINITY;
#pragma unroll
        for (int i = 0; i < 7; ++i) {
            const int e = i * 64 + lane; float v = -INFINITY;
            if (e < 387) { const int g = e / 129, j = e % 129, dil = (g == 0) ? 1 : (g == 1 ? 4 : 16), delta = j * dil, pos = p - delta;
                if (pos >= 0) {
                    const float* kp;
                    if (!samp) kp = P + (size_t)(b * SEQ + pos) * NINP + C_AK + h * 64;
                    else if (pos >= SEQ) kp = P + (size_t)(MP + b * DS + (pos - SEQ)) * NINP + C_AK + h * 64;
                    else kp = ck + (((size_t)b * SEQ + pos) * NH + h) * HD;
                    float acc = 0.f;
#pragma unroll
                    for (int d = 0; d < 64; d += 4) { const f32x4 kv = *(const f32x4*)(kp + d); acc += kv.x * sq[d] + kv.y * sq[d + 1] + kv.z * sq[d + 2] + kv.w * sq[d + 3]; }
                    v = acc + relb[t5_bucket(delta) * NH + h]; } }
            lg[i] = v; mx = fmaxf(mx, v); }
        mx = wave_max(mx);
        float sum = 0.f;
#pragma unroll
        for (int i = 0; i < 7; ++i) { const int e = i * 64 + lane; const float pe = (lg[i] == -INFINITY) ? 0.f : __expf(lg[i] - mx); if (e < 387) sp[e] = pe; sum += pe; }
        sum = wave_sum(sum);
        LDS_WAIT(); asm volatile("" ::: "memory");
        float o = 0.f;
        for (int e = 0; e < 387; ++e) { const float pe = sp[e]; if (pe == 0.f) continue;
            const int g = e / 129, j = e % 129, dil = (g == 0) ? 1 : (g == 1 ? 4 : 16), pos = p - j * dil;
            const float* vp;
            if (!samp) vp = P + (size_t)(b * SEQ + pos) * NINP + C_AV + h * 64;
            else if (pos >= SEQ) vp = P + (size_t)(MP + b * DS + (pos - SEQ)) * NINP + C_AV + h * 64;
            else vp = cv + (((size_t)b * SEQ + pos) * NH + h) * HD;
            o += pe * vp[lane]; }
        heads[(size_t)m * DM + h * 64 + lane] = (bf16)f2bf(o / sum);
        LDS_WAIT(); asm volatile("" ::: "memory");
    }
}
#define SDPP(x, ctrl) __builtin_bit_cast(float, __builtin_amdgcn_update_dpp(0, __builtin_bit_cast(int, (x)), (ctrl), 0xF, 0xF, false))
__device__ __forceinline__ void p_attn_sample(const float* P, const float* ck, const float* cv, const float* relb, bf16* heads, LAS float* lgs  , int gw, int NGW, int lane_in) {
    int lane = lane_in; asm volatile("" : "+v"(lane));
    const int g = lane >> 3, c = lane & 7;
    for (int task = gw; task < MS * NH; task += NGW) {
        const int sr = task >> 3, h = task & 7, b = sr >> 2, t = sr & 3, m = MP + sr, p = SEQ + t;
        f32x4 q0 = *(const f32x4*)(P + (size_t)m * NINP + C_AQ + h * 64 + 8 * c), q1 = *(const f32x4*)(P + (size_t)m * NINP + C_AQ + h * 64 + 8 * c + 4);
        q0 = q0 * 0.125f; q1 = q1 * 0.125f;
        const float* knew = P + (size_t)(MP + b * DS) * NINP + C_AK + h * 64 + 8 * c; const float* kold = ck + ((size_t)b * SEQ * NH + h) * HD + 8 * c;
        float mx = -INFINITY;
#pragma unroll 7
        for (int it = 0; it < 49; ++it) {
            const int e = it * 8 + g; const int ee = e < 387 ? e : 386;
            const int pat = (ee >= 258) ? 2 : (ee >= 129 ? 1 : 0), j = ee - pat * 129, delta = j << (2 * pat), pos = p - delta;
            const float* kp = (pos >= SEQ) ? knew + (size_t)(pos - SEQ) * NINP : kold + (size_t)pos * (NH * HD);
            const f32x4 k0 = *(const f32x4*)kp, k1 = *(const f32x4*)(kp + 4);
            float d = (k0.x * q0.x + k0.y * q0.y) + (k0.z * q0.z + k0.w * q0.w) + (k1.x * q1.x + k1.y * q1.y) + (k1.z * q1.z + k1.w * q1.w);
            d += SDPP(d, 0xB1); d += SDPP(d, 0x4E); d += SDPP(d, 0x141);
            const float v = (e < 387) ? d + relb[t5_bucket(delta) * NH + h] : -INFINITY;
            if (c == 0) lgs[it * 8 + g] = v;
            mx = fmaxf(mx, v); }
        mx = fmaxf(mx, __shfl_xor(mx, 8)); mx = fmaxf(mx, __shfl_xor(mx, 16)); mx = fmaxf(mx, __shfl_xor(mx, 32));
        LDS_WAIT(); asm volatile("" ::: "memory");
        const float* vnew = knew + (C_AV - C_AK); const float* vold = cv + ((size_t)b * SEQ * NH + h) * HD + 8 * c;
        float sum = 0.f; float acc[8];
#pragma unroll
        for (int j = 0; j < 8; ++j) acc[j] = 0.f;
#pragma unroll 7
        for (int it = 0; it < 49; ++it) {
            const int e = it * 8 + g; const int ee = e < 387 ? e : 386;
            const int pat = (ee >= 258) ? 2 : (ee >= 129 ? 1 : 0), j = ee - pat * 129, delta = j << (2 * pat), pos = p - delta;
            const float* vp = (pos >= SEQ) ? vnew + (size_t)(pos - SEQ) * NINP : vold + (size_t)pos * (NH * HD);
            const f32x4 v0 = *(const f32x4*)vp, v1 = *(const f32x4*)(vp + 4);
            const float pe = __expf(lgs[it * 8 + g] - mx); sum += pe;
            acc[0] += pe * v0.x; acc[1] += pe * v0.y; acc[2] += pe * v0.z; acc[3] += pe * v0.w; acc[4] += pe * v1.x; acc[5] += pe * v1.y; acc[6] += pe * v1.z; acc[7] += pe * v1.w; }
        sum += __shfl_xor(sum, 8); sum += __shfl_xor(sum, 16); sum += __shfl_xor(sum, 32);
#pragma unroll
        for (int j = 0; j < 8; ++j) { acc[j] += __shfl_xor(acc[j], 8); acc[j] += __shfl_xor(acc[j], 16); acc[j] += __shfl_xor(acc[j], 32); }
        if (g == 0) { const float inv = 1.0f / sum; v4u o; o.x = pk2(acc[0] * inv, acc[1] * inv); o.y = pk2(acc[2] * inv, acc[3] * inv); o.z = pk2(acc[4] * inv, acc[5] * inv); o.w = pk2(acc[6] * inv, acc[7] * inv);
            *(v4u*)(heads + (size_t)m * DM + h * 64 + 8 * c) = o; }
        LDS_WAIT(); asm volatile("" ::: "memory");
    }
}
__device__ __forceinline__ void p_gdn_prep(const float* P, const float* sconv, const float* convw, const float* alog, const float* dtb, float* GQ, float* GK, float* GV, float* GG, float* GB, int m0, int vcu, int G, int h, int lane) {
    for (int m = m0 + vcu; m < M; m += G) {
        const bool samp = m >= MP; int b, t;
        if (!samp) { b = m / SEQ; t = m % SEQ; } else { b = (m - MP) / DS; t = (m - MP) % DS; }
        float r[3];
#pragma unroll
        for (int part = 0; part < 3; ++part) {
            const int c = part * 512 + h * 64 + lane; float acc = 0.f;
#pragma unroll
            for (int j = 0; j < 4; ++j) { const int tt = t - 3 + j; float x;
                if (tt >= 0) x = P[(size_t)(m - t + tt) * NINP + C_GQKV + c]; else x = samp ? sconv[((size_t)b * 3 + (tt + 3)) * 1536 + c] : 0.f;
                acc += x * convw[j * 1536 + c]; }
            r[part] = acc / (1.0f + __expf(-acc)); }
        const float qn = wave_sum(r[0] * r[0]), kn = wave_sum(r[1] * r[1]);
        GQ[(size_t)m * GW + h * 64 + lane] = r[0] * (1.0f / sqrtf(qn + RMS_EPS)) * 0.125f;
        GK[(size_t)m * GW + h * 64 + lane] = r[1] * (1.0f / sqrtf(kn + RMS_EPS));
        GV[(size_t)m * GW + h * 64 + lane] = r[2];
        if (lane == 0) { const float bb = P[(size_t)m * NINP + C_B + h], aa = P[(size_t)m * NINP + C_A + h] + dtb[h];
            GB[(size_t)m * NH + h] = 1.0f / (1.0f + __expf(-bb));
            const float sp = (aa > 20.f) ? aa : log1pf(__expf(aa));
            GG[(size_t)m * NH + h] = -__expf(alog[h]) * sp; }
    }
}
__device__ __forceinline__ void gdn_scan_task(int task, const float* GQ, const float* GK, const float* GV, const float* GG, const float* GB, const float* s0, const float* P, const float* nw, bf16* heads, float* out, int lane) {
    const int seq = task / NH, h = task % NH;
    float S[64]; int row0, L; float* sdst;
    if (seq < NB) { row0 = seq * SEQ; L = SEQ; sdst = out + O_SGP + ((size_t)seq * NH + h) * 4096;
#pragma unroll
        for (int d = 0; d < 64; ++d) S[d] = 0.f; }
    else { const int b = seq - NB; row0 = MP + b * DS; L = DS; sdst = out + O_SGS + ((size_t)b * NH + h) * 4096; const float* sp = s0 + ((size_t)b * NH + h) * 4096;
#pragma unroll
        for (int d = 0; d < 64; ++d) S[d] = sp[d * 64 + lane]; }
    const float nwl = nw[lane];
    size_t o = (size_t)row0 * GW + h * 64 + lane;
    float qn = GQ[o], kn = GK[o], vn = GV[o], gn = GG[(size_t)row0 * NH + h], bn = GB[(size_t)row0 * NH + h], zn = P[(size_t)row0 * NINP + C_Z + h * 64 + lane];
    for (int t = 0; t < L; ++t) {
        const float qv = qn, kv = kn, vv = vn, eg = __expf(gn), beta = bn, z = zn; const int m = row0 + t;
        if (t + 1 < L) { o += GW; qn = GQ[o]; kn = GK[o]; vn = GV[o]; gn = GG[(size_t)(m + 1) * NH + h]; bn = GB[(size_t)(m + 1) * NH + h]; zn = P[(size_t)(m + 1) * NINP + C_Z + h * 64 + lane]; }
        float k0 = 0.f, k1 = 0.f, k2 = 0.f, k3 = 0.f;
#pragma unroll
        for (int d = 0; d < 64; d += 4) {
            k0 += __builtin_bit_cast(float, __builtin_amdgcn_readlane(__builtin_bit_cast(int, kv), d)) * S[d];
            k1 += __builtin_bit_cast(float, __builtin_amdgcn_readlane(__builtin_bit_cast(int, kv), d + 1)) * S[d + 1];
            k2 += __builtin_bit_cast(float, __builtin_amdgcn_readlane(__builtin_bit_cast(int, kv), d + 2)) * S[d + 2];
            k3 += __builtin_bit_cast(float, __builtin_amdgcn_readlane(__builtin_bit_cast(int, kv), d + 3)) * S[d + 3]; }
        const float ks = (k0 + k1) + (k2 + k3);
        const float c = beta * (vv - eg * ks);
        float o0 = 0.f, o1 = 0.f, o2 = 0.f, o3 = 0.f;
#pragma unroll
        for (int d = 0; d < 64; d += 4) {
#pragma unroll
            for (int e = 0; e < 4; ++e) { const float kd = __builtin_bit_cast(float, __builtin_amdgcn_readlane(__builtin_bit_cast(int, kv), d + e)); S[d + e] = fmaf(kd, c, eg * S[d + e]); }
            o0 += __builtin_bit_cast(float, __builtin_amdgcn_readlane(__builtin_bit_cast(int, qv), d)) * S[d];
            o1 += __builtin_bit_cast(float, __builtin_amdgcn_readlane(__builtin_bit_cast(int, qv), d + 1)) * S[d + 1];
            o2 += __builtin_bit_cast(float, __builtin_amdgcn_readlane(__builtin_bit_cast(int, qv), d + 2)) * S[d + 2];
            o3 += __builtin_bit_cast(float, __builtin_amdgcn_readlane(__builtin_bit_cast(int, qv), d + 3)) * S[d + 3]; }
        const float ov = (o0 + o1) + (o2 + o3);
        const float ms = wave_sum(ov * ov) * (1.f / 64.f);
        const float y = ov * (1.0f / sqrtf(ms + RMS_EPS)) * nwl * (z / (1.0f + __expf(-z)));
        heads[(size_t)m * DM + AW + h * 64 + lane] = (bf16)f2bf(y);
    }
#pragma unroll
    for (int d = 0; d < 64; ++d) sdst[d * 64 + lane] = S[d];
}

__device__ __forceinline__ void p_gdn_out(const float* GO, const float* P, const float* nw, bf16* heads, int gw, int NGW, int lane) {
    const float nwl = nw[lane];
    for (int m = gw; m < MP; m += NGW) {
#pragma unroll
        for (int h = 0; h < NH; ++h) { const float o = GO[(size_t)m * GW + h * 64 + lane]; const float ms = wave_sum(o * o) * (1.f / 64.f); const float z = P[(size_t)m * NINP + C_Z + h * 64 + lane];
            heads[(size_t)m * DM + AW + h * 64 + lane] = (bf16)f2bf(o * (1.0f / sqrtf(ms + RMS_EPS)) * nwl * (z / (1.0f + __expf(-z)))); }
    }
}
typedef float f32x4m __attribute__((ext_vector_type(4)));
__device__ __forceinline__ void thin_gemm(const bf16* A, const bf16* Bt, int K, float* out, int ldo, LAS float* red, int vcu, int G, int tid_in) {
    int tid = tid_in; asm volatile("" : "+v"(tid));
    const int wave = __builtin_amdgcn_readfirstlane(tid >> 6), lane = tid & 63, r = lane & 15, kq = lane >> 4;
    const int kper = K >> 3, steps = kper >> 5;
    for (int tile = vcu; tile < 256; tile += G) {
        const int tm = tile >> 4, tn = tile & 15;
        const bf16* ap = A + (size_t)(32 * tm + r) * K + wave * kper + 8 * kq;
        const bf16* bp = Bt + (size_t)(64 * tn + r) * K + wave * kper + 8 * kq;
        f32x4m acc[2][4];
#pragma unroll
        for (int i = 0; i < 2; ++i)
#pragma unroll
            for (int j = 0; j < 4; ++j) acc[i][j] = (f32x4m){0.f, 0.f, 0.f, 0.f};
#pragma unroll 2
        for (int s = 0; s < steps; ++s) {
            const bf16x8 a0 = *(const bf16x8*)(ap + 32 * s), a1 = *(const bf16x8*)(ap + (size_t)16 * K + 32 * s);
            bf16x8 b[4];
#pragma unroll
            for (int j = 0; j < 4; ++j) b[j] = *(const bf16x8*)(bp + (size_t)(16 * j) * K + 32 * s);
#pragma unroll
            for (int j = 0; j < 4; ++j) { acc[0][j] = __builtin_amdgcn_mfma_f32_16x16x32_bf16(a0, b[j], acc[0][j], 0, 0, 0); acc[1][j] = __builtin_amdgcn_mfma_f32_16x16x32_bf16(a1, b[j], acc[1][j], 0, 0, 0); }
        }
#pragma unroll
        for (int i = 0; i < 2; ++i)
#pragma unroll
            for (int j = 0; j < 4; ++j)
#pragma unroll
                for (int e = 0; e < 4; ++e) red[(wave * 32 + 16 * i + 4 * kq + e) * 64 + 16 * j + r] = acc[i][j][e];
        __syncthreads();
        {   const int row = tid >> 4, c4 = (tid & 15) * 4;
            f32x4m sum = (f32x4m){0.f, 0.f, 0.f, 0.f};
#pragma unroll
            for (int w = 0; w < 8; ++w) sum += *(const LAS f32x4m*)(red + (w * 32 + row) * 64 + c4);
            *(f32x4m*)(out + (size_t)(32 * tm + row) * ldo + 64 * tn + c4) = sum; }
        __syncthreads();
    }
}
__global__ void __launch_bounds__(NWAVES * 64, 2) mega_fwd(Args args) {
    extern __shared__ __attribute__((aligned(16))) unsigned char lds[];
    LAS unsigned char* L = (LAS unsigned char*)lds;
    volatile LAS unsigned* MISC = (volatile LAS unsigned*)(L + MISC_OFF);
    const int tid = threadIdx.x, lane = tid & 63, wave = __builtin_amdgcn_readfirstlane(tid >> 6);
    const int G = gridDim.x; const int bx = blockIdx.x; const int vcu = (G % 8 == 0) ? (bx % 8) * (G / 8) + bx / 8 : bx;
    unsigned char* ws = args.ws; float* out = args.out;
    gu32* ctl = (gu32*)(ws + WS_CTL);
    for (int u = tid; u < (LDS_BYTES - LDSCTL_OFF) / 4; u += NWAVES * 64) ((LAS unsigned*)(L + LDSCTL_OFF))[u] = 0u;
    __syncthreads();
    XcdBarrier bar = xcd_barrier_post((unsigned*)(ctl + CW_BAR), MISC + 8);
#define GRID_BAR() xcd_barrier(bar)
    const float* const* in = args.in;
    bf16 *Wgu1 = (bf16*)(ws + WS_WGU1), *Wd1 = (bf16*)(ws + WS_WD1), *Win = (bf16*)(ws + WS_WIN), *Wout = (bf16*)(ws + WS_WOUT), *Wgu2 = (bf16*)(ws + WS_WGU2), *Wd2 = (bf16*)(ws + WS_WD2);
    bf16 *XB = (bf16*)(ws + WS_XB), *H = (bf16*)(ws + WS_H), *X1B = (bf16*)(ws + WS_X1B), *HEADS = (bf16*)(ws + WS_HEADS), *X2B = (bf16*)(ws + WS_X2B);
    float *T = (float*)(ws + WS_T), *X1 = (float*)(ws + WS_X1), *P = (float*)(ws + WS_P), *GQ = (float*)(ws + WS_GQ), *GK = (float*)(ws + WS_GK), *GV = (float*)(ws + WS_GV), *GG = (float*)(ws + WS_GG), *GB = (float*)(ws + WS_GB), *X2 = (float*)(ws + WS_X2);
    const int gw = vcu * NWAVES + wave, NGW = G * NWAVES;
    bf16 *Qb = (bf16*)(ws + WS_QB), *Kb = (bf16*)(ws + WS_KB), *Vb = (bf16*)(ws + WS_VB);
    unsigned char* REC = ws + WS_REC; float* GO = (float*)(ws + WS_GO);

    {   LAS float* scr = (LAS float*)(L + RING_OFF + wave * 16384);
        p_transpose(in[9], in[10], DM, FF, NGU, 1, Wgu1, scr, gw, NGW, lane);
        p_transpose(in[11], nullptr, FF, DM, DM, 0, Wd1, scr, gw, NGW, lane);
        p_transpose(in[12], nullptr, DM, NIN, NINP, 0, Win, scr, gw, NGW, lane);
        p_transpose(in[13], nullptr, DM, DM, DM, 0, Wout, scr, gw, NGW, lane);
        p_transpose(in[20], in[21], DM, FF, NGU, 1, Wgu2, scr, gw, NGW, lane);
        p_transpose(in[22], nullptr, FF, DM, DM, 0, Wd2, scr, gw, NGW, lane);
        p_cvt_x(in[0], in[1], XB, gw, NGW, lane);
        GRID_BAR(); }
    {   pg8::Gemm g{XB, Wgu1, M, NGU, DM, 0}; pg8::StaticOrder S; S.init(M, NGU, G, bx); pg8::EpiSwiGLU E{H, FF, 0};
        pg8::gemm_phase<pg8::EpiSwiGLU, pg8::StaticOrder, true, true>(L + RING_OFF, g, S, E); GRID_BAR(); }
    {   pg8::Gemm g{H, Wd1, MP, DM, FF, 0}; pg8::StaticOrder S; S.init(MP, DM, G, bx); pg8::EpiF32 E{T, DM, 0};
        pg8::gemm_phase<pg8::EpiF32, pg8::StaticOrder, true, true>(L + RING_OFF, g, S, E);
        thin_gemm(H + (size_t)MP * FF, Wd1, FF, T + (size_t)MP * DM, DM, (LAS float*)(L + RING_OFF), vcu, G, tid); GRID_BAR(); }
    p_ln(in[0], in[1], T, 0.5f, in[7], in[8], X1, X1 + (size_t)MP * DM, X1B, gw, NGW, lane); GRID_BAR();
    {   pg8::Gemm g{X1B, Win, M, NINP, DM, 0}; pg8::StaticOrder S; S.init(M, NINP, G, bx); pg8::EpiF32 E{P, NINP, 0};
        pg8::gemm_phase<pg8::EpiF32, pg8::StaticOrder, true, true>(L + RING_OFF, g, S, E); GRID_BAR(); }
    p_copy_out(P, out, Qb, Kb, Vb, gw, NGW, lane);
    p_gdn_prep(P, in[5], in[14], in[15], in[16], GQ, GK, GV, GG, GB, MP, vcu, G, wave, lane);
    for (int unit = gw; unit < NB * NH * 32; unit += NGW) gdn::pre_unit(unit, P, in[14], in[15], in[16], REC, L + RING_OFF + wave * 16384, lane);
    GRID_BAR();
    {   const attn_body::AttnTensors AT{(const attn_body::bf16*)Qb, (const attn_body::bf16*)Kb, (const attn_body::bf16*)Vb, (attn_body::bf16*)HEADS};
        const attn_body::StaticOrder S(G, bx);
        attn_body::attn_phase<attn_body::StaticOrder>((char*)lds + RING_OFF, AT, in[6], S); }
    p_attn_sample(P, in[2], in[3], in[6], HEADS, (LAS float*)(L + RING_OFF) + wave * 392, gw, NGW, lane);
    for (int task = NB * NH + wave * G + bx; task < (NB + DB) * NH; task += NGW) gdn_scan_task(task, GQ, GK, GV, GG, GB, in[4], P, in[17], HEADS, out, lane);
    if (vcu < NB * NH) gdn::scan_wg(vcu, REC, GO, out + O_SGP, L + RING_OFF, tid);
    GRID_BAR();
    p_gdn_out(GO, P, in[17], HEADS, gw, NGW, lane);
    GRID_BAR();
    {   pg8::Gemm g{HEADS, Wout, MP, DM, DM, 0}; pg8::StaticOrder S; S.init(MP, DM, G, bx); pg8::EpiF32 E{T, DM, 0};
        pg8::gemm_phase<pg8::EpiF32, pg8::StaticOrder, true, true>(L + RING_OFF, g, S, E);
        thin_gemm(HEADS + (size_t)MP * DM, Wout, DM, T + (size_t)MP * DM, DM, (LAS float*)(L + RING_OFF), vcu, G, tid); GRID_BAR(); }
    p_ln(X1, X1 + (size_t)MP * DM, T, 1.0f, in[18], in[19], X2, X2 + (size_t)MP * DM, X2B, gw, NGW, lane); GRID_BAR();
    {   pg8::Gemm g{X2B, Wgu2, M, NGU, DM, 0}; pg8::StaticOrder S; S.init(M, NGU, G, bx); pg8::EpiSwiGLU E{H, FF, 0};
        pg8::gemm_phase<pg8::EpiSwiGLU, pg8::StaticOrder, true, true>(L + RING_OFF, g, S, E); GRID_BAR(); }
    {   pg8::Gemm g{H, Wd2, MP, DM, FF, 0}; pg8::StaticOrder S; S.init(MP, DM, G, bx); pg8::EpiF32 E{T, DM, 0};
        pg8::gemm_phase<pg8::EpiF32, pg8::StaticOrder, true, true>(L + RING_OFF, g, S, E);
        thin_gemm(H + (size_t)MP * FF, Wd2, FF, T + (size_t)MP * DM, DM, (LAS float*)(L + RING_OFF), vcu, G, tid); GRID_BAR(); }
    p_ln(X2, X2 + (size_t)MP * DM, T, 0.5f, in[23], in[24], out + O_YP, out + O_YS, nullptr, gw, NGW, lane);
}

extern "C" void kernel_launch(void* const* d_in, const int* in_sizes, int n_in, void* d_out, int out_size, void* d_ws, size_t ws_size, hipStream_t stream) {
    static int grid = 0;
    if (grid == 0) {
        if (n_in != 25 || out_size != (int)O_END || ws_size < WS_END) { fprintf(stderr, "kernel_launch: unexpected shapes (n_in %d out %d ws %zu)\n", n_in, out_size, ws_size); grid = -1; return; }
        int dev = 0, cus = 0, per_cu = 0;
        if (hipGetDevice(&dev) != hipSuccess || hipDeviceGetAttribute(&cus, hipDeviceAttributeMultiprocessorCount, dev) != hipSuccess) { grid = -1; return; }
        if (hipFuncSetAttribute((const void*)mega_fwd, hipFuncAttributeMaxDynamicSharedMemorySize, LDS_BYTES) != hipSuccess) { fprintf(stderr, "kernel_launch: hipFuncSetAttribute failed\n"); grid = -1; return; }
        if (hipOccupancyMaxActiveBlocksPerMultiprocessor(&per_cu, (const void*)mega_fwd, NWAVES * 64, LDS_BYTES) != hipSuccess || per_cu < 1) { fprintf(stderr, "kernel_launch: occupancy query reports %d\n", per_cu); }
        (void)hipGetLastError();
        grid = cus;
    }
    if (grid < 0) return;
    if (hipMemsetAsync((char*)d_ws + WS_CTL, 0, CTL_ZERO_BYTES, stream) != hipSuccess) return;
    Args a; memset(&a, 0, sizeof(a));
    for (int i = 0; i < 25; ++i) a.in[i] = (const float*)d_in[i];
    a.out = (float*)d_out; a.ws = (unsigned char*)d_ws;
    hipLaunchKernelGGL(mega_fwd, dim3(grid), dim3(NWAVES * 64), LDS_BYTES, stream, a);
}
```

```cpp
#include <hip/hip_runtime.h>
#include <cstdio>
#include <cstdint>
#include <cstring>
#include <cmath>
namespace pg8 {
#define PG8_LAS __attribute__((address_space(3)))
typedef unsigned short bf16_t;
typedef short bf16x8 __attribute__((ext_vector_type(8)));
typedef float f32x4 __attribute__((ext_vector_type(4)));
typedef unsigned u32x4 __attribute__((ext_vector_type(4)));
constexpr int BM = 256, BK = 64, HALF = 128, HTB = HALF * BK * 2  , STAGE_BYTES = 8 * HTB, NXCD = 8, WGM = 8;

__host__ __device__ __forceinline__ int lds_byte(int r, int c) { const int st = (r >> 4) * 2 + (c >> 5), rr = r & 15, cc = c & 31, ob = rr * 64 + cc * 2; return st * 1024 + (ob ^ (((ob >> 9) & 1) << 5)); }
__host__ __device__ __forceinline__ void stage_rc(int b, int& R, int& C) { const int st = b / 1024, sb = b % 1024, swz = sb ^ (((sb >> 9) & 1) << 5); R = (st >> 1) * 16 + swz / 64; C = (st & 1) * 32 + (swz % 64) / 2; }
__host__ __device__ __forceinline__ int perm32(int rho) { const int n = rho >> 4, i = rho & 15; return 8 * (i >> 2) + 4 * n + (i & 3); }

struct Unit { int pm, pn; };
struct Gemm { const bf16_t* A; const bf16_t* Bt; int M, N, K, pad; };

struct StaticOrder {
    int nM, nN, nwg, G, c;
    __host__ __device__ void init(int M, int N, int G_, int c_) { nM = M / BM; nN = N / BM; nwg = nM * nN; G = G_; c = c_; }
    __host__ __device__ bool next(int i, Unit& u) const {
        const long L = (long)i * G + c; if (L >= nwg) return false;
        int wgid = (int)L; { const int q = nwg / NXCD, r = nwg % NXCD, xcd = wgid % NXCD, off = wgid / NXCD; wgid = (xcd < r ? xcd * (q + 1) : r * (q + 1) + (xcd - r) * q) + off; }
        const int nig = WGM * nN, gid = wgid / nig, fm = gid * WGM, gsz = (nM - fm) < WGM ? (nM - fm) : WGM;
        u.pm = fm + ((wgid % nig) % gsz); u.pn = (wgid % nig) / gsz; return true;
    }
    __device__ __forceinline__ void a_ready(const Unit&) const {}
    __device__ __forceinline__ void done(const Unit&) const {}
};

__device__ __forceinline__ unsigned cvt_pk_bf16(float lo, float hi) { unsigned r; asm volatile("v_cvt_pk_bf16_f32 %0, %1, %2" : "=v"(r) : "v"(lo), "v"(hi)); return r; }
typedef float f32x2 __attribute__((ext_vector_type(2)));
struct EpiF32 {
    static constexpr bool PERM = false, AFTER_DRAIN = false;
    float* C; int ldc, pad;
    __device__ __forceinline__ void operator()(const f32x4 (&acc)[2][2][4][2], const Unit& u, int wr, int wc, int fr, int fq) const {
        const int row0 = u.pm * BM + wr * 64 + fr, col0 = u.pn * BM + wc * 32 + 4 * fq;
#pragma unroll
        for (int ai = 0; ai < 2; ++ai)
#pragma unroll
            for (int m = 0; m < 4; ++m) { float* rowp = C + (size_t)(row0 + ai * HALF + m * 16) * ldc + col0;
#pragma unroll
                for (int bj = 0; bj < 2; ++bj)
#pragma unroll
                    for (int n = 0; n < 2; ++n) *(f32x4*)(rowp + bj * HALF + n * 16) = acc[ai][bj][m][n]; }
    }
};
__device__ __forceinline__ float silu_f(float x) { return x * __builtin_amdgcn_rcpf(1.0f + __builtin_amdgcn_exp2f(-1.4426950408889634f * x)); }
struct EpiSwiGLU {
    static constexpr bool PERM = true, AFTER_DRAIN = false;
    bf16_t* H; int ldc, pad;
    __device__ __forceinline__ void operator()(const f32x4 (&acc)[2][2][4][2], const Unit& u, int wr, int wc, int fr, int fq) const {
        const int row0 = u.pm * BM + wr * 64 + fr, col0 = u.pn * HALF + wc * 32 + 8 * fq;
#pragma unroll
        for (int ai = 0; ai < 2; ++ai)
#pragma unroll
            for (int m = 0; m < 4; ++m) { bf16_t* rowp = H + (size_t)(row0 + ai * HALF + m * 16) * ldc + col0;
                const f32x4 g0 = acc[ai][0][m][0], g1 = acc[ai][0][m][1], u0 = acc[ai][1][m][0], u1 = acc[ai][1][m][1];
                u32x4 w;
                w.x = cvt_pk_bf16(silu_f(g0[0]) * u0[0], silu_f(g0[1]) * u0[1]); w.y = cvt_pk_bf16(silu_f(g0[2]) * u0[2], silu_f(g0[3]) * u0[3]);
                w.z = cvt_pk_bf16(silu_f(g1[0]) * u1[0], silu_f(g1[1]) * u1[1]); w.w = cvt_pk_bf16(silu_f(g1[2]) * u1[2], silu_f(g1[3]) * u1[3]);
                *(u32x4*)rowp = w; }
    }
};
template <class Epi, class Sched, bool ALIGN_EPI = false, bool SP2 = false>
__device__ __forceinline__ void gemm_phase(PG8_LAS unsigned char* lds, const Gemm g, const Sched& S, const Epi& E) {
    int tid_l = threadIdx.x; asm volatile("" : "+v"(tid_l));
    const int tid = tid_l, wid = __builtin_amdgcn_readfirstlane(tid >> 6), lane = tid & 63, wr = wid >> 2, wc = wid & 3, fr = lane & 15, fq = lane >> 4;
    const int K = g.K, nt = K / BK;
    unsigned voffA[2], voffB[2];
#pragma unroll
    for (int i = 0; i < 2; ++i) { int R, C; stage_rc(tid * 16 + i * 8192, R, C); const int Rb = Epi::PERM ? ((R & ~31) + perm32(R & 31)) : R;
        voffA[i] = (unsigned)(R * K + C) * 2u; voffB[i] = (unsigned)(Rb * K + C) * 2u; }
    const size_t kstep = (size_t)(BK * 2);
    const size_t hstep = (size_t)HALF * K * 2;
    const size_t tstep = 2 * hstep;
    const unsigned ldsw = (unsigned)wid * 1024u;
    const int aoff = lds_byte(wr * 64 + fr, fq * 8), boff = lds_byte(wc * 32 + fr, fq * 8);
#define PG8_SA(b, h) (((b) * 2 + (h)) * HTB)
#define PG8_SB(b, h) ((4 + (b) * 2 + (h)) * HTB)
#define PG8_STAGE(bufoff, gbase, voff) do { _Pragma("unroll") for (int _i = 0; _i < 2; ++_i) \
        __builtin_amdgcn_global_load_lds((const unsigned*)((const char*)(gbase) + (voff)[_i]), (PG8_LAS unsigned*)(lds + (bufoff) + ldsw + _i * 8192), 16, 0, 0); } while (0)
#define PG8_LDA(dst, b, h) do { _Pragma("unroll") for (int m = 0; m < 4; ++m) _Pragma("unroll") for (int k = 0; k < 2; ++k) dst[m][k] = *(const PG8_LAS bf16x8*)(lds + PG8_SA(b, h) + aoff + m * 2048 + k * 1024); } while (0)
#define PG8_LDB(dst, b, h) do { _Pragma("unroll") for (int n = 0; n < 2; ++n) _Pragma("unroll") for (int k = 0; k < 2; ++k) dst[n][k] = *(const PG8_LAS bf16x8*)(lds + PG8_SB(b, h) + boff + n * 2048 + k * 1024); } while (0)
#define PG8_MMA(ai, bj, At, Bt) do { __builtin_amdgcn_s_setprio(1); _Pragma("unroll") for (int m = 0; m < 4; ++m) _Pragma("unroll") for (int n = 0; n < 2; ++n) _Pragma("unroll") for (int k = 0; k < 2; ++k) \
        acc[ai][bj][m][n] = __builtin_amdgcn_mfma_f32_16x16x32_bf16(Bt[n][k], At[m][k], acc[ai][bj][m][n], 0, 0, 0); __builtin_amdgcn_s_setprio(0); } while (0)
#define PG8_WAIT_V(n) asm volatile("s_waitcnt vmcnt(" #n ")" ::: "memory")
#define PG8_WAIT_L(n) asm volatile("s_waitcnt lgkmcnt(" #n ")" ::: "memory")
#define PG8_BAR __builtin_amdgcn_s_barrier()
#define PG8_SCHED __builtin_amdgcn_sched_barrier(0)
    Unit cur, nxt; int ui = 0;
    if (!S.next(0, cur)) return;
    f32x4 acc[2][2][4][2];
#pragma unroll
    for (int a = 0; a < 2; ++a)
#pragma unroll
        for (int b = 0; b < 2; ++b)
#pragma unroll
            for (int m = 0; m < 4; ++m)
#pragma unroll
                for (int n = 0; n < 2; ++n) acc[a][b][m][n] = (f32x4){0.f, 0.f, 0.f, 0.f};
    bf16x8 At[4][2], B0[2][2], B1[2][2];
    const char* cA = (const char*)g.A + (size_t)cur.pm * tstep; const char* cB = (const char*)g.Bt + (size_t)cur.pn * tstep;
    S.a_ready(cur);
    if constexpr (SP2) {
        PG8_STAGE(PG8_SB(0, 0), cB, voffB); PG8_STAGE(PG8_SB(0, 1), cB + hstep, voffB); PG8_STAGE(PG8_SA(0, 0), cA, voffA); PG8_STAGE(PG8_SA(0, 1), cA + hstep, voffA);
        if (wr == 1) PG8_BAR;
        PG8_WAIT_V(2); PG8_BAR;
        PG8_STAGE(PG8_SB(1, 0), cB + kstep, voffB); PG8_STAGE(PG8_SA(1, 0), cA + kstep, voffA); PG8_STAGE(PG8_SB(1, 1), cB + hstep + kstep, voffB);
        PG8_WAIT_V(6); PG8_BAR;
    } else {
        PG8_STAGE(PG8_SB(0, 0), cB, voffB); PG8_STAGE(PG8_SA(0, 0), cA, voffA); PG8_STAGE(PG8_SB(0, 1), cB + hstep, voffB); PG8_STAGE(PG8_SA(0, 1), cA + hstep, voffA);
        if (wr == 1) PG8_BAR;
        PG8_WAIT_V(4); PG8_BAR;
        PG8_STAGE(PG8_SB(1, 0), cB + kstep, voffB); PG8_STAGE(PG8_SA(1, 0), cA + kstep, voffA); PG8_STAGE(PG8_SB(1, 1), cB + hstep + kstep, voffB);
        PG8_WAIT_V(6); PG8_BAR;
    }
    for (;;) {
        const bool has_next = S.next(ui + 1, nxt);
        const char* nA = has_next ? (const char*)g.A + (size_t)nxt.pm * tstep : cA; const char* nB = has_next ? (const char*)g.Bt + (size_t)nxt.pn * tstep : cB;
        for (int t = 0; t < nt; t += 2) {
            const bool last = (t == nt - 2);
            const char* a1 = cA + (size_t)(t + 1) * kstep;
            const char* a2 = last ? nA : cA + (size_t)(t + 2) * kstep; const char* b2 = last ? nB : cB + (size_t)(t + 2) * kstep;
            const char* a3 = a2 + kstep; const char* b3 = b2 + kstep;
            if (last && has_next) S.a_ready(nxt);
            if constexpr (SP2) {
            PG8_LDB(B0, 0, 0); PG8_LDB(B1, 0, 1); PG8_SCHED; PG8_LDA(At, 0, 0); PG8_STAGE(PG8_SA(1, 1), a1 + hstep, voffA);
            PG8_WAIT_V(8); PG8_WAIT_L(0); PG8_BAR; PG8_MMA(0, 0, At, B0); PG8_MMA(0, 1, At, B1); PG8_BAR; PG8_SCHED;
            PG8_LDA(At, 0, 1); PG8_STAGE(PG8_SB(0, 0), b2, voffB); PG8_STAGE(PG8_SB(0, 1), b2 + hstep, voffB); PG8_STAGE(PG8_SA(0, 0), a2, voffA);
            PG8_WAIT_V(8); PG8_WAIT_L(0); PG8_BAR; PG8_MMA(1, 0, At, B0); PG8_MMA(1, 1, At, B1); PG8_BAR; PG8_SCHED;
            PG8_LDB(B0, 1, 0); PG8_LDB(B1, 1, 1); PG8_SCHED; PG8_LDA(At, 1, 0); PG8_STAGE(PG8_SA(0, 1), a2 + hstep, voffA);
            PG8_WAIT_V(8); PG8_WAIT_L(0); PG8_BAR; PG8_MMA(0, 0, At, B0); PG8_MMA(0, 1, At, B1); PG8_BAR; PG8_SCHED;
            PG8_LDA(At, 1, 1); PG8_STAGE(PG8_SB(1, 0), b3, voffB); PG8_STAGE(PG8_SB(1, 1), b3 + hstep, voffB); PG8_STAGE(PG8_SA(1, 0), a3, voffA);
            PG8_WAIT_V(8); PG8_WAIT_L(0); PG8_BAR; PG8_MMA(1, 0, At, B0); PG8_MMA(1, 1, At, B1); PG8_BAR; PG8_SCHED;
            } else {
            PG8_LDB(B0, 0, 0); PG8_SCHED; PG8_LDA(At, 0, 0); PG8_STAGE(PG8_SA(1, 1), a1 + hstep, voffA);
            PG8_WAIT_L(8); PG8_BAR; PG8_WAIT_L(0); PG8_MMA(0, 0, At, B0); PG8_BAR; PG8_SCHED;
            PG8_LDB(B1, 0, 1); PG8_STAGE(PG8_SB(0, 0), b2, voffB);
            PG8_BAR; PG8_WAIT_L(0); PG8_MMA(0, 1, At, B1); PG8_BAR;
            PG8_LDA(At, 0, 1); PG8_STAGE(PG8_SA(0, 0), a2, voffA);
            PG8_BAR; PG8_WAIT_L(0); PG8_MMA(1, 0, At, B0); PG8_BAR; PG8_SCHED;
            PG8_STAGE(PG8_SB(0, 1), b2 + hstep, voffB);
            PG8_WAIT_V(6); PG8_BAR; PG8_MMA(1, 1, At, B1); PG8_BAR;
            PG8_LDB(B0, 1, 0); PG8_SCHED; PG8_LDA(At, 1, 0); PG8_STAGE(PG8_SA(0, 1), a2 + hstep, voffA);
            PG8_WAIT_L(8); PG8_BAR; PG8_WAIT_L(0); PG8_MMA(0, 0, At, B0); PG8_BAR; PG8_SCHED;
            PG8_LDB(B1, 1, 1); PG8_STAGE(PG8_SB(1, 0), b3, voffB);
            PG8_BAR; PG8_WAIT_L(0); PG8_MMA(0, 1, At, B1); PG8_BAR;
            PG8_LDA(At, 1, 1); PG8_STAGE(PG8_SA(1, 0), a3, voffA);
            PG8_BAR; PG8_WAIT_L(0); PG8_MMA(1, 0, At, B0); PG8_BAR; PG8_SCHED;
            PG8_STAGE(PG8_SB(1, 1), b3 + hstep, voffB);
            PG8_WAIT_V(6); PG8_BAR; PG8_MMA(1, 1, At, B1); PG8_BAR;
            }
        }
        if constexpr (ALIGN_EPI) { if (wr == 0) PG8_BAR; }
        if constexpr (!Epi::AFTER_DRAIN) { E(acc, cur, wr, wc, fr, fq); S.done(cur); }
        if (!has_next) break;
#pragma unroll
        for (int a = 0; a < 2; ++a)
#pragma unroll
            for (int b = 0; b < 2; ++b)
#pragma unroll
                for (int m = 0; m < 4; ++m)
#pragma unroll
                    for (int n = 0; n < 2; ++n) acc[a][b][m][n] = (f32x4){0.f, 0.f, 0.f, 0.f};
        cur = nxt; cA = nA; cB = nB; ++ui;
        if constexpr (ALIGN_EPI) { if (wr == 1) PG8_BAR; }
    }
    PG8_WAIT_V(0);
    if constexpr (!ALIGN_EPI) { if (wr == 0) PG8_BAR; }
    PG8_BAR;
    if constexpr (Epi::AFTER_DRAIN) { E.fused(acc, cur, wr, wc, fr, fq, lds, wid, lane); S.done(cur); }
#undef PG8_SA
#undef PG8_SB
#undef PG8_STAGE
#undef PG8_LDA
#undef PG8_LDB
#undef PG8_MMA
#undef PG8_WAIT_V
#undef PG8_WAIT_L
#undef PG8_BAR
#undef PG8_SCHED
}
}
#include <hip/hip_bf16.h>
#include <cmath>
namespace attn_body {
using bf16=__hip_bfloat16;
using bf16x8=__attribute__((ext_vector_type(8)))short;
using s16x4=__attribute__((ext_vector_type(4)))short;
using f32x16=__attribute__((ext_vector_type(16)))float;
using u32x4=__attribute__((ext_vector_type(4)))unsigned;
constexpr int BATCH=8,NHEAD=8,SEQ=2048,D=64,DM=NHEAD*D,OPITCH=1024,BT_OFF=256,BT_N=2304;
constexpr int NW=8,QBLK=32,QB=QBLK*NW,KVBLK=64,NQB=SEQ/QB;
constexpr int ATTN_PITCH=DM, ATTN_UNIT_ROWS=QB;
__device__ __forceinline__ int crow(int r,int hi){return (r&3)+8*(r>>2)+4*hi;}
#define SBAR() __builtin_amdgcn_sched_barrier(0)
__device__ __forceinline__ void cmask(f32x16&p0,f32x16&p1,int jb,int qrel,int hi){
  const float NEG=-INFINITY; int kb=64*jb+4*hi;
  #pragma unroll
  for(int r=0;r<16;++r){int kv=kb+(r&3)+8*(r>>2); if(kv>qrel)p0[r]=NEG; if(kv+32>qrel)p1[r]=NEG;}
}

constexpr int NSLOT=3, SLOTB=8192;
constexpr int LDS_K=0, LDS_V=NSLOT*SLOTB, LDS_WS=2*NSLOT*SLOTB, LDS_OST=LDS_WS+NW*64*4, LDS_BYTES=LDS_OST+NW*4096;
constexpr float C2=0.125f*1.4426950408889634f;
__device__ __forceinline__ void glds16(const void*gsrc,unsigned lds_dst){unsigned keep;
  asm volatile("s_mov_b32 %0, m0\n\ts_mov_b32 m0, %2\n\ts_nop 0\n\tglobal_load_lds_dwordx4 %1, off\n\ts_mov_b32 m0, %0":"=&s"(keep):"v"(gsrc),"s"(lds_dst):"memory");}
__device__ __forceinline__ float max3f(float a,float b,float c){float r;asm("v_max3_f32 %0, %1, %2, %3":"=v"(r):"v"(a),"v"(b),"v"(c));return r;}
__device__ __forceinline__ float max2f(float a,float b){float r;asm("v_max_f32_e32 %0, %1, %2":"=v"(r):"v"(a),"v"(b));return r;}
__device__ __forceinline__ float fadd_s(float a,float b){float r;asm("v_add_f32_e32 %0, %1, %2":"=v"(r):"v"(a),"v"(b));return r;}
__device__ __forceinline__ float fsub_s(float a,float b){float r;asm("v_sub_f32_e32 %0, %1, %2":"=v"(r):"v"(a),"v"(b));return r;}
typedef float f32x2_t __attribute__((ext_vector_type(2))); typedef __bf16 bf16x2_t __attribute__((ext_vector_type(2)));
__device__ __forceinline__ unsigned cvtpk_s(float lo,float hi){f32x2_t v={lo,hi};bf16x2_t b=__builtin_convertvector(v,bf16x2_t);return __builtin_bit_cast(unsigned,b);}
#define WAIT_BAR(N) asm volatile("s_waitcnt vmcnt(" #N ") lgkmcnt(0)\n\ts_barrier":::"memory")

__device__ __forceinline__ void qkt(f32x16&p0,f32x16&p1,const char*Kslot,const bf16x8*qr,const f32x16&negm,int r32,int hi){
  const char*kb=Kslot+hi*1024+r32*16;
  #pragma unroll
  for(int d0=0;d0<4;++d0){
    const bf16x8 b0=*reinterpret_cast<const bf16x8*>(kb+d0*2048);
    const bf16x8 b1=*reinterpret_cast<const bf16x8*>(kb+d0*2048+512);
    if(d0==0){p0=__builtin_amdgcn_mfma_f32_32x32x16_bf16(b0,qr[0],negm,0,0,0);p1=__builtin_amdgcn_mfma_f32_32x32x16_bf16(b1,qr[0],negm,0,0,0);}
    else{p0=__builtin_amdgcn_mfma_f32_32x32x16_bf16(b0,qr[d0],p0,0,0,0);p1=__builtin_amdgcn_mfma_f32_32x32x16_bf16(b1,qr[d0],p1,0,0,0);}}
}
typedef __attribute__((address_space(3))) const char* lds_cptr;
typedef short v4i16_t __attribute__((ext_vector_type(4)));
__device__ __forceinline__ void kload8(bf16x8*kf,lds_cptr kp){
  kf[0]=*(const __attribute__((address_space(3))) bf16x8*)(kp);      kf[1]=*(const __attribute__((address_space(3))) bf16x8*)(kp+512);
  kf[2]=*(const __attribute__((address_space(3))) bf16x8*)(kp+2048); kf[3]=*(const __attribute__((address_space(3))) bf16x8*)(kp+2560);
  kf[4]=*(const __attribute__((address_space(3))) bf16x8*)(kp+4096); kf[5]=*(const __attribute__((address_space(3))) bf16x8*)(kp+4608);
  kf[6]=*(const __attribute__((address_space(3))) bf16x8*)(kp+6144); kf[7]=*(const __attribute__((address_space(3))) bf16x8*)(kp+6656);
}
__device__ __forceinline__ void kload2(bf16x8*kf,lds_cptr kp,int j){ kf[2*j]=*(const __attribute__((address_space(3))) bf16x8*)(kp+j*2048); kf[2*j+1]=*(const __attribute__((address_space(3))) bf16x8*)(kp+j*2048+512); }
__device__ __forceinline__ s16x4 vtr(lds_cptr p){ return __builtin_bit_cast(s16x4,__builtin_amdgcn_ds_read_tr16_b64_v4i16((__attribute__((address_space(3))) v4i16_t*)p)); }
__device__ __forceinline__ float rowmax(const f32x16&p0,const f32x16&p1){
  float a=max3f(p0[0],p0[1],p1[0]),b=max3f(p0[2],p0[3],p1[1]);a=max3f(a,p1[2],p1[3]);
  #pragma unroll
  for(int r=4;r<16;r+=4){a=max3f(a,p0[r],p0[r+1]);b=max3f(b,p0[r+2],p0[r+3]);a=max3f(a,p1[r],p1[r+1]);b=max3f(b,p1[r+2],p1[r+3]);}
  const float m=max2f(a,b);
  auto rr=__builtin_amdgcn_permlane32_swap(__float_as_uint(m),__float_as_uint(m),false,false);
  return max2f(__uint_as_float(rr[0]),__uint_as_float(rr[1]));
}
__device__ __forceinline__ void pv(f32x16*o,int vb,bf16x8 pa0,bf16x8 pa1,bf16x8 pa2,bf16x8 pa3){
  #pragma unroll
  for(int d0=0;d0<2;++d0){s16x4 lo[4],hi[4];
    #pragma unroll
    for(int ks=0;ks<4;++ks){
      asm volatile("ds_read_b64_tr_b16 %0,%1 offset:%c2":"=&v"(lo[ks]):"v"(vb),"i"(d0*4096+ks*1024):"memory");
      asm volatile("ds_read_b64_tr_b16 %0,%1 offset:%c2":"=&v"(hi[ks]):"v"(vb),"i"(d0*4096+ks*1024+512):"memory");}
    asm volatile("s_waitcnt lgkmcnt(0)":::"memory");SBAR();
    #define PK(k) (bf16x8){lo[k][0],lo[k][1],lo[k][2],lo[k][3],hi[k][0],hi[k][1],hi[k][2],hi[k][3]}
    o[d0]=__builtin_amdgcn_mfma_f32_32x32x16_bf16(pa0,PK(0),o[d0],0,0,0);
    o[d0]=__builtin_amdgcn_mfma_f32_32x32x16_bf16(pa1,PK(1),o[d0],0,0,0);
    o[d0]=__builtin_amdgcn_mfma_f32_32x32x16_bf16(pa2,PK(2),o[d0],0,0,0);
    o[d0]=__builtin_amdgcn_mfma_f32_32x32x16_bf16(pa3,PK(3),o[d0],0,0,0);
    #undef PK
  }
}

#ifndef ATTN_STORE16
#define ATTN_STORE16(p,v) (*(u32x4*)(p)=(v))
#endif
template<int THRL> __device__ __forceinline__ void attn_unit(int b,int h,int qb,const bf16*Q,const bf16*__restrict__ K,const bf16*__restrict__ V,bf16*O,char*shm,const __attribute__((address_space(3))) float* btab){
  int tid_l=threadIdx.x; asm volatile("":"+v"(tid_l)); const int tid=tid_l,lane=tid&63,r32=lane&31,hi=lane>>5; const int wid=__builtin_amdgcn_readfirstlane(tid>>6);
  const long rowbase=(long)b*SEQ; const int q0=qb*QB;
  const bf16*Qw=Q+(rowbase+q0+wid*QBLK)*DM+h*D;
  const bf16*Kh=K+rowbase*DM+h*D,*Vh=V+rowbase*DM+h*D;
  const unsigned lds0=(unsigned)(uintptr_t)shm;
  float*wsf=(float*)(shm+LDS_WS)+wid*64;
  const bf16*ksrc=Kh+(long)lane*DM+wid*8;
  const bf16*vsrc=Vh+(long)(16*(wid&3)+(lane>>2))*DM+(wid>>2)*32+(lane&3)*8;
  const unsigned kdst=lds0+LDS_K+wid*1024, vdst=lds0+LDS_V+wid*1024;
  #define DMA_K(t,slot) glds16(ksrc+(long)(t)*KVBLK*DM,(unsigned)__builtin_amdgcn_readfirstlane(kdst+(slot)))
  #define DMA_V(t,slot) glds16(vsrc+(long)(t)*KVBLK*DM,(unsigned)__builtin_amdgcn_readfirstlane(vdst+(slot)))
  const int vb0=(int)(lds0+LDS_V)+((lane>>4)&1)*32+(lane&3)*8+(4*hi+((lane&15)>>2))*64;
  const char*Kbase=shm+LDS_K; bf16x8 kf[8];
  const lds_cptr shm3=(lds_cptr)shm; const lds_cptr kp0=shm3+LDS_K+hi*1024+r32*16; const lds_cptr vp0=shm3+LDS_V+((lane>>4)&1)*32+(lane&3)*8+(4*hi+((lane&15)>>2))*64;
  const int NT=(q0+QB)/KVBLK;
  DMA_K(0,0);DMA_V(0,0);DMA_K(1,SLOTB);
  bf16x8 qr[4];
  #pragma unroll
  for(int d0=0;d0<4;++d0)qr[d0]=*reinterpret_cast<const bf16x8*>(&Qw[(long)r32*DM+d0*16+hi*8]);
  float mhat=0.f,l_reg=0.f;f32x16 o[2];o[0]=f32x16{};o[1]=f32x16{};const f32x16 zero16=f32x16{};
    const int qabs=q0+wid*QBLK+r32;
  #define CMASK(P0,P1,t) do{ const __attribute__((address_space(3))) float* bp_=btab+(BT_OFF-59+qabs-64*(t)-4*hi); \
    _Pragma("unroll") for(int r=0;r<16;++r){ const int x_=(r&3)+8*(r>>2); P0[r]=fadd_s(P0[r],fsub_s(bp_[59-x_],mhat)); P1[r]=fadd_s(P1[r],fsub_s(bp_[27-x_],mhat)); } }while(0)
  bool resc=false;
  #define START(P0,P1) do{ const float rm=rowmax(P0,P1); resc=false; \
    { const float dl=rm; mhat=fadd_s(mhat,dl); \
      _Pragma("unroll") for(int r=0;r<16;++r){P0[r]=fsub_s(P0[r],dl);P1[r]=fsub_s(P1[r],dl);} \
      } \
    _Pragma("unroll") for(int r=0;r<16;++r)P0[r]=__builtin_amdgcn_exp2f(P0[r]); }while(0)
  #define RESC() do{ if(resc){ asm volatile("s_waitcnt lgkmcnt(0)":::"memory"); \
      _Pragma("unroll") for(int d_=0;d_<2;++d_) _Pragma("unroll") for(int r=0;r<16;++r)o[d_][r]*=wsf[crow(r,hi)]; } }while(0)
  f32x16 pA0,pA1,pB0,pB1;
  int sl_prev=0,sl_cur=0,sl_next=SLOTB;
  #define ROT() do{sl_prev=sl_cur;sl_cur=sl_next;sl_next=(sl_next==(NSLOT-1)*SLOTB)?0:sl_next+SLOTB;}while(0)
  DMA_K(2,2*SLOTB);
  WAIT_BAR(3);
  qkt(pA0,pA1,Kbase,qr,zero16,r32,hi);asm volatile("s_nop 15\n\ts_nop 7":"+v"(pA0),"+v"(pA1));CMASK(pA0,pA1,0);
  START(pA0,pA1);
  _Pragma("unroll") for(int r=0;r<16;++r)pA1[r]=__builtin_amdgcn_exp2f(pA1[r]);
  WAIT_BAR(0);
  DMA_K(3,0);DMA_V(1,SLOTB);
  ROT();
  kload8(kf,kp0+sl_cur);
  WAIT_BAR(2);
  s16x4 vlo[8],vhi[8]; u32x4 pw0,pw1,pw2,pw3;
  #define PKW(P,B) cvtpk_s(P[B],P[B+1])
  #define PAF(k) __builtin_bit_cast(bf16x8,pw##k)
  #define VFR(i) (bf16x8){vlo[i][0],vlo[i][1],vlo[i][2],vlo[i][3],vhi[i][0],vhi[i][1],vhi[i][2],vhi[i][3]}
  #define PIN(x) asm volatile("":"+v"(x))
  #define MX3(a,b,c) __builtin_fmaxf(__builtin_fmaxf((a),(b)),(c))
  #define GAPA(MF,A0,A1,A2,A3,W0,W1,PW) do{ MF; sacc+=A0; sacc+=A1; sacc+=A2; sacc+=A3; PIN(sacc); W0; W1; PIN(PW); SBAR(); }while(0)
  #define EX(v) __builtin_amdgcn_exp2f(v)
  #define GAPB(MF,X,B) do{ MF; X[B]=EX(X[B]); X[B+1]=EX(X[B+1]); X[B+2]=EX(X[B+2]); X[B+3]=EX(X[B+3]); PIN(X); SBAR(); }while(0)
  #define VRD(i) do{ vlo[i]=vtr(vp_+(((i)>>2)*4096+((i)&3)*1024)); vhi[i]=vtr(vp_+(((i)>>2)*4096+((i)&3)*1024+512)); }while(0)
  #define KRD(G,j) do{ if(G){ kload2(kf,kp0+sl_next,j); SBAR(); } }while(0)
  #define STEP(C0,C1,P0,P1,t,GK,GV,GL) do{ SBAR(); \
    const lds_cptr vp_=vp0+sl_prev; \
    VRD(0); SBAR(); float sacc=(P0[0]+P0[1]); \
    GAPA(C0=__builtin_amdgcn_mfma_f32_32x32x16_bf16(kf[0],qr[0],zero16,0,0,0), P0[2],P0[3],P0[4],P0[5],     pw0[0]=PKW(P0,0), pw0[1]=PKW(P0,2), pw0); \
    VRD(4); SBAR(); GAPA(C1=__builtin_amdgcn_mfma_f32_32x32x16_bf16(kf[1],qr[0],zero16,0,0,0), P0[6],P0[7],P0[8],P0[9],     pw0[2]=PKW(P0,4), pw0[3]=PKW(P0,6), pw0); \
    VRD(1); SBAR(); GAPA(C0=__builtin_amdgcn_mfma_f32_32x32x16_bf16(kf[2],qr[1],C0,0,0,0),   P0[10],P0[11],P0[12],P0[13], pw1[0]=PKW(P0,8), pw1[1]=PKW(P0,10), pw1); \
    VRD(5); SBAR(); GAPA(C1=__builtin_amdgcn_mfma_f32_32x32x16_bf16(kf[3],qr[1],C1,0,0,0),   P0[14],P0[15],P1[0],P1[1],   pw1[2]=PKW(P0,12),pw1[3]=PKW(P0,14), pw1); \
    VRD(2); SBAR(); GAPA(C0=__builtin_amdgcn_mfma_f32_32x32x16_bf16(kf[4],qr[2],C0,0,0,0),   P1[2],P1[3],P1[4],P1[5],     pw2[0]=PKW(P1,0), pw2[1]=PKW(P1,2), pw2); \
    VRD(6); SBAR(); GAPA(C1=__builtin_amdgcn_mfma_f32_32x32x16_bf16(kf[5],qr[2],C1,0,0,0),   P1[6],P1[7],P1[8],P1[9],     pw2[2]=PKW(P1,4), pw2[3]=PKW(P1,6), pw2); \
    VRD(3); SBAR(); GAPA(C0=__builtin_amdgcn_mfma_f32_32x32x16_bf16(kf[6],qr[3],C0,0,0,0),   P1[10],P1[11],P1[12],P1[13], pw3[0]=PKW(P1,8), pw3[1]=PKW(P1,10), pw3); \
    VRD(7); SBAR(); GAPA(C1=__builtin_amdgcn_mfma_f32_32x32x16_bf16(kf[7],qr[3],C1,0,0,0),   P1[14],P1[15],0.f,0.f,       pw3[2]=PKW(P1,12),pw3[3]=PKW(P1,14), pw3); \
    l_reg+=sacc; \
    if(GK){DMA_K((t)+3,sl_cur);} if(GV){DMA_V((t)+1,sl_next);} \
    CMASK(C0,C1,t); \
    { float a=MX3(C0[0],C0[1],C1[0]),b=MX3(C0[2],C0[3],C1[1]); a=MX3(a,C1[2],C1[3]); \
      _Pragma("unroll") for(int r=4;r<16;r+=4){a=MX3(a,C0[r],C0[r+1]);b=MX3(b,C0[r+2],C0[r+3]);a=MX3(a,C1[r],C1[r+1]);b=MX3(b,C1[r+2],C1[r+3]);} \
      float rm=__builtin_fmaxf(a,b); { auto rr=__builtin_amdgcn_permlane32_swap(__float_as_uint(rm),__float_as_uint(rm),false,false); rm=__builtin_fmaxf(__uint_as_float(rr[0]),__uint_as_float(rr[1])); } \
      resc=false; \
      if(__builtin_expect(__any(rm>(float)THRL),0)){ const float dl=__builtin_fmaxf(rm,0.f); mhat+=dl; \
        _Pragma("unroll") for(int r=0;r<16;++r){C0[r]-=dl;C1[r]-=dl;} \
        const float f=__builtin_amdgcn_exp2f(-dl); l_reg*=f; if(hi==0)wsf[r32]=f; resc=true; } } \
    SBAR(); \
    GAPB(o[0]=__builtin_amdgcn_mfma_f32_32x32x16_bf16(PAF(0),VFR(0),o[0],0,0,0), C0,0); \
    GAPB(o[1]=__builtin_amdgcn_mfma_f32_32x32x16_bf16(PAF(0),VFR(4),o[1],0,0,0), C0,4); \
    KRD(GL,0); GAPB(o[0]=__builtin_amdgcn_mfma_f32_32x32x16_bf16(PAF(1),VFR(1),o[0],0,0,0), C0,8); \
    KRD(GL,1); GAPB(o[1]=__builtin_amdgcn_mfma_f32_32x32x16_bf16(PAF(1),VFR(5),o[1],0,0,0), C0,12); \
    KRD(GL,2); GAPB(o[0]=__builtin_amdgcn_mfma_f32_32x32x16_bf16(PAF(2),VFR(2),o[0],0,0,0), C1,0); \
    KRD(GL,3); GAPB(o[1]=__builtin_amdgcn_mfma_f32_32x32x16_bf16(PAF(2),VFR(6),o[1],0,0,0), C1,4); \
    GAPB(o[0]=__builtin_amdgcn_mfma_f32_32x32x16_bf16(PAF(3),VFR(3),o[0],0,0,0), C1,8); \
    GAPB(o[1]=__builtin_amdgcn_mfma_f32_32x32x16_bf16(PAF(3),VFR(7),o[1],0,0,0), C1,12); \
    }while(0)
  int t=1;
  for(;t+5<NT;t+=2){
    STEP(pB0,pB1,pA0,pA1,t,true,true,true);     WAIT_BAR(2); RESC(); ROT();
    STEP(pA0,pA1,pB0,pB1,t+1,true,true,true);   WAIT_BAR(2); RESC(); ROT();
  }
  #define ENDW(tt) do{ if((tt)+3<NT){WAIT_BAR(2);} else if((tt)+2<NT){WAIT_BAR(1);} else {WAIT_BAR(0);} }while(0)
  for(;t+1<NT;t+=2){
    STEP(pB0,pB1,pA0,pA1,t,(t+3<NT),(t+1<NT),(t+1<NT));       ENDW(t);   RESC(); ROT();
    STEP(pA0,pA1,pB0,pB1,t+1,(t+4<NT),(t+2<NT),(t+2<NT));     ENDW(t+1); RESC(); ROT();
  }
  STEP(pB0,pB1,pA0,pA1,NT-1,false,false,false); RESC();
  { float sacc=pB0[0]+pB0[1]; _Pragma("unroll") for(int r=2;r<16;++r)sacc+=pB0[r]; _Pragma("unroll") for(int r=0;r<16;++r)sacc+=pB1[r]; l_reg+=sacc;
    pw0=(u32x4){PKW(pB0,0),PKW(pB0,2),PKW(pB0,4),PKW(pB0,6)};pw1=(u32x4){PKW(pB0,8),PKW(pB0,10),PKW(pB0,12),PKW(pB0,14)};pw2=(u32x4){PKW(pB1,0),PKW(pB1,2),PKW(pB1,4),PKW(pB1,6)};pw3=(u32x4){PKW(pB1,8),PKW(pB1,10),PKW(pB1,12),PKW(pB1,14)};
    SBAR(); pv(o,vb0+sl_cur,PAF(0),PAF(1),PAF(2),PAF(3)); }
  #undef PKW
  #undef PAF
  #undef VFR
  #undef PIN
  #undef MX3
  #undef GAPA
  #undef GAPB
  #undef EX
  #undef VRD
  #undef KRD
  #undef STEP
  #undef ENDW
  {auto rr=__builtin_amdgcn_permlane32_swap(__float_as_uint(l_reg),__float_as_uint(l_reg),false,false);l_reg=__uint_as_float(rr[0])+__uint_as_float(rr[1]);}
  if(hi==0)wsf[32+r32]=l_reg;asm volatile("s_waitcnt lgkmcnt(0)":::"memory");
  float rli[16];
  #pragma unroll
  for(int r=0;r<16;++r)rli[r]=__builtin_amdgcn_rcpf(wsf[32+crow(r,hi)]);
  bf16*Ow=O+(rowbase+q0+wid*QBLK)*OPITCH+h*D;
  { bf16*stg=(bf16*)(shm+LDS_OST)+wid*2048;
    #pragma unroll
    for(int r=0;r<16;++r){const int orow=crow(r,hi);
      #pragma unroll
      for(int d0=0;d0<2;++d0)stg[orow*64+d0*32+r32]=__float2bfloat16(o[d0][r]*rli[r]);}
    asm volatile("s_waitcnt lgkmcnt(0)":::"memory");
    #pragma unroll
    for(int i=0;i<4;++i){const int row=i*8+(lane>>3),ch=lane&7; const u32x4 v=*(const u32x4*)(stg+row*64+ch*8); ATTN_STORE16(Ow+(long)row*OPITCH+ch*8,v);} }
  asm volatile("s_waitcnt lgkmcnt(0)\n\ts_barrier":::"memory");
  #undef DMA_K
  #undef DMA_V
  #undef CMASK
  #undef START
  #undef RESC
  #undef ROT
}
constexpr int ATTN_LDS_BYTES=LDS_BYTES;
struct AttnTensors { const bf16* Q; const bf16* K; const bf16* V; bf16* O; };
struct AttnUnit { int bh; int qb; };
struct StaticOrder {
  int vcu;
  __device__ __forceinline__ explicit StaticOrder(int grid,int block):vcu((block%8)*(grid/8)+block/8){}
  __device__ __forceinline__ bool next(int i,AttnUnit&u)const{ if(i>=2)return false; const int s=vcu&3; u.bh=vcu>>2; u.qb=(i==0)?s:7-s; return true; }
  __device__ __forceinline__ void a_ready(const AttnUnit&)const{}
  __device__ __forceinline__ void done(const AttnUnit&)const{}
};
struct QueueOrder {
  unsigned* ctr; volatile __attribute__((address_space(3))) unsigned* slot;
  __device__ __forceinline__ bool next(int,AttnUnit&u)const{ __syncthreads(); if(threadIdx.x==0)*slot=__hip_atomic_fetch_add(ctr,1u,__ATOMIC_RELAXED,__HIP_MEMORY_SCOPE_AGENT); __syncthreads(); const unsigned v=*slot; if(v>=512u)return false; u.qb=7-(int)(v>>6); u.bh=(int)(v&63u); return true; }
  __device__ __forceinline__ void a_ready(const AttnUnit&)const{}
  __device__ __forceinline__ void done(const AttnUnit&)const{}
};
constexpr int BT_LDS_OFF=86016, ATTN_LDS_TOTAL=BT_LDS_OFF+BT_N*4;
__device__ __forceinline__ int t5b(int n){ if(n<16)return n; int b=16; b+=(n>=22);b+=(n>=30);b+=(n>=40);b+=(n>=54);b+=(n>=73);b+=(n>=99);b+=(n>=134);b+=(n>=182);b+=(n>=246);b+=(n>=332);b+=(n>=450);b+=(n>=609);b+=(n>=825);b+=(n>=1117);b+=(n>=1513); return b; }
__device__ __forceinline__ void build_btab(__attribute__((address_space(3))) float* bt,const float*relb,int h){
  for(int i=threadIdx.x;i<BT_N;i+=NW*64){ const int dl=i-BT_OFF; float v=-INFINITY;
    if(dl>=0){ const int c=(dl<=128?1:0)+(((dl&3)==0&&dl<=512)?1:0)+(((dl&15)==0&&dl<=2048)?1:0);
      if(c>0) v=(relb[t5b(dl)*NHEAD+h]+(c==1?0.f:(c==2?0.6931471805599453f:1.0986122886681098f)))*1.4426950408889634f; }
    bt[i]=v; }
}
template<class Sched,int THRL=8> __device__ __forceinline__ void attn_phase(char*lds,const AttnTensors&T,const float*relb,const Sched&S){
  AttnUnit u; int cur_h=-1;
  __attribute__((address_space(3))) float* bt=(__attribute__((address_space(3))) float*)((__attribute__((address_space(3))) char*)lds+BT_LDS_OFF);
  for(int i=0;S.next(i,u);++i){ S.a_ready(u);
    const int h=u.bh%NHEAD;
    if(h!=cur_h){ asm volatile("s_waitcnt lgkmcnt(0)\n\ts_barrier":::"memory"); build_btab(bt,relb,h); asm volatile("s_waitcnt lgkmcnt(0)\n\ts_barrier":::"memory"); cur_h=h; }
    attn_unit<THRL>(u.bh/NHEAD,u.bh%NHEAD,u.qb,T.Q,T.K,T.V,T.O,lds,bt); S.done(u); }
}
#undef SBAR
#undef WAIT_BAR
}
#define GAS __attribute__((address_space(1)))
#define LAS __attribute__((address_space(3)))
typedef unsigned short bf16;
typedef unsigned v4u __attribute__((ext_vector_type(4)));
typedef float f32x4 __attribute__((ext_vector_type(4)));
typedef short bf16x8 __attribute__((ext_vector_type(8)));
typedef GAS unsigned gu32;
typedef GAS unsigned long long gu64;
#define RLX_AGENT __ATOMIC_RELAXED, __HIP_MEMORY_SCOPE_AGENT
#define LDS_WAIT() asm volatile("s_waitcnt lgkmcnt(0)" ::: "memory")
#define VM_WAIT() asm volatile("s_waitcnt vmcnt(0)" ::: "memory")
__device__ __forceinline__ unsigned long long rt() { return __builtin_amdgcn_s_memrealtime(); }
__device__ __forceinline__ unsigned f2bf(float f) { unsigned u = __builtin_bit_cast(unsigned, f); return (u + 0x7fffu + ((u >> 16) & 1u)) >> 16; }
__device__ __forceinline__ unsigned pk2(float lo, float hi) { return f2bf(lo) | (f2bf(hi) << 16); }
#define XB_TMO      128
#define XB_XCNT(j)  (256  + 64 * (j))
#define XB_XSUB(j)  (1280 + 64 * (j))
#define XB_XGEN(j)  (2304 + 64 * (j))
#define XB_TOP      3328
#define XB_TOPGEN   3392
#define XCD_BAR_WORDS 3456
#define XB_SPIN_CAP (1u << 18)

__device__ __forceinline__ unsigned xb_ld(unsigned* p)              { return __hip_atomic_load(p, __ATOMIC_RELAXED, __HIP_MEMORY_SCOPE_AGENT); }
__device__ __forceinline__ unsigned xb_add(unsigned* p, unsigned v) { return __hip_atomic_fetch_add(p, v, __ATOMIC_RELAXED, __HIP_MEMORY_SCOPE_AGENT); }
__device__ __forceinline__ unsigned xb_xcc_id() { return (unsigned)__builtin_amdgcn_s_getreg((3 << 11) | 20) & 0xFu; }
#define XB_SPIN(cond, bar) do { unsigned _sp = 0; while (cond) { __builtin_amdgcn_s_sleep(1); \
    if ((++_sp & 255u) == 0u) { if (xb_ld(&(bar)[XB_TMO])) break; if (_sp > XB_SPIN_CAP) { atomicAdd(&(bar)[XB_TMO], 1u); break; } } } } while (0)

struct XcdBarrier {
    unsigned* bar; unsigned x;
    volatile LAS unsigned* st;
};

__device__ __forceinline__ XcdBarrier xcd_barrier_post(unsigned* bar, volatile LAS unsigned* st) {
    XcdBarrier b; b.bar = bar; b.x = xb_xcc_id(); b.st = st;
    if (threadIdx.x == 0) (void)xb_add(&bar[XB_XCNT(b.x)], 1u);
    return b;
}
__device__ __forceinline__ void xcd_barrier_complete(unsigned* bar, unsigned x, unsigned& nloc, unsigned& nx) {
    const unsigned G = gridDim.x * gridDim.y * gridDim.z;
    unsigned sum, cnt, mine, sp = 0u;
    for (;;) {
        sum = 0u; cnt = 0u; mine = 0u;
#pragma unroll
        for (unsigned j = 0; j < 16; ++j) { const unsigned c = xb_ld(&bar[XB_XCNT(j)]); sum += c; cnt += (c > 0u) ? 1u : 0u; mine = (j == x) ? c : mine; }
        if (sum == G) break;
        __builtin_amdgcn_s_sleep(1);
        if ((++sp & 255u) == 0u) { if (xb_ld(&bar[XB_TMO])) break; if (sp > XB_SPIN_CAP) { atomicAdd(&bar[XB_TMO], 1u); break; } }
    }
    nloc = mine > 0u ? mine : 1u; nx = cnt > 0u ? cnt : 1u;
}

__device__ __forceinline__ void xcd_barrier(const XcdBarrier& b) {
    asm volatile("s_waitcnt vmcnt(0)" ::: "memory");
    __syncthreads();
    if (threadIdx.x == 0) {
        unsigned* bar = b.bar;
        __builtin_amdgcn_s_waitcnt(0);
        unsigned nloc = b.st[0], nx = b.st[1];
        if (nloc == 0u) { xcd_barrier_complete(bar, b.x, nloc, nx); b.st[0] = nloc; b.st[1] = nx; }
        const unsigned old = xb_add(&bar[XB_XSUB(b.x)], 1u);
        const unsigned gen = old / nloc;
        if (old + 1u == (gen + 1u) * nloc) {
            __builtin_amdgcn_fence(__ATOMIC_RELEASE, "agent");
            asm volatile("s_waitcnt vmcnt(0)" ::: "memory");
            const unsigned og = xb_add(&bar[XB_TOP], 1u);
            const unsigned tg = og / nx;
            if (og + 1u == (tg + 1u) * nx) xb_add(&bar[XB_TOPGEN], 1u);
            else XB_SPIN(xb_ld(&bar[XB_TOPGEN]) == tg, bar);
            __builtin_amdgcn_fence(__ATOMIC_ACQUIRE, "agent");
            xb_add(&bar[XB_XGEN(b.x)], 1u);
            asm volatile("s_waitcnt vmcnt(0)" ::: "memory");
        } else {
            XB_SPIN(xb_ld(&bar[XB_XGEN(b.x)]) == gen, bar);
            __builtin_amdgcn_fence(__ATOMIC_ACQUIRE, "agent");
            asm volatile("s_waitcnt vmcnt(0)" ::: "memory");
        }
    }
    __syncthreads();
}
namespace gdn {
#define GLAS __attribute__((address_space(3)))
typedef short bf16x8 __attribute__((ext_vector_type(8)));
typedef float f32x16 __attribute__((ext_vector_type(16)));
typedef float f32x2_t __attribute__((ext_vector_type(2))); typedef __bf16 bf16x2_t __attribute__((ext_vector_type(2)));
typedef unsigned u32x4 __attribute__((ext_vector_type(4)));
typedef unsigned u32x2 __attribute__((ext_vector_type(2)));
typedef float f32x4 __attribute__((ext_vector_type(4)));
#define GDI __device__ __forceinline__
#define GMFMA(a, b, c) __builtin_amdgcn_mfma_f32_32x32x16_bf16((a), (b), (c), 0, 0, 0)
GDI unsigned cvtpk(float lo, float hi) { f32x2_t v = {lo, hi}; bf16x2_t b = __builtin_convertvector(v, bf16x2_t); return __builtin_bit_cast(unsigned, b); }
GDI unsigned short cvt1(float x) { return (unsigned short)(cvtpk(x, 0.f) & 0xffffu); }
GDI constexpr int crow(int r, int hi) { return (r & 3) + 8 * (r >> 2) + 4 * hi; }
template <class T> GDI T* uni_ptr(T* p) { const unsigned long long u = (unsigned long long)p; const unsigned lo = __builtin_amdgcn_readfirstlane((unsigned)u), hi = __builtin_amdgcn_readfirstlane((unsigned)(u >> 32)); return (T*)(((unsigned long long)hi << 32) | lo); }
GDI float rdl(float v, int l) { return __builtin_bit_cast(float, __builtin_amdgcn_readlane(__builtin_bit_cast(int, v), l)); }
#define GDPP(x, ctrl, rmask) __builtin_bit_cast(float, __builtin_amdgcn_update_dpp(0, __builtin_bit_cast(int, (x)), (ctrl), (rmask), 0xF, false))
GDI float wsum(float v) {
    v += GDPP(v, 0xB1, 0xF); v += GDPP(v, 0x4E, 0xF); v += GDPP(v, 0x141, 0xF); v += GDPP(v, 0x140, 0xF);
    v += GDPP(v, 0x142, 0xA); v += GDPP(v, 0x143, 0xC);
    return rdl(v, 63);
}
constexpr int R_NEGW = 0, R_Q = 8192, R_INTRA = 16384, R_KT = 24576, R_U = 32768, R_SC = 49152, R_BYTES = 50176, R_TMP = 50176, R_STRIDE = 66560;
constexpr int NCH = 32, CH = 64, NIN_P = 3840, C_GQKV_ = 1536, C_B_ = 3584, C_A_ = 3592, SEQ_ = 2048;
GDI int frag_off(int R, int K) { return ((((R >> 5) * 4 + (K >> 4)) * 2 + ((K >> 2) & 1)) * 32 + (R & 31)) * 16 + ((((K >> 3) & 1) * 4) + (K & 3)) * 2; }
GDI int img_off(int row, int d) { return row * 128 + ((((d >> 3) ^ (row & 7))) << 4) + (d & 7) * 2; }
GDI bf16x8 img_frag(const GLAS unsigned char* img, int row0, int ks, int lane) {
    const int r = lane & 31, hh = lane >> 5, row = row0 + r;
    return *(const GLAS bf16x8*)(img + row * 128 + ((((2 * ks + hh) ^ (row & 7))) << 4));
}

GDI void pre_unit(int unit, const float* __restrict__ P, const float* __restrict__ convw, const float* __restrict__ alog, const float* __restrict__ dtb, unsigned char* __restrict__ rec_base, GLAS unsigned char* lw, int lane_in) {
    int lane = lane_in; asm volatile("" : "+v"(lane));
    const int bh = unit >> 5, c = unit & 31, b = bh >> 3, h = bh & 7;
    const int m0 = b * SEQ_ + c * CH;
    unsigned char* rec = uni_ptr(rec_base + (size_t)unit * R_STRIDE);
    GLAS unsigned char* q16 = lw; GLAS unsigned char* k16 = lw + 8192; GLAS float* AT = (GLAS float*)lw;
    float bt_v, gc_v, eg_v;
    {   const float* pr = P + (size_t)(m0 + lane) * NIN_P;
        const float aa = pr[C_A_ + h] + dtb[h], bb = pr[C_B_ + h];
        const float sp = (aa > 20.f) ? aa : log1pf(__expf(aa));
        const float g = -__expf(alog[h]) * sp;
        bt_v = 1.0f / (1.0f + __expf(-bb));
        float s = g;
#pragma unroll
        for (int o = 1; o < 64; o <<= 1) { const float t = __shfl_up(s, o); if (lane >= o) s += t; }
        gc_v = s; eg_v = __expf(gc_v);
        const float gcl = rdl(gc_v, 63);
        float* sc = (float*)(rec + R_SC);
        sc[lane] = eg_v; sc[64 + lane] = __expf(gcl - gc_v); if (lane == 0) sc[128] = __expf(gcl);
    }
    float W[64];
    float* ug = (float*)(rec + R_U); float* tg = (float*)(rec + R_TMP);
    {   const int ch = h * 64 + lane;
        float wq[4], wk[4], wv[4];
#pragma unroll
        for (int j = 0; j < 4; ++j) { wq[j] = convw[j * 1536 + ch]; wk[j] = convw[j * 1536 + 512 + ch]; wv[j] = convw[j * 1536 + 1024 + ch]; }
        const float* pbs = uni_ptr(P + (size_t)m0 * NIN_P + C_GQKV_ + h * 64 + 512);
        float q1 = 0.f, q2 = 0.f, q3 = 0.f, k1 = 0.f, k2 = 0.f, k3 = 0.f, v1 = 0.f, v2 = 0.f, v3 = 0.f;
        if (c > 0) { const float* p3 = pbs - 3 * NIN_P; const float* p2 = pbs - 2 * NIN_P; const float* p1 = pbs - NIN_P;
            q1 = p3[lane - 512]; k1 = p3[lane]; v1 = p3[lane + 512]; q2 = p2[lane - 512]; k2 = p2[lane]; v2 = p2[lane + 512]; q3 = p1[lane - 512]; k3 = p1[lane]; v3 = p1[lane + 512]; }
        float kwin[16];
#pragma unroll
        for (int t8 = 0; t8 < 64; t8 += 4) {
            asm volatile("" ::: "memory");
            float xq[4], xk[4], xv[4];
#pragma unroll
            for (int u = 0; u < 4; ++u) { const float* rp = pbs + (size_t)(t8 + u) * NIN_P; xq[u] = rp[lane - 512]; xk[u] = rp[lane]; xv[u] = rp[lane + 512]; }
#pragma unroll
            for (int u = 0; u < 4; ++u) { const int t = t8 + u;
                float cq = wq[0] * q1 + wq[1] * q2 + wq[2] * q3 + wq[3] * xq[u];
                float ck = wk[0] * k1 + wk[1] * k2 + wk[2] * k3 + wk[3] * xk[u];
                float cv = wv[0] * v1 + wv[1] * v2 + wv[2] * v3 + wv[3] * xv[u];
                q1 = q2; q2 = q3; q3 = xq[u]; k1 = k2; k2 = k3; k3 = xk[u]; v1 = v2; v2 = v3; v3 = xv[u];
                cq = cq / (1.0f + __expf(-cq)); ck = ck / (1.0f + __expf(-ck)); cv = cv / (1.0f + __expf(-cv));
                const float qn = wsum(cq * cq), kn = wsum(ck * ck);
                const float qv = cq * (1.0f / sqrtf(qn + 1e-6f)) * 0.125f, kv = ck * (1.0f / sqrtf(kn + 1e-6f));
                *(GLAS unsigned short*)(q16 + img_off(t, lane)) = cvt1(qv);
                *(GLAS unsigned short*)(k16 + img_off(t, lane)) = cvt1(kv);
                const float bt = rdl(bt_v, t), eg = rdl(eg_v, t);
                W[t] = bt * cv; { float* tb = uni_ptr(tg + (t >> 4) * 1024); tb[(t & 15) * 64 + lane] = bt * eg * kv; }
                kwin[t & 15] = kv;
                if ((t & 15) == 15) {
                    const int s = t >> 4, rt = lane >> 5, r = lane & 31;
                    u32x4 f0, f1;
                    f0.x = cvtpk(kwin[0], kwin[1]); f0.y = cvtpk(kwin[2], kwin[3]); f0.z = cvtpk(kwin[8], kwin[9]); f0.w = cvtpk(kwin[10], kwin[11]);
                    f1.x = cvtpk(kwin[4], kwin[5]); f1.y = cvtpk(kwin[6], kwin[7]); f1.z = cvtpk(kwin[12], kwin[13]); f1.w = cvtpk(kwin[14], kwin[15]);
                    *(u32x4*)(rec + R_KT + (((rt * 4 + s) * 2 + 0) * 32 + r) * 16) = f0;
                    *(u32x4*)(rec + R_KT + (((rt * 4 + s) * 2 + 1) * 32 + r) * 16) = f1;
                }
            }
        }
    }
    asm volatile("s_waitcnt lgkmcnt(0)" ::: "memory");
    const int r31 = lane & 31, hi = lane >> 5;
#pragma unroll
    for (int tile = 0; tile < 3; ++tile) { const int jt = (tile == 2) ? 1 : 0, it = (tile == 0) ? 0 : 1;
        f32x16 acc = {};
#pragma unroll
        for (int ks = 0; ks < 4; ++ks) acc = GMFMA(img_frag(k16, 32 * jt, ks, lane), img_frag(q16, 32 * it, ks, lane), acc);
        const int i = 32 * it + r31; const float gci = __shfl(gc_v, i);
        float vals[16];
#pragma unroll
        for (int rr = 0; rr < 16; ++rr) { const int j0 = 32 * jt + crow(rr, 0); const float gcj0 = rdl(gc_v, j0), gcj1 = rdl(gc_v, j0 + 4); const float gcj = hi ? gcj1 : gcj0; const int j = j0 + 4 * hi;
            vals[rr] = (i >= j) ? acc[rr] * __expf(gci - gcj) : 0.f; }
#pragma unroll
        for (int s = 0; s < 2; ++s) { u32x4 f; f.x = cvtpk(vals[8 * s], vals[8 * s + 1]); f.y = cvtpk(vals[8 * s + 2], vals[8 * s + 3]); f.z = cvtpk(vals[8 * s + 4], vals[8 * s + 5]); f.w = cvtpk(vals[8 * s + 6], vals[8 * s + 7]);
            *(u32x4*)(rec + R_INTRA + (((it * 4 + 2 * jt + s) * 2 + hi) * 32 + r31) * 16) = f; }
    }
#pragma unroll
    for (int rt = 0; rt < 2; ++rt)
#pragma unroll
        for (int ks = 0; ks < 4; ++ks) { const int row = 32 * rt + r31;
            const u32x2 lo = *(const GLAS u32x2*)(q16 + row * 128 + ((((2 * ks) ^ (row & 7))) << 4) + 8 * hi), hh = *(const GLAS u32x2*)(q16 + row * 128 + ((((2 * ks + 1) ^ (row & 7))) << 4) + 8 * hi);
            u32x4 f; f.x = lo.x; f.y = lo.y; f.z = hh.x; f.w = hh.y;
            *(u32x4*)(rec + R_Q + (((rt * 4 + ks) * 2 + hi) * 32 + r31) * 16) = f; }
    {   const float gc_lo = __shfl(gc_v, r31), gc_hi2 = __shfl(gc_v, 32 + r31), bt_lo = __shfl(bt_v, r31), bt_hi2 = __shfl(bt_v, 32 + r31);
        asm volatile("s_waitcnt lgkmcnt(0)" ::: "memory");
        {   f32x16 d00 = {}, d01 = {};
#pragma unroll
            for (int ks = 0; ks < 4; ++ks) { const bf16x8 f0 = img_frag(k16, 0, ks, lane), f1 = img_frag(k16, 32, ks, lane); d00 = GMFMA(f0, f0, d00); d01 = GMFMA(f0, f1, d01); }
#pragma unroll
            for (int rr = 0; rr < 16; ++rr) { const int i0 = crow(rr, 0); const float gci0 = rdl(gc_v, i0), gci1 = rdl(gc_v, i0 + 4); const float gci = hi ? gci1 : gci0; const int ia = i0 + 4 * hi;
                AT[ia * 64 + r31] = (r31 > ia) ? bt_lo * d00[rr] * __expf(gc_lo - gci) : 0.f;
                AT[ia * 64 + 32 + r31] = bt_hi2 * d01[rr] * __expf(gc_hi2 - gci); } }
        {   f32x16 d11 = {};
#pragma unroll
            for (int ks = 0; ks < 4; ++ks) { const bf16x8 f1 = img_frag(k16, 32, ks, lane); d11 = GMFMA(f1, f1, d11); }
            asm volatile("s_waitcnt lgkmcnt(0)" ::: "memory");
#pragma unroll
            for (int rr = 0; rr < 16; ++rr) { const int i0 = crow(rr, 0); const float gci0 = rdl(gc_v, 32 + i0), gci1 = rdl(gc_v, 32 + i0 + 4); const float gci = hi ? gci1 : gci0; const int ib = 32 + i0 + 4 * hi;
                AT[ib * 64 + 32 + r31] = (32 + r31 > ib) ? bt_hi2 * d11[rr] * __expf(gc_hi2 - gci) : 0.f; } }
    }
    asm volatile("s_waitcnt lgkmcnt(0)" ::: "memory");
#define GSUBST(X, ATP) _Pragma("unroll") for (int i = 0; i < 63; ++i) { unsigned ao_ = (unsigned)(i * 256); asm volatile("" : "+v"(ao_) : "v"(X[i]));     \
        _Pragma("unroll") for (int q4 = (i + 1) >> 2; q4 < 16; ++q4) { \
        const f32x4 a = *(const GLAS f32x4*)((const GLAS unsigned char*)(ATP) + ao_ + 16 * q4); \
        _Pragma("unroll") for (int e = 0; e < 4; ++e) { const int ip = 4 * q4 + e; if (ip > i) X[ip] = fmaf(-a[e], X[i], X[ip]); } } }
#pragma unroll 1
    for (int pass = 0; pass < 2; ++pass) {
        GSUBST(W, AT)
        if (pass == 0) {
#pragma unroll
            for (int i = 0; i < 64; ++i) { float* ub = uni_ptr(ug + (i >> 4) * 1024); ub[(i & 15) * 64 + lane] = W[i]; }
            asm volatile("s_waitcnt vmcnt(0)" ::: "memory");
#pragma unroll
            for (int i = 0; i < 64; ++i) { const float* tb = uni_ptr(tg + (i >> 4) * 1024); W[i] = tb[(i & 15) * 64 + lane]; }
        }
    }
#undef GSUBST
    {   asm volatile("s_waitcnt lgkmcnt(0)" ::: "memory");
#pragma unroll
        for (int i = 0; i < 64; ++i) *(GLAS unsigned short*)(lw + frag_off(i, lane)) = cvt1(-W[i]);
        asm volatile("s_waitcnt lgkmcnt(0)" ::: "memory");
#pragma unroll
        for (int x = 0; x < 8; ++x) *(u32x4*)(rec + R_NEGW + x * 1024 + lane * 16) = *(const GLAS u32x4*)(lw + x * 1024 + lane * 16);
        asm volatile("s_waitcnt lgkmcnt(0)" ::: "memory");
    }
}

GDI void scan_wg(int bh, const unsigned char* __restrict__ rec_base, const float* __restrict__ P, const float* __restrict__ nw, unsigned short* __restrict__ heads, float* __restrict__ sg_out, GLAS unsigned char* lds, int tid_in) {
    int tid = tid_in; asm volatile("" : "+v"(tid));
    const int wave = __builtin_amdgcn_readfirstlane(tid >> 6), lane = tid & 63, r31 = lane & 31, hi = lane >> 5;
    const int b = bh >> 3, h = bh & 7;
    const unsigned char* rec0 = rec_base + (size_t)bh * NCH * R_STRIDE;
    __syncthreads();
    for (int x = tid; x < R_BYTES / 16; x += 512) *(GLAS u32x4*)(lds + x * 16) = *(const u32x4*)(rec0 + (size_t)x * 16);
    __syncthreads();
    constexpr int OB_OFF = 2 * R_BYTES;
    const float nwl = nw[lane];
    float zz[11];
    auto load_z = [&](int cc) { const int m0 = b * SEQ_ + cc * CH;
#pragma unroll
        for (int k = 0; k < 11; ++k) { const int row = wave - 2 + 6 * k; zz[k] = (row < CH) ? P[(size_t)(m0 + row) * NIN_P + 3072 + h * 64 + lane] : 0.f; } };
    auto finish_o = [&](int cc) { const GLAS float* ob = (const GLAS float*)(lds + OB_OFF + (cc & 1) * 16384); const int m0 = b * SEQ_ + cc * CH;
#pragma unroll
        for (int k = 0; k < 11; ++k) { const int row = wave - 2 + 6 * k; if (row < CH) { const float o = ob[row * 64 + lane]; const float ms = wsum(o * o) * (1.f / 64.f); const float z = zz[k];
            heads[(size_t)(m0 + row) * 1024 + 512 + h * 64 + lane] = cvt1(o * (1.0f / sqrtf(ms + 1e-6f)) * nwl * (z / (1.0f + __expf(-z)))); } } };
    f32x16 S0 = {}, S1 = {};
    for (int c = 0; c < NCH; ++c) {
        GLAS unsigned char* buf = lds + (c & 1) * R_BYTES;
        if (wave >= 2) {
            if (c > 0) load_z(c - 1);
            if (c + 1 < NCH) { const unsigned char* src = rec0 + (size_t)(c + 1) * R_STRIDE; GLAS unsigned char* dst = lds + ((c + 1) & 1) * R_BYTES;
                for (int x = tid - 128; x < R_BYTES / 16; x += 384) *(GLAS u32x4*)(dst + x * 16) = *(const u32x4*)(src + (size_t)x * 16); }
            if (c > 0) finish_o(c - 1);
        } else {
            const int dv = 32 * wave + r31;
            const GLAS float* sc = (const GLAS float*)(buf + R_SC);
            const float gl = sc[128];
#define GFRAG(base, rt, ks) (*(const GLAS bf16x8*)(buf + (base) + ((((rt) * 4 + (ks)) * 2 + hi) * 32 + r31) * 16))
            bf16x8 sb[4];
#pragma unroll
            for (int s = 0; s < 2; ++s) { u32x4 f; f.x = cvtpk(S0[8 * s], S0[8 * s + 1]); f.y = cvtpk(S0[8 * s + 2], S0[8 * s + 3]); f.z = cvtpk(S0[8 * s + 4], S0[8 * s + 5]); f.w = cvtpk(S0[8 * s + 6], S0[8 * s + 7]); sb[s] = __builtin_bit_cast(bf16x8, f);
                u32x4 g; g.x = cvtpk(S1[8 * s], S1[8 * s + 1]); g.y = cvtpk(S1[8 * s + 2], S1[8 * s + 3]); g.z = cvtpk(S1[8 * s + 4], S1[8 * s + 5]); g.w = cvtpk(S1[8 * s + 6], S1[8 * s + 7]); sb[2 + s] = __builtin_bit_cast(bf16x8, g); }
            f32x16 vn[2], x2[2];
            const GLAS float* ul = (const GLAS float*)(buf + R_U);
#pragma unroll
            for (int ct = 0; ct < 2; ++ct) {
#pragma unroll
                for (int rr = 0; rr < 16; ++rr) vn[ct][rr] = ul[(32 * ct + crow(rr, 0) + 4 * hi) * 64 + dv];
                x2[ct] = f32x16{};
#pragma unroll
                for (int ks = 0; ks < 4; ++ks) { vn[ct] = GMFMA(GFRAG(R_NEGW, ct, ks), sb[ks], vn[ct]); x2[ct] = GMFMA(GFRAG(R_Q, ct, ks), sb[ks], x2[ct]); }
            }
            bf16x8 vb[4], vs[4];
#pragma unroll
            for (int ct = 0; ct < 2; ++ct) {
                float sv[16];
#pragma unroll
                for (int rr = 0; rr < 16; ++rr) { const int row = 32 * ct + crow(rr, 0) + 4 * hi; sv[rr] = vn[ct][rr] * sc[64 + row]; x2[ct][rr] *= sc[row]; }
#pragma unroll
                for (int s = 0; s < 2; ++s) { u32x4 f; f.x = cvtpk(vn[ct][8 * s], vn[ct][8 * s + 1]); f.y = cvtpk(vn[ct][8 * s + 2], vn[ct][8 * s + 3]); f.z = cvtpk(vn[ct][8 * s + 4], vn[ct][8 * s + 5]); f.w = cvtpk(vn[ct][8 * s + 6], vn[ct][8 * s + 7]); vb[2 * ct + s] = __builtin_bit_cast(bf16x8, f);
                    u32x4 g; g.x = cvtpk(sv[8 * s], sv[8 * s + 1]); g.y = cvtpk(sv[8 * s + 2], sv[8 * s + 3]); g.z = cvtpk(sv[8 * s + 4], sv[8 * s + 5]); g.w = cvtpk(sv[8 * s + 6], sv[8 * s + 7]); vs[2 * ct + s] = __builtin_bit_cast(bf16x8, g); }
            }
            x2[0] = GMFMA(GFRAG(R_INTRA, 0, 0), vb[0], x2[0]); x2[0] = GMFMA(GFRAG(R_INTRA, 0, 1), vb[1], x2[0]);
#pragma unroll
            for (int ks = 0; ks < 4; ++ks) x2[1] = GMFMA(GFRAG(R_INTRA, 1, ks), vb[ks], x2[1]);
#pragma unroll
            for (int rr = 0; rr < 16; ++rr) { S0[rr] *= gl; S1[rr] *= gl; }
#pragma unroll
            for (int ks = 0; ks < 4; ++ks) { S0 = GMFMA(GFRAG(R_KT, 0, ks), vs[ks], S0); S1 = GMFMA(GFRAG(R_KT, 1, ks), vs[ks], S1); }
#undef GFRAG
            GLAS float* ob = (GLAS float*)(lds + OB_OFF + (c & 1) * 16384);
#pragma unroll
            for (int ct = 0; ct < 2; ++ct)
#pragma unroll
                for (int rr = 0; rr < 16; ++rr) ob[(32 * ct + crow(rr, 0) + 4 * hi) * 64 + dv] = x2[ct][rr];
        }
        __syncthreads();
    }
    if (wave >= 2) { load_z(NCH - 1); finish_o(NCH - 1); }
    if (wave < 2) { float* so = sg_out + (size_t)bh * 4096 + 32 * wave + r31;
#pragma unroll
        for (int rr = 0; rr < 16; ++rr) { so[(crow(rr, 0) + 4 * hi) * 64] = S0[rr]; so[(32 + crow(rr, 0) + 4 * hi) * 64] = S1[rr]; } }
}
#undef GMFMA
#undef GDI
}

constexpr int NWAVES = 8;
constexpr int DM = 1024, NB = 8, SEQ = 2048, DB = 128, DS = 4;
constexpr int MP = NB * SEQ, MS = DB * DS, M = MP + MS;
constexpr int FF = 2816, NGU = 2 * FF, NIN = 3600, NINP = 3840;
constexpr int NH = 8, HD = 64, AW = 512, GW = 512;
constexpr int C_AQ = 0, C_AK = 512, C_AV = 1024, C_GQKV = 1536, C_Z = 3072, C_B = 3584, C_A = 3592;
constexpr float LN_EPS = 1e-5f, RMS_EPS = 1e-6f, ALPHA = 1.189207115002721f;
constexpr size_t O_YP = 0, O_YS = 16777216, O_KP = 17301504, O_VP = 25690112, O_SGP = 34078720, O_SCP = 34340864, O_KS = 34377728, O_VS = 34639872, O_SGS = 34902016, O_SCS = 39096320, O_END = 39686144;
constexpr size_t MiB = 1u << 20;
constexpr size_t WS_CTL = 0, CTL_ZERO_BYTES = 1 * MiB, WS_WGU1 = 1 * MiB, WS_WD1 = 13 * MiB, WS_WIN = 19 * MiB, WS_WOUT = 27 * MiB, WS_WGU2 = 29 * MiB, WS_WD2 = 41 * MiB;
constexpr size_t WS_XB = 48 * MiB, WS_H = 82 * MiB, WS_T = 174 * MiB, WS_X1 = 240 * MiB, WS_X1B = 306 * MiB, WS_P = 340 * MiB, WS_HEADS = 588 * MiB;
constexpr size_t WS_GQ = 622 * MiB, WS_GK = 655 * MiB, WS_GV = 688 * MiB, WS_GG = 721 * MiB, WS_GB = 722 * MiB, WS_GO = 723 * MiB, WS_X2 = 756 * MiB, WS_X2B = 822 * MiB, WS_QB = 856 * MiB, WS_KB = 872 * MiB, WS_VB = 888 * MiB, WS_REC = 904 * MiB, WS_END = 1036 * MiB;
constexpr int CW_BAR = 4096;
constexpr int RING_OFF = 0, RING_BYTES = 131072, LDS_BYTES = 147456, LDSCTL_OFF = LDS_BYTES - 512, MISC_OFF = LDSCTL_OFF + 320;

struct Args { const float* in[25]; float* out; unsigned char* ws; };

__device__ __forceinline__ float wave_sum(float v) {
#pragma unroll
    for (int o = 1; o < 64; o <<= 1) v += __shfl_xor(v, o);
    return v;
}
__device__ __forceinline__ float wave_max(float v) {
#pragma unroll
    for (int o = 1; o < 64; o <<= 1) v = fmaxf(v, __shfl_xor(v, o));
    return v;
}
__device__ __forceinline__ int t5_bucket(int n) {
    if (n < 16) return n;
    int b = 16;
    b += (n >= 22); b += (n >= 30); b += (n >= 40); b += (n >= 54); b += (n >= 73); b += (n >= 99); b += (n >= 134); b += (n >= 182);
    b += (n >= 246); b += (n >= 332); b += (n >= 450); b += (n >= 609); b += (n >= 825); b += (n >= 1117); b += (n >= 1513);
    return b;
}
__device__ __forceinline__ unsigned long long pk4(f32x4 v) { return (unsigned long long)pk2(v.x, v.y) | ((unsigned long long)pk2(v.z, v.w) << 32); }

__device__ __forceinline__ void p0_transpose_item(const float* W0, const float* W1, int K, int Nsrc, int Nd, int mode, bf16* WT, LAS float* scr, int item, int lane) {
    const int nblk = Nd / 32, kb = item / nblk, nb = item % nblk, k0 = 64 * kb, n0 = 32 * nb;
    const float* src = W0; int c0 = n0;
    if (mode == 1) { const int t = n0 / 256, w = n0 % 256; src = (w < 128) ? W0 : W1; c0 = t * 128 + (w & 127); }
    const bool okc = (c0 + (lane & 31)) < Nsrc;
#pragma unroll 8
    for (int i = 0; i < 32; ++i) { const int kk = 2 * i + (lane >> 5); scr[kk * 33 + (lane & 31)] = okc ? src[(size_t)(k0 + kk) * Nsrc + c0 + (lane & 31)] : 0.f; }
    LDS_WAIT(); asm volatile("" ::: "memory");
    const int c = lane & 7;
#pragma unroll
    for (int j = 0; j < 4; ++j) { const int n = (lane >> 3) + 8 * j; const LAS float* s = scr + (8 * c) * 33 + n;
        v4u o; o.x = pk2(s[0 * 33], s[1 * 33]); o.y = pk2(s[2 * 33], s[3 * 33]); o.z = pk2(s[4 * 33], s[5 * 33]); o.w = pk2(s[6 * 33], s[7 * 33]);
        *(GAS v4u*)(WT + (size_t)(n0 + n) * K + k0 + 8 * c) = o; }
    LDS_WAIT(); asm volatile("" ::: "memory");
}
__device__ __forceinline__ void p_transpose(const float* W0, const float* W1, int K, int Nsrc, int Nd, int mode, bf16* WT, LAS float* scr, int gw, int NGW, int lane) {
    const int nitems = (K / 64) * (Nd / 32);
    for (int it = gw; it < nitems; it += NGW) p0_transpose_item(W0, W1, K, Nsrc, Nd, mode, WT, scr, it, lane);
}
__device__ __forceinline__ void p_cvt_x(const float* xp, const float* xs, bf16* xb, int gw, int NGW, int lane) {
    for (int m = gw; m < M; m += NGW) { const float* s = (m < MP) ? xp + (size_t)m * DM : xs + (size_t)(m - MP) * DM;
#pragma unroll
        for (int j = 0; j < 4; ++j) { const f32x4 v = *(const f32x4*)(s + j * 256 + lane * 4); *(unsigned long long*)(xb + (size_t)m * DM + j * 256 + lane * 4) = pk4(v); } }
}
__device__ __forceinline__ void p_ln(const float* r0, const float* r1, const float* t, float s, const float* g, const float* b, float* o0, float* o1, bf16* ob, int gw, int NGW, int lane) {
    for (int m = gw; m < M; m += NGW) {
        const float* rr = (m < MP) ? r0 + (size_t)m * DM : r1 + (size_t)(m - MP) * DM;
        const float* tt = t + (size_t)m * DM;
        f32x4 v[4]; float sum = 0.f;
#pragma unroll
        for (int j = 0; j < 4; ++j) { const f32x4 a = *(const f32x4*)(rr + j * 256 + lane * 4), c = *(const f32x4*)(tt + j * 256 + lane * 4); v[j] = a * ALPHA + c * s; sum += (v[j].x + v[j].y) + (v[j].z + v[j].w); }
        const float mean = wave_sum(sum) * (1.f / DM); float s2 = 0.f;
#pragma unroll
        for (int j = 0; j < 4; ++j) { v[j] = v[j] - mean; s2 += (v[j].x * v[j].x + v[j].y * v[j].y) + (v[j].z * v[j].z + v[j].w * v[j].w); }
        const float rstd = 1.0f / sqrtf(wave_sum(s2) * (1.f / DM) + LN_EPS);
        float* oo = (m < MP) ? o0 + (size_t)m * DM : o1 + (size_t)(m - MP) * DM;
#pragma unroll
        for (int j = 0; j < 4; ++j) { const f32x4 gg = *(const f32x4*)(g + j * 256 + lane * 4), bb = *(const f32x4*)(b + j * 256 + lane * 4); const f32x4 y = v[j] * rstd * gg + bb;
            *(f32x4*)(oo + j * 256 + lane * 4) = y;
            if (ob) *(unsigned long long*)(ob + (size_t)m * DM + j * 256 + lane * 4) = pk4(y); }
    }
}
__device__ __forceinline__ void p_copy_out(const float* P, float* out, bf16* Qb, bf16* Kb, bf16* Vb, int gw, int NGW, int lane) {
    for (int m = gw; m < M; m += NGW) {
        const float* pr = P + (size_t)m * NINP;
        if (m < MP) {
#pragma unroll
            for (int j = 0; j < 2; ++j) { const int c = j * 256 + lane * 4; *(unsigned long long*)(Qb + (size_t)m * AW + c) = pk4(*(const f32x4*)(pr + C_AQ + c) * attn_body::C2);
                *(unsigned long long*)(Kb + (size_t)m * AW + c) = pk4(*(const f32x4*)(pr + C_AK + c)); *(unsigned long long*)(Vb + (size_t)m * AW + c) = pk4(*(const f32x4*)(pr + C_AV + c)); } }
        float* kd; float* vd;
        if (m < MP) { kd = out + O_KP + (size_t)m * AW; vd = out + O_VP + (size_t)m * AW; } else { kd = out + O_KS + (size_t)(m - MP) * AW; vd = out + O_VS + (size_t)(m - MP) * AW; }
#pragma unroll
        for (int j = 0; j < 2; ++j) { *(f32x4*)(kd + j * 256 + lane * 4) = *(const f32x4*)(pr + C_AK + j * 256 + lane * 4); *(f32x4*)(vd + j * 256 + lane * 4) = *(const f32x4*)(pr + C_AV + j * 256 + lane * 4); }
        float* sd = nullptr;
        if (m < MP) { const int b = m / SEQ, t = m % SEQ; if (t >= SEQ - 3) sd = out + O_SCP + ((size_t)b * 3 + (t - (SEQ - 3))) * 1536; }
        else { const int b = (m - MP) / DS, t = (m - MP) % DS; if (t >= 1) sd = out + O_SCS + ((size_t)b * 3 + (t - 1)) * 1536; }
        if (sd) {
#pragma unroll
            for (int j = 0; j < 6; ++j) *(f32x4*)(sd + j * 256 + lane * 4) = *(const f32x4*)(pr + C_GQKV + j * 256 + lane * 4); }
    }
}
__device__ __forceinline__ void p_attn_simple(const float* P, const float* ck, const float* cv, const float* relb, bf16* heads, LAS float* lds, int m0, int vcu, int G, int h, int lane) {
    LAS float* sq = lds + h * 64; LAS float* sp = lds + 8 * 64 + h * 392;
    for (int m = m0 + vcu; m < M; m += G) {
        const bool samp = m >= MP; int b, p;
        if (!samp) { b = m / SEQ; p = m % SEQ; } else { b = (m - MP) / DS; p = SEQ + (m - MP) % DS; }
        sq[lane] = P[(size_t)m * NINP + C_AQ + h * 64 + lane] * 0.125f;
        LDS_WAIT(); asm volatile("" ::: "memory");
        float lg[7]; float mx = -INFINITY;
#pragma unroll
        for (int i = 0; i < 7; ++i) {
            const int e = i * 64 + lane; float v = -INFINITY;
            if (e < 387) { const int g = e / 129, j = e % 129, dil = (g == 0) ? 1 : (g == 1 ? 4 : 16), delta = j * dil, pos = p - delta;
                if (pos >= 0) {
                    const float* kp;
                    if (!samp) kp = P + (size_t)(b * SEQ + pos) * NINP + C_AK + h * 64;
                    else if (pos >= SEQ) kp = P + (size_t)(MP + b * DS + (pos - SEQ)) * NINP + C_AK + h * 64;
                    else kp = ck + (((size_t)b * SEQ + pos) * NH + h) * HD;
                    float acc = 0.f;
#pragma unroll
                    for (int d = 0; d < 64; d += 4) { const f32x4 kv = *(const f32x4*)(kp + d); acc += kv.x * sq[d] + kv.y * sq[d + 1] + kv.z * sq[d + 2] + kv.w * sq[d + 3]; }
                    v = acc + relb[t5_bucket(delta) * NH + h]; } }
            lg[i] = v; mx = fmaxf(mx, v); }
        mx = wave_max(mx);
        float sum = 0.f;
#pragma unroll
        for (int i = 0; i < 7; ++i) { const int e = i * 64 + lane; const float pe = (lg[i] == -INFINITY) ? 0.f : __expf(lg[i] - mx); if (e < 387) sp[e] = pe; sum += pe; }
        sum = wave_sum(sum);
        LDS_WAIT(); asm volatile("" ::: "memory");
        float o = 0.f;
        for (int e = 0; e < 387; ++e) { const float pe = sp[e]; if (pe == 0.f) continue;
            const int g = e / 129, j = e % 129, dil = (g == 0) ? 1 : (g == 1 ? 4 : 16), pos = p - j * dil;
            const float* vp;
            if (!samp) vp = P + (size_t)(b * SEQ + pos) * NINP + C_AV + h * 64;
            else if (pos >= SEQ) vp = P + (size_t)(MP + b * DS + (pos - SEQ)) * NINP + C_AV + h * 64;
            else vp = cv + (((size_t)b * SEQ + pos) * NH + h) * HD;
            o += pe * vp[lane]; }
        heads[(size_t)m * DM + h * 64 + lane] = (bf16)f2bf(o / sum);
        LDS_WAIT(); asm volatile("" ::: "memory");
    }
}
#define SDPP(x, ctrl) __builtin_bit_cast(float, __builtin_amdgcn_update_dpp(0, __builtin_bit_cast(int, (x)), (ctrl), 0xF, 0xF, false))
__device__ __forceinline__ void p_attn_sample(const float* P, const float* ck, const float* cv, const float* relb, bf16* heads, LAS float* lgs  , unsigned* qctr, int lane_in) {
    int lane = lane_in; asm volatile("" : "+v"(lane));
    const int g = lane >> 3, c = lane & 7;
    for (;;) {
        unsigned tk = 0; if (lane == 0) tk = __hip_atomic_fetch_add(qctr, 1u, __ATOMIC_RELAXED, __HIP_MEMORY_SCOPE_AGENT);
        const int task = __builtin_amdgcn_readfirstlane(tk); if (task >= MS * NH) break;
        const int sr = task >> 3, h = task & 7, b = sr >> 2, t = sr & 3, m = MP + sr, p = SEQ + t;
        f32x4 q0 = *(const f32x4*)(P + (size_t)m * NINP + C_AQ + h * 64 + 8 * c), q1 = *(const f32x4*)(P + (size_t)m * NINP + C_AQ + h * 64 + 8 * c + 4);
        q0 = q0 * 0.125f; q1 = q1 * 0.125f;
        const float* knew = P + (size_t)(MP + b * DS) * NINP + C_AK + h * 64 + 8 * c; const float* kold = ck + ((size_t)b * SEQ * NH + h) * HD + 8 * c;
        float mx = -INFINITY;
#pragma unroll 7
        for (int it = 0; it < 49; ++it) {
            const int e = it * 8 + g; const int ee = e < 387 ? e : 386;
            const int pat = (ee >= 258) ? 2 : (ee >= 129 ? 1 : 0), j = ee - pat * 129, delta = j << (2 * pat), pos = p - delta;
            const float* kp = (pos >= SEQ) ? knew + (size_t)(pos - SEQ) * NINP : kold + (size_t)pos * (NH * HD);
            const f32x4 k0 = *(const f32x4*)kp, k1 = *(const f32x4*)(kp + 4);
            float d = (k0.x * q0.x + k0.y * q0.y) + (k0.z * q0.z + k0.w * q0.w) + (k1.x * q1.x + k1.y * q1.y) + (k1.z * q1.z + k1.w * q1.w);
            d += SDPP(d, 0xB1); d += SDPP(d, 0x4E); d += SDPP(d, 0x141);
            const float v = (e < 387) ? d + relb[t5_bucket(delta) * NH + h] : -INFINITY;
            if (c == 0) lgs[it * 8 + g] = v;
            mx = fmaxf(mx, v); }
        mx = fmaxf(mx, __shfl_xor(mx, 8)); mx = fmaxf(mx, __shfl_xor(mx, 16)); mx = fmaxf(mx, __shfl_xor(mx, 32));
        LDS_WAIT(); asm volatile("" ::: "memory");
        const float* vnew = knew + (C_AV - C_AK); const float* vold = cv + ((size_t)b * SEQ * NH + h) * HD + 8 * c;
        float sum = 0.f; float acc[8];
#pragma unroll
        for (int j = 0; j < 8; ++j) acc[j] = 0.f;
#pragma unroll 7
        for (int it = 0; it < 49; ++it) {
            const int e = it * 8 + g; const int ee = e < 387 ? e : 386;
            const int pat = (ee >= 258) ? 2 : (ee >= 129 ? 1 : 0), j = ee - pat * 129, delta = j << (2 * pat), pos = p - delta;
            const float* vp = (pos >= SEQ) ? vnew + (size_t)(pos - SEQ) * NINP : vold + (size_t)pos * (NH * HD);
            const f32x4 v0 = *(const f32x4*)vp, v1 = *(const f32x4*)(vp + 4);
            const float pe = __expf(lgs[it * 8 + g] - mx); sum += pe;
            acc[0] += pe * v0.x; acc[1] += pe * v0.y; acc[2] += pe * v0.z; acc[3] += pe * v0.w; acc[4] += pe * v1.x; acc[5] += pe * v1.y; acc[6] += pe * v1.z; acc[7] += pe * v1.w; }
        sum += __shfl_xor(sum, 8); sum += __shfl_xor(sum, 16); sum += __shfl_xor(sum, 32);
#pragma unroll
        for (int j = 0; j < 8; ++j) { acc[j] += __shfl_xor(acc[j], 8); acc[j] += __shfl_xor(acc[j], 16); acc[j] += __shfl_xor(acc[j], 32); }
        if (g == 0) { const float inv = 1.0f / sum; v4u o; o.x = pk2(acc[0] * inv, acc[1] * inv); o.y = pk2(acc[2] * inv, acc[3] * inv); o.z = pk2(acc[4] * inv, acc[5] * inv); o.w = pk2(acc[6] * inv, acc[7] * inv);
            *(v4u*)(heads + (size_t)m * DM + h * 64 + 8 * c) = o; }
        LDS_WAIT(); asm volatile("" ::: "memory");
    }
}
__device__ __forceinline__ void p_gdn_prep(const float* P, const float* sconv, const float* convw, const float* alog, const float* dtb, float* GQ, float* GK, float* GV, float* GG, float* GB, int m0, int vcu, int G, int h, int lane) {
    for (int m = m0 + vcu; m < M; m += G) {
        const bool samp = m >= MP; int b, t;
        if (!samp) { b = m / SEQ; t = m % SEQ; } else { b = (m - MP) / DS; t = (m - MP) % DS; }
        float r[3];
#pragma unroll
        for (int part = 0; part < 3; ++part) {
            const int c = part * 512 + h * 64 + lane; float acc = 0.f;
#pragma unroll
            for (int j = 0; j < 4; ++j) { const int tt = t - 3 + j; float x;
                if (tt >= 0) x = P[(size_t)(m - t + tt) * NINP + C_GQKV + c]; else x = samp ? sconv[((size_t)b * 3 + (tt + 3)) * 1536 + c] : 0.f;
                acc += x * convw[j * 1536 + c]; }
            r[part] = acc / (1.0f + __expf(-acc)); }
        const float qn = wave_sum(r[0] * r[0]), kn = wave_sum(r[1] * r[1]);
        GQ[(size_t)m * GW + h * 64 + lane] = r[0] * (1.0f / sqrtf(qn + RMS_EPS)) * 0.125f;
        GK[(size_t)m * GW + h * 64 + lane] = r[1] * (1.0f / sqrtf(kn + RMS_EPS));
        GV[(size_t)m * GW + h * 64 + lane] = r[2];
        if (lane == 0) { const float bb = P[(size_t)m * NINP + C_B + h], aa = P[(size_t)m * NINP + C_A + h] + dtb[h];
            GB[(size_t)m * NH + h] = 1.0f / (1.0f + __expf(-bb));
            const float sp = (aa > 20.f) ? aa : log1pf(__expf(aa));
            GG[(size_t)m * NH + h] = -__expf(alog[h]) * sp; }
    }
}
__device__ __forceinline__ void gdn_scan_task(int task, const float* GQ, const float* GK, const float* GV, const float* GG, const float* GB, const float* s0, const float* P, const float* nw, bf16* heads, float* out, int lane) {
    const int seq = task / NH, h = task % NH;
    float S[64]; int row0, L; float* sdst;
    if (seq < NB) { row0 = seq * SEQ; L = SEQ; sdst = out + O_SGP + ((size_t)seq * NH + h) * 4096;
#pragma unroll
        for (int d = 0; d < 64; ++d) S[d] = 0.f; }
    else { const int b = seq - NB; row0 = MP + b * DS; L = DS; sdst = out + O_SGS + ((size_t)b * NH + h) * 4096; const float* sp = s0 + ((size_t)b * NH + h) * 4096;
#pragma unroll
        for (int d = 0; d < 64; ++d) S[d] = sp[d * 64 + lane]; }
    const float nwl = nw[lane];
    size_t o = (size_t)row0 * GW + h * 64 + lane;
    float qn = GQ[o], kn = GK[o], vn = GV[o], gn = GG[(size_t)row0 * NH + h], bn = GB[(size_t)row0 * NH + h], zn = P[(size_t)row0 * NINP + C_Z + h * 64 + lane];
    for (int t = 0; t < L; ++t) {
        const float qv = qn, kv = kn, vv = vn, eg = __expf(gn), beta = bn, z = zn; const int m = row0 + t;
        if (t + 1 < L) { o += GW; qn = GQ[o]; kn = GK[o]; vn = GV[o]; gn = GG[(size_t)(m + 1) * NH + h]; bn = GB[(size_t)(m + 1) * NH + h]; zn = P[(size_t)(m + 1) * NINP + C_Z + h * 64 + lane]; }
        float k0 = 0.f, k1 = 0.f, k2 = 0.f, k3 = 0.f;
#pragma unroll
        for (int d = 0; d < 64; d += 4) {
            k0 += __builtin_bit_cast(float, __builtin_amdgcn_readlane(__builtin_bit_cast(int, kv), d)) * S[d];
            k1 += __builtin_bit_cast(float, __builtin_amdgcn_readlane(__builtin_bit_cast(int, kv), d + 1)) * S[d + 1];
            k2 += __builtin_bit_cast(float, __builtin_amdgcn_readlane(__builtin_bit_cast(int, kv), d + 2)) * S[d + 2];
            k3 += __builtin_bit_cast(float, __builtin_amdgcn_readlane(__builtin_bit_cast(int, kv), d + 3)) * S[d + 3]; }
        const float ks = (k0 + k1) + (k2 + k3);
        const float c = beta * (vv - eg * ks);
        float o0 = 0.f, o1 = 0.f, o2 = 0.f, o3 = 0.f;
#pragma unroll
        for (int d = 0; d < 64; d += 4) {
#pragma unroll
            for (int e = 0; e < 4; ++e) { const float kd = __builtin_bit_cast(float, __builtin_amdgcn_readlane(__builtin_bit_cast(int, kv), d + e)); S[d + e] = fmaf(kd, c, eg * S[d + e]); }
            o0 += __builtin_bit_cast(float, __builtin_amdgcn_readlane(__builtin_bit_cast(int, qv), d)) * S[d];
            o1 += __builtin_bit_cast(float, __builtin_amdgcn_readlane(__builtin_bit_cast(int, qv), d + 1)) * S[d + 1];
            o2 += __builtin_bit_cast(float, __builtin_amdgcn_readlane(__builtin_bit_cast(int, qv), d + 2)) * S[d + 2];
            o3 += __builtin_bit_cast(float, __builtin_amdgcn_readlane(__builtin_bit_cast(int, qv), d + 3)) * S[d + 3]; }
        const float ov = (o0 + o1) + (o2 + o3);
        const float ms = wave_sum(ov * ov) * (1.f / 64.f);
        const float y = ov * (1.0f / sqrtf(ms + RMS_EPS)) * nwl * (z / (1.0f + __expf(-z)));
        heads[(size_t)m * DM + AW + h * 64 + lane] = (bf16)f2bf(y);
    }
#pragma unroll
    for (int d = 0; d < 64; ++d) sdst[d * 64 + lane] = S[d];
}

__device__ __forceinline__ void p_gdn_out(const float* GO, const float* P, const float* nw, bf16* heads, int gw, int NGW, int lane) {
    const float nwl = nw[lane];
    for (int m = gw; m < MP; m += NGW) {
#pragma unroll
        for (int h = 0; h < NH; ++h) { const float o = GO[(size_t)m * GW + h * 64 + lane]; const float ms = wave_sum(o * o) * (1.f / 64.f); const float z = P[(size_t)m * NINP + C_Z + h * 64 + lane];
            heads[(size_t)m * DM + AW + h * 64 + lane] = (bf16)f2bf(o * (1.0f / sqrtf(ms + RMS_EPS)) * nwl * (z / (1.0f + __expf(-z)))); }
    }
}
typedef float f32x4m __attribute__((ext_vector_type(4)));
__device__ __forceinline__ void thin_gemm(const bf16* A, const bf16* Bt, int K, float* out, int ldo, LAS float* red, int vcu, int G, int tid_in) {
    int tid = tid_in; asm volatile("" : "+v"(tid));
    const int wave = __builtin_amdgcn_readfirstlane(tid >> 6), lane = tid & 63, r = lane & 15, kq = lane >> 4;
    const int kper = K >> 3, steps = kper >> 5;
    for (int tile = vcu; tile < 256; tile += G) {
        const int tm = tile >> 4, tn = tile & 15;
        const bf16* ap = A + (size_t)(32 * tm + r) * K + wave * kper + 8 * kq;
        const bf16* bp = Bt + (size_t)(64 * tn + r) * K + wave * kper + 8 * kq;
        f32x4m acc[2][4];
#pragma unroll
        for (int i = 0; i < 2; ++i)
#pragma unroll
            for (int j = 0; j < 4; ++j) acc[i][j] = (f32x4m){0.f, 0.f, 0.f, 0.f};
#pragma unroll 2
        for (int s = 0; s < steps; ++s) {
            const bf16x8 a0 = *(const bf16x8*)(ap + 32 * s), a1 = *(const bf16x8*)(ap + (size_t)16 * K + 32 * s);
            bf16x8 b[4];
#pragma unroll
            for (int j = 0; j < 4; ++j) b[j] = *(const bf16x8*)(bp + (size_t)(16 * j) * K + 32 * s);
#pragma unroll
            for (int j = 0; j < 4; ++j) { acc[0][j] = __builtin_amdgcn_mfma_f32_16x16x32_bf16(a0, b[j], acc[0][j], 0, 0, 0); acc[1][j] = __builtin_amdgcn_mfma_f32_16x16x32_bf16(a1, b[j], acc[1][j], 0, 0, 0); }
        }
#pragma unroll
        for (int i = 0; i < 2; ++i)
#pragma unroll
            for (int j = 0; j < 4; ++j)
#pragma unroll
                for (int e = 0; e < 4; ++e) red[(wave * 32 + 16 * i + 4 * kq + e) * 64 + 16 * j + r] = acc[i][j][e];
        __syncthreads();
        {   const int row = tid >> 4, c4 = (tid & 15) * 4;
            f32x4m sum = (f32x4m){0.f, 0.f, 0.f, 0.f};
#pragma unroll
            for (int w = 0; w < 8; ++w) sum += *(const LAS f32x4m*)(red + (w * 32 + row) * 64 + c4);
            *(f32x4m*)(out + (size_t)(32 * tm + row) * ldo + 64 * tn + c4) = sum; }
        __syncthreads();
    }
}
__global__ void __launch_bounds__(NWAVES * 64, 2) mega_fwd(Args args) {
    extern __shared__ __attribute__((aligned(16))) unsigned char lds[];
    LAS unsigned char* L = (LAS unsigned char*)lds;
    volatile LAS unsigned* MISC = (volatile LAS unsigned*)(L + MISC_OFF);
    const int tid = threadIdx.x, lane = tid & 63, wave = __builtin_amdgcn_readfirstlane(tid >> 6);
    const int G = gridDim.x; const int bx = blockIdx.x; const int vcu = (G % 8 == 0) ? (bx % 8) * (G / 8) + bx / 8 : bx;
    unsigned char* ws = args.ws; float* out = args.out;
    gu32* ctl = (gu32*)(ws + WS_CTL);
    for (int u = tid; u < (LDS_BYTES - LDSCTL_OFF) / 4; u += NWAVES * 64) ((LAS unsigned*)(L + LDSCTL_OFF))[u] = 0u;
    __syncthreads();
    XcdBarrier bar = xcd_barrier_post((unsigned*)(ctl + CW_BAR), MISC + 8);
#define GRID_BAR() xcd_barrier(bar)
    const float* const* in = args.in;
    bf16 *Wgu1 = (bf16*)(ws + WS_WGU1), *Wd1 = (bf16*)(ws + WS_WD1), *Win = (bf16*)(ws + WS_WIN), *Wout = (bf16*)(ws + WS_WOUT), *Wgu2 = (bf16*)(ws + WS_WGU2), *Wd2 = (bf16*)(ws + WS_WD2);
    bf16 *XB = (bf16*)(ws + WS_XB), *H = (bf16*)(ws + WS_H), *X1B = (bf16*)(ws + WS_X1B), *HEADS = (bf16*)(ws + WS_HEADS), *X2B = (bf16*)(ws + WS_X2B);
    float *T = (float*)(ws + WS_T), *X1 = (float*)(ws + WS_X1), *P = (float*)(ws + WS_P), *GQ = (float*)(ws + WS_GQ), *GK = (float*)(ws + WS_GK), *GV = (float*)(ws + WS_GV), *GG = (float*)(ws + WS_GG), *GB = (float*)(ws + WS_GB), *X2 = (float*)(ws + WS_X2);
    const int gw = vcu * NWAVES + wave, NGW = G * NWAVES;
    bf16 *Qb = (bf16*)(ws + WS_QB), *Kb = (bf16*)(ws + WS_KB), *Vb = (bf16*)(ws + WS_VB);
    unsigned char* REC = ws + WS_REC; float* GO = (float*)(ws + WS_GO);

    {   LAS float* scr = (LAS float*)(L + RING_OFF + wave * 16384);
        p_transpose(in[9], in[10], DM, FF, NGU, 1, Wgu1, scr, gw, NGW, lane);
        p_transpose(in[11], nullptr, FF, DM, DM, 0, Wd1, scr, gw, NGW, lane);
        p_transpose(in[12], nullptr, DM, NIN, NINP, 0, Win, scr, gw, NGW, lane);
        p_transpose(in[13], nullptr, DM, DM, DM, 0, Wout, scr, gw, NGW, lane);
        p_transpose(in[20], in[21], DM, FF, NGU, 1, Wgu2, scr, gw, NGW, lane);
        p_transpose(in[22], nullptr, FF, DM, DM, 0, Wd2, scr, gw, NGW, lane);
        p_cvt_x(in[0], in[1], XB, gw, NGW, lane);
        GRID_BAR(); }
    {   pg8::Gemm g{XB, Wgu1, M, NGU, DM, 0}; pg8::StaticOrder S; S.init(M, NGU, G, bx); pg8::EpiSwiGLU E{H, FF, 0};
        pg8::gemm_phase<pg8::EpiSwiGLU, pg8::StaticOrder, true, true>(L + RING_OFF, g, S, E); GRID_BAR(); }
    {   pg8::Gemm g{H, Wd1, MP, DM, FF, 0}; pg8::StaticOrder S; S.init(MP, DM, G, bx); pg8::EpiF32 E{T, DM, 0};
        pg8::gemm_phase<pg8::EpiF32, pg8::StaticOrder, true, true>(L + RING_OFF, g, S, E);
        thin_gemm(H + (size_t)MP * FF, Wd1, FF, T + (size_t)MP * DM, DM, (LAS float*)(L + RING_OFF), vcu, G, tid); GRID_BAR(); }
    p_ln(in[0], in[1], T, 0.5f, in[7], in[8], X1, X1 + (size_t)MP * DM, X1B, gw, NGW, lane); GRID_BAR();
    {   pg8::Gemm g{X1B, Win, M, NINP, DM, 0}; pg8::StaticOrder S; S.init(M, NINP, G, bx); pg8::EpiF32 E{P, NINP, 0};
        pg8::gemm_phase<pg8::EpiF32, pg8::StaticOrder, true, true>(L + RING_OFF, g, S, E); GRID_BAR(); }
    p_copy_out(P, out, Qb, Kb, Vb, gw, NGW, lane);
    p_gdn_prep(P, in[5], in[14], in[15], in[16], GQ, GK, GV, GG, GB, MP, vcu, G, wave, lane);
    for (int unit = gw; unit < NB * NH * 32; unit += NGW) gdn::pre_unit(unit, P, in[14], in[15], in[16], REC, L + RING_OFF + wave * 16384, lane);
    GRID_BAR();
    if (vcu < NB * NH) gdn::scan_wg(vcu, REC, P, in[17], HEADS, out + O_SGP, L + RING_OFF, tid);
    {   const attn_body::AttnTensors AT{(const attn_body::bf16*)Qb, (const attn_body::bf16*)Kb, (const attn_body::bf16*)Vb, (attn_body::bf16*)HEADS};
        const attn_body::QueueOrder S{(unsigned*)(ctl + 192), MISC + 16};
        attn_body::attn_phase<attn_body::QueueOrder>((char*)lds + RING_OFF, AT, in[6], S); }
    p_attn_sample(P, in[2], in[3], in[6], HEADS, (LAS float*)(L + RING_OFF) + wave * 448, (unsigned*)(ctl + 256), lane);
    for (int task = NB * NH + wave * G + bx; task < (NB + DB) * NH; task += NGW) gdn_scan_task(task, GQ, GK, GV, GG, GB, in[4], P, in[17], HEADS, out, lane);
    GRID_BAR();
    {   pg8::Gemm g{HEADS, Wout, MP, DM, DM, 0}; pg8::StaticOrder S; S.init(MP, DM, G, bx); pg8::EpiF32 E{T, DM, 0};
        pg8::gemm_phase<pg8::EpiF32, pg8::StaticOrder, true, true>(L + RING_OFF, g, S, E);
        thin_gemm(HEADS + (size_t)MP * DM, Wout, DM, T + (size_t)MP * DM, DM, (LAS float*)(L + RING_OFF), vcu, G, tid); GRID_BAR(); }
    p_ln(X1, X1 + (size_t)MP * DM, T, 1.0f, in[18], in[19], X2, X2 + (size_t)MP * DM, X2B, gw, NGW, lane); GRID_BAR();
    {   pg8::Gemm g{X2B, Wgu2, M, NGU, DM, 0}; pg8::StaticOrder S; S.init(M, NGU, G, bx); pg8::EpiSwiGLU E{H, FF, 0};
        pg8::gemm_phase<pg8::EpiSwiGLU, pg8::StaticOrder, true, true>(L + RING_OFF, g, S, E); GRID_BAR(); }
    {   pg8::Gemm g{H, Wd2, MP, DM, FF, 0}; pg8::StaticOrder S; S.init(MP, DM, G, bx); pg8::EpiF32 E{T, DM, 0};
        pg8::gemm_phase<pg8::EpiF32, pg8::StaticOrder, true, true>(L + RING_OFF, g, S, E);
        thin_gemm(H + (size_t)MP * FF, Wd2, FF, T + (size_t)MP * DM, DM, (LAS float*)(L + RING_OFF), vcu, G, tid); GRID_BAR(); }
    p_ln(X2, X2 + (size_t)MP * DM, T, 0.5f, in[23], in[24], out + O_YP, out + O_YS, nullptr, gw, NGW, lane);
}

extern "C" void kernel_launch(void* const* d_in, const int* in_sizes, int n_in, void* d_out, int out_size, void* d_ws, size_t ws_size, hipStream_t stream) {
    static int grid = 0;
    if (grid == 0) {
        if (n_in != 25 || out_size != (int)O_END || ws_size < WS_END) { fprintf(stderr, "kernel_launch: unexpected shapes (n_in %d out %d ws %zu)\n", n_in, out_size, ws_size); grid = -1; return; }
        int dev = 0, cus = 0, per_cu = 0;
        if (hipGetDevice(&dev) != hipSuccess || hipDeviceGetAttribute(&cus, hipDeviceAttributeMultiprocessorCount, dev) != hipSuccess) { grid = -1; return; }
        if (hipFuncSetAttribute((const void*)mega_fwd, hipFuncAttributeMaxDynamicSharedMemorySize, LDS_BYTES) != hipSuccess) { fprintf(stderr, "kernel_launch: hipFuncSetAttribute failed\n"); grid = -1; return; }
        if (hipOccupancyMaxActiveBlocksPerMultiprocessor(&per_cu, (const void*)mega_fwd, NWAVES * 64, LDS_BYTES) != hipSuccess || per_cu < 1) { fprintf(stderr, "kernel_launch: occupancy query reports %d\n", per_cu); }
        (void)hipGetLastError();
        grid = cus;
    }
    if (grid < 0) return;
    if (hipMemsetAsync((char*)d_ws + WS_CTL, 0, CTL_ZERO_BYTES, stream) != hipSuccess) return;
    Args a; memset(&a, 0, sizeof(a));
    for (int i = 0; i < 25; ++i) a.in[i] = (const float*)d_in[i];
    a.out = (float*)d_out; a.ws = (unsigned char*)d_ws;
    hipLaunchKernelGGL(mega_fwd, dim3(grid), dim3(NWAVES * 64), LDS_BYTES, stream, a);
}
```
